# Optimizing an MI355X kernel written in HIP

```python
import math
import jax, jax.numpy as jnp
from jax import lax
import numpy as np

D_MODEL = 1024
BATCH = 8
SEQ = 4096
DEPTH = 4

HGRN_HEADS = 4
HGRN_DK = 128
HGRN_DV = 128
HGRN_KW = HGRN_HEADS * HGRN_DK
HGRN_VW = HGRN_HEADS * HGRN_DV
HGRN_CHUNK = 32
MLA_HEADS = 4
MLA_NOPE = 64
MLA_ROPE = 32
MLA_V = 64
MLA_Q_LORA = 192
MLA_KV_LORA = 128
ROPE_THETA = 10000.0
DSA_HEADS = 4
DSA_HEAD_DIM = 64
DSA_WIDTH = DSA_HEADS * DSA_HEAD_DIM
IDX_HEADS = 8
IDX_DIM = 64
TOPK_MAX = 256
NUM_BUCKETS = 32
MAX_DISTANCE = 128
MAX_POS_OFFSET = 1024
D_FF = 4 * D_MODEL
QB = 128
EPS = 1e-6

D_MIX = HGRN_VW + MLA_HEADS * MLA_V + DSA_WIDTH
IN_SIZES = (HGRN_KW, HGRN_KW, HGRN_VW, HGRN_VW,
            MLA_Q_LORA, MLA_KV_LORA + MLA_ROPE,
            DSA_WIDTH, DSA_WIDTH, DSA_WIDTH,
            IDX_HEADS * IDX_DIM, IDX_DIM, IDX_HEADS)
N_IN = sum(IN_SIZES)
SPLIT_POINTS = tuple(int(v) for v in np.cumsum(IN_SIZES)[:-1])

kernel_name = 'hybrid_hgrn2_mla_dsa'


def rms_norm(x, w):
    xf = x.astype(jnp.float32)
    y = xf * lax.rsqrt(jnp.mean(xf * xf, axis=-1, keepdims=True) + EPS)
    return (y * w.astype(jnp.float32)).astype(x.dtype)


def layer_norm(x, w, b):
    xf = x.astype(jnp.float32)
    mu = jnp.mean(xf, axis=-1, keepdims=True)
    var = jnp.mean(jnp.square(xf - mu), axis=-1, keepdims=True)
    y = (xf - mu) * lax.rsqrt(var + EPS)
    return (y * w.astype(jnp.float32) + b.astype(jnp.float32)).astype(x.dtype)


def apply_rope(x, cos, sin):
    half = x.shape[-1] // 2
    x1 = x[..., :half].astype(jnp.float32)
    x2 = x[..., half:].astype(jnp.float32)
    return jnp.concatenate([x1 * cos - x2 * sin, x2 * cos + x1 * sin], axis=-1).astype(x.dtype)


def t5_bucket(dist):
    n = jnp.maximum(dist, 0)
    max_exact = NUM_BUCKETS // 2
    nf = jnp.maximum(n, 1).astype(jnp.float32)
    large = max_exact + (jnp.log(nf / max_exact) / math.log(MAX_DISTANCE / max_exact)
                         * (NUM_BUCKETS - max_exact)).astype(jnp.int32)
    large = jnp.minimum(large, NUM_BUCKETS - 1)
    return jnp.where(n < max_exact, n, large)


def hgrn2_mixer(q, f_pre, i, g, lb, norm_w):
    B, S, _ = q.shape
    N = S // HGRN_CHUNK
    C = HGRN_CHUNK
    fp = f_pre.astype(jnp.float32)
    lb = lb.astype(jnp.float32)
    log_f = jnp.logaddexp(jnp.log(lb), jnp.log1p(-lb) + jax.nn.log_sigmoid(fp))
    k = (1.0 - lb) * jax.nn.sigmoid(-fp)

    def chunked(a, d):
        return a.astype(jnp.float32).reshape(B, N, C, HGRN_HEADS, d).transpose(1, 0, 3, 2, 4)

    qc = chunked(q, HGRN_DK) * (HGRN_DK ** -0.5)
    kc = chunked(k, HGRN_DK)
    vc = chunked(i, HGRN_DV)
    G = jnp.cumsum(chunked(log_f, HGRN_DK), axis=3)
    q_dec = qc * jnp.exp(G)
    k_inv = kc * jnp.exp(-G)
    causal = jnp.tril(jnp.ones((C, C), dtype=bool))
    A = jnp.where(causal, jnp.einsum('nbhtk,nbhsk->nbhts', q_dec, k_inv), 0.0)
    o_intra = jnp.einsum('nbhts,nbhsv->nbhtv', A, vc)
    G_last = G[:, :, :, -1:, :]
    k_state = kc * jnp.exp(G_last - G)
    chunk_decay = jnp.exp(G_last[:, :, :, 0, :])

    def step(state, xs):
        q_n, k_n, v_n, d_n = xs
        o_n = jnp.einsum('bhtk,bhkv->bhtv', q_n, state)
        state = d_n[..., None] * state + jnp.einsum('bhtk,bhtv->bhkv', k_n, v_n)
        return state, o_n

    s0 = jnp.zeros((B, HGRN_HEADS, HGRN_DK, HGRN_DV), jnp.float32)
    _, o_inter = lax.scan(step, s0, (q_dec, k_state, vc, chunk_decay))
    o = (o_intra + o_inter).transpose(1, 0, 3, 2, 4).reshape(B, S, HGRN_HEADS, HGRN_DV)
    gate = g.astype(jnp.float32).reshape(B, S, HGRN_HEADS, HGRN_DV)
    o = rms_norm(o, norm_w) * jax.nn.silu(gate)
    return o.reshape(B, S, HGRN_VW).astype(q.dtype)


def dense_causal_attention(q, k, v, scale):
    B, S, H, Dk = q.shape
    Dv = v.shape[-1]
    nb = S // QB
    qb = q.reshape(B, nb, QB, H, Dk).swapaxes(0, 1)
    key_pos = jnp.arange(S)

    def one_block(args):
        q_b, start = args
        t = start + jnp.arange(QB)
        logits = jnp.einsum('bqhd,bshd->bhqs', q_b, k).astype(jnp.float32) * scale
        mask = key_pos[None, :] <= t[:, None]
        logits = jnp.where(mask, logits, -jnp.inf)
        p = jax.nn.softmax(logits, axis=-1)
        return jnp.einsum('bhqs,bshd->bqhd', p.astype(v.dtype), v)

    out = lax.map(one_block, (qb, jnp.arange(nb) * QB))
    return out.swapaxes(0, 1).reshape(B, S, H * Dv)


def mla_mixer(q_a, kv_a, cos, sin, q_norm_w, w_qb, kv_norm_w, w_kvb):
    B, S, _ = q_a.shape
    q = (rms_norm(q_a, q_norm_w) @ w_qb).reshape(B, S, MLA_HEADS, MLA_NOPE + MLA_ROPE)
    q_nope, q_pe = q[..., :MLA_NOPE], q[..., MLA_NOPE:]
    c_kv, k_pe = kv_a[..., :MLA_KV_LORA], kv_a[..., MLA_KV_LORA:]
    kv = (rms_norm(c_kv, kv_norm_w) @ w_kvb).reshape(B, S, MLA_HEADS, MLA_NOPE + MLA_V)
    k_nope, v = kv[..., :MLA_NOPE], kv[..., MLA_NOPE:]
    q_pe = apply_rope(q_pe, cos[:, :, None, :], sin[:, :, None, :])
    k_pe = apply_rope(k_pe, cos, sin)[:, :, None, :]
    qf = jnp.concatenate([q_nope, q_pe], axis=-1)
    kf = jnp.concatenate([k_nope, jnp.broadcast_to(k_pe, (B, S, MLA_HEADS, MLA_ROPE))], axis=-1)
    return dense_causal_attention(qf, kf, v, (MLA_NOPE + MLA_ROPE) ** -0.5)


def dsa_mixer(q, k, v, qi, ki, wi, positions, rel_table):
    B, S, H, D = q.shape
    nb = S // QB
    n_sel = min(TOPK_MAX, S // 4)
    key_pos = jnp.arange(S)
    gather = jax.vmap(lambda a, idx: a[idx])
    kif = ki.astype(jnp.float32)

    def blockify(a):
        return a.reshape((B, nb, QB) + a.shape[2:]).swapaxes(0, 1)

    def one_block(args):
        q_b, qi_b, w_b, pos_b, start = args
        t = start + jnp.arange(QB)
        idx_logits = jnp.einsum('bqhd,bsd->bqhs', qi_b.astype(jnp.float32), kif) * (IDX_DIM ** -0.5)
        score = jnp.einsum('bqhs,bqh->bqs', jax.nn.relu(idx_logits), w_b.astype(jnp.float32))
        causal = key_pos[None, :] <= t[:, None]
        score = jnp.where(causal[None], score, -jnp.inf)
        top_val, top_idx = lax.top_k(score, n_sel)
        valid = jnp.isfinite(top_val)
        k_sel = gather(k, top_idx)
        v_sel = gather(v, top_idx)
        pos_sel = gather(positions, top_idx)
        bias = rel_table.astype(jnp.float32)[t5_bucket(pos_b[:, :, None] - pos_sel)]
        logits = (jnp.einsum('bqhd,bqkhd->bqhk', q_b, k_sel).astype(jnp.float32) * (D ** -0.5)
                  + bias.transpose(0, 1, 3, 2))
        logits = jnp.where(valid[:, :, None, :], logits, -jnp.inf)
        p = jax.nn.softmax(logits, axis=-1)
        return jnp.einsum('bqhk,bqkhd->bqhd', p.astype(v.dtype), v_sel)

    out = lax.map(one_block, (blockify(q), blockify(qi), blockify(wi), blockify(positions),
                              jnp.arange(nb) * QB))
    return out.swapaxes(0, 1).reshape(B, S, H * D)


def setup_inputs(seed: int = 0) -> dict:
    key = jax.random.key(seed)
    ks = jax.random.split(key, 20)
    f32 = jnp.float32

    def nrm(k, shape, scale):
        return jax.random.normal(k, shape, f32) * scale

    def gain(k, shape):
        return 1.0 + 0.02 * jax.random.normal(k, shape, f32)

    x = jax.random.normal(ks[0], (BATCH, SEQ, D_MODEL), f32)
    offsets = jax.random.randint(ks[1], (BATCH, 1), 0, MAX_POS_OFFSET, dtype=jnp.int32)
    positions = (offsets + jnp.arange(SEQ, dtype=jnp.int32)[None, :]).astype(jnp.int32)
    return {
        'x': x,
        'positions': positions,
        'attn_norm_w': gain(ks[2], (DEPTH, D_MODEL)),
        'w_in': nrm(ks[3], (DEPTH, D_MODEL, N_IN), D_MODEL ** -0.5),
        'hgrn_lb_logits': nrm(ks[4], (DEPTH, HGRN_KW), 0.1),
        'hgrn_norm_w': gain(ks[5], (DEPTH, HGRN_DV)),
        'mla_q_norm_w': gain(ks[6], (DEPTH, MLA_Q_LORA)),
        'mla_w_qb': nrm(ks[7], (DEPTH, MLA_Q_LORA, MLA_HEADS * (MLA_NOPE + MLA_ROPE)), MLA_Q_LORA ** -0.5),
        'mla_kv_norm_w': gain(ks[8], (DEPTH, MLA_KV_LORA)),
        'mla_w_kvb': nrm(ks[9], (DEPTH, MLA_KV_LORA, MLA_HEADS * (MLA_NOPE + MLA_V)), MLA_KV_LORA ** -0.5),
        'idx_k_norm_w': gain(ks[10], (DEPTH, IDX_DIM)),
        'idx_k_norm_b': nrm(ks[11], (DEPTH, IDX_DIM), 0.02),
        'rel_bias_table': nrm(ks[12], (NUM_BUCKETS, DSA_HEADS), 0.3),
        'w_out': nrm(ks[13], (DEPTH, D_MIX, D_MODEL), D_MIX ** -0.5),
        'mlp_norm_w': gain(ks[14], (DEPTH, D_MODEL)),
        'w_mlp_in': nrm(ks[15], (DEPTH, D_MODEL, D_FF), D_MODEL ** -0.5),
        'w_mlp_out': nrm(ks[16], (DEPTH, D_FF, D_MODEL), D_FF ** -0.5),
        'final_norm_w': gain(ks[17], (D_MODEL,)),
    }


def reference(x, positions, attn_norm_w, w_in, hgrn_lb_logits, hgrn_norm_w, mla_q_norm_w, mla_w_qb,
              mla_kv_norm_w, mla_w_kvb, idx_k_norm_w, idx_k_norm_b, rel_bias_table, w_out,
              mlp_norm_w, w_mlp_in, w_mlp_out, final_norm_w):
    B, S, _ = x.shape
    inv_freq = 1.0 / (ROPE_THETA ** (jnp.arange(0, MLA_ROPE, 2, dtype=jnp.float32) / MLA_ROPE))
    ang = positions.astype(jnp.float32)[..., None] * inv_freq
    cos, sin = jnp.cos(ang), jnp.sin(ang)
    lb_all = jnp.cumsum(jax.nn.softmax(hgrn_lb_logits.astype(jnp.float32), axis=0), axis=0)
    lb_all = lb_all - lb_all[0:1]
    h = x
    for l in range(DEPTH):
        u = rms_norm(h, attn_norm_w[l])
        proj = u @ w_in[l]
        (hq, hf, hi, hg, mqa, mkva, dq, dk, dv, iq, ik, iw) = jnp.split(proj, SPLIT_POINTS, axis=-1)
        y_hgrn = hgrn2_mixer(hq, hf, hi, hg, lb_all[l], hgrn_norm_w[l])
        y_mla = mla_mixer(mqa, mkva, cos, sin, mla_q_norm_w[l], mla_w_qb[l], mla_kv_norm_w[l], mla_w_kvb[l])
        y_dsa = dsa_mixer(dq.reshape(B, S, DSA_HEADS, DSA_HEAD_DIM),
                          dk.reshape(B, S, DSA_HEADS, DSA_HEAD_DIM),
                          dv.reshape(B, S, DSA_HEADS, DSA_HEAD_DIM),
                          iq.reshape(B, S, IDX_HEADS, IDX_DIM),
                          layer_norm(ik, idx_k_norm_w[l], idx_k_norm_b[l]),
                          iw * (IDX_HEADS ** -0.5),
                          positions, rel_bias_table)
        mixed = jnp.concatenate([y_hgrn, y_mla.astype(h.dtype), y_dsa.astype(h.dtype)], axis=-1)
        h = h + mixed @ w_out[l]
        u = rms_norm(h, mlp_norm_w[l])
        h = h + jnp.square(jax.nn.relu(u @ w_mlp_in[l])) @ w_mlp_out[l]
    return rms_norm(h, final_norm_w)
```

```cpp
#include <hip/hip_runtime.h>
#include <hip/hip_bf16.h>
#include <cstdio>
#include <cstdint>
#include <cmath>
namespace pg8 {
#define PG8_LAS __attribute__((address_space(3)))
typedef unsigned short bf16_t;
typedef short bf16x8 __attribute__((ext_vector_type(8)));
typedef float f32x4 __attribute__((ext_vector_type(4)));
typedef unsigned u32x4 __attribute__((ext_vector_type(4)));
constexpr int BM = 256, BK = 64, HALF = 128, HTB = HALF * BK * 2  , STAGE_BYTES = 8 * HTB, NXCD = 8, WGM = 8;

__host__ __device__ __forceinline__ int lds_byte(int r, int c) { const int st = (r >> 4) * 2 + (c >> 5), rr = r & 15, cc = c & 31, ob = rr * 64 + cc * 2; return st * 1024 + (ob ^ (((ob >> 9) & 1) << 5)); }
__host__ __device__ __forceinline__ void stage_rc(int b, int& R, int& C) { const int st = b / 1024, sb = b % 1024, swz = sb ^ (((sb >> 9) & 1) << 5); R = (st >> 1) * 16 + swz / 64; C = (st & 1) * 32 + (swz % 64) / 2; }
__host__ __device__ __forceinline__ int perm32(int rho) { const int n = rho >> 4, i = rho & 15; return 8 * (i >> 2) + 4 * n + (i & 3); }

struct Unit { int pm, pn; };
struct Gemm { const bf16_t* A; const bf16_t* Bt; int M, N, K; };

struct StaticOrder {
    int nM, nN, nwg, G, c;
    __host__ __device__ void init(int M, int N, int G_, int c_) { nM = M / BM; nN = N / BM; nwg = nM * nN; G = G_; c = c_; }
    __host__ __device__ bool next(int i, Unit& u) const {
        const long L = (long)i * G + c; if (L >= nwg) return false;
        int wgid = (int)L; { const int q = nwg / NXCD, r = nwg % NXCD, xcd = wgid % NXCD, off = wgid / NXCD; wgid = (xcd < r ? xcd * (q + 1) : r * (q + 1) + (xcd - r) * q) + off; }
        const int nig = WGM * nN, gid = wgid / nig, fm = gid * WGM, gsz = (nM - fm) < WGM ? (nM - fm) : WGM;
        u.pm = fm + ((wgid % nig) % gsz); u.pn = (wgid % nig) / gsz; return true;
    }
    __device__ __forceinline__ void a_ready(const Unit&) const {}
    __device__ __forceinline__ void done(const Unit&) const {}
};

__device__ __forceinline__ unsigned cvt_pk_bf16(float lo, float hi) { unsigned r; asm volatile("v_cvt_pk_bf16_f32 %0, %1, %2" : "=v"(r) : "v"(lo), "v"(hi)); return r; }
typedef float f32x2 __attribute__((ext_vector_type(2)));
__device__ __forceinline__ f32x2 gelu_pk(f32x2 v) {
    const f32x2 av = __builtin_elementwise_abs(v), d = av * 0.2316418882f + 1.0f;
    f32x2 t; t.x = __builtin_amdgcn_rcpf(d.x); t.y = __builtin_amdgcn_rcpf(d.y);
    f32x2 q = t * 0.5307027145f + (-0.7265760135f); q = q * t + 0.7107068705f; q = q * t + (-0.142248368f); q = q * t + 0.127414796f; q = q * t;
    const f32x2 s = (v * v) * (-0.72134752044f);
    f32x2 e; e.x = __builtin_amdgcn_exp2f(s.x); e.y = __builtin_amdgcn_exp2f(s.y);
    const f32x2 m = v * (q * e), r = v - m;
    f32x2 o; o.x = v.x < 0.f ? m.x : r.x; o.y = v.y < 0.f ? m.y : r.y; return o;
}

template <int ACT  > struct EpiBf16 {
    static constexpr bool PERM = true, AFTER_DRAIN = false; static_assert(ACT == 0 || ACT == 1, "EpiBf16: ACT is 0 (none) or 1 (gelu_pk)");
    bf16_t* O; int ldc; const float* bias; int split_cols; size_t split_stride; float scale0;
    __device__ __forceinline__ void operator()(const f32x4 (&acc)[2][2][4][2], const Unit& u, int wr, int wc, int fr, int fq) const {
        const int row0 = u.pm * BM + wr * 64 + fr; int colt = u.pn * BM; bf16_t* base = O;
        float sc = 1.f; if (split_cols) { const int t = colt / split_cols; base += (size_t)t * split_stride; colt -= t * split_cols; if (t == 0) sc = scale0; }
        const int col0 = colt + wc * 32 + 8 * fq, bcol0 = u.pn * BM + wc * 32 + 8 * fq;
        f32x4 bv[2][2];
#pragma unroll
        for (int bj = 0; bj < 2; ++bj)
#pragma unroll
            for (int n = 0; n < 2; ++n) bv[bj][n] = bias ? *(const f32x4*)(bias + bcol0 + bj * HALF + 4 * n) : (f32x4){0.f, 0.f, 0.f, 0.f};
#pragma unroll
        for (int ai = 0; ai < 2; ++ai)
#pragma unroll
            for (int m = 0; m < 4; ++m) { bf16_t* rowp = base + (size_t)(row0 + ai * HALF + m * 16) * ldc + col0;
#pragma unroll
                for (int bj = 0; bj < 2; ++bj) { f32x4 v0 = acc[ai][bj][m][0] + bv[bj][0], v1 = acc[ai][bj][m][1] + bv[bj][1];
                    if (ACT == 1) { f32x2 a = gelu_pk((f32x2){v0[0], v0[1]}), b = gelu_pk((f32x2){v0[2], v0[3]}), c = gelu_pk((f32x2){v1[0], v1[1]}), d = gelu_pk((f32x2){v1[2], v1[3]});
                        v0 = (f32x4){a.x, a.y, b.x, b.y}; v1 = (f32x4){c.x, c.y, d.x, d.y}; }
                    v0 = v0 * sc; v1 = v1 * sc; u32x4 w; w.x = cvt_pk_bf16(v0[0], v0[1]); w.y = cvt_pk_bf16(v0[2], v0[3]); w.z = cvt_pk_bf16(v1[0], v1[1]); w.w = cvt_pk_bf16(v1[2], v1[3]);
                    *(u32x4*)(rowp + bj * HALF) = w; } }
    }
};
template <int ACT  > struct EpiScale {
    static constexpr bool PERM = true, AFTER_DRAIN = false;
    bf16_t* O; int ldc; const float* part;
    __device__ __forceinline__ void operator()(const f32x4 (&acc)[2][2][4][2], const Unit& u, int wr, int wc, int fr, int fq) const {
        const int row0 = u.pm * BM + wr * 64 + fr, col0 = u.pn * BM + wc * 32 + 8 * fq;
#pragma unroll
        for (int ai = 0; ai < 2; ++ai)
#pragma unroll
            for (int m = 0; m < 4; ++m) {
                const int row = row0 + ai * HALF + m * 16;
                const f32x4* pp = (const f32x4*)(part + (size_t)row * 16);
                const f32x4 p0 = pp[0], p1 = pp[1], p2 = pp[2], p3 = pp[3];
                const float ss = ((p0[0] + p0[1]) + (p0[2] + p0[3])) + ((p1[0] + p1[1]) + (p1[2] + p1[3])) + ((p2[0] + p2[1]) + (p2[2] + p2[3])) + ((p3[0] + p3[1]) + (p3[2] + p3[3]));
                const float rs = 1.0f / sqrtf(ss * (1.0f / 1024.0f) + 1e-6f);
                bf16_t* rowp = O + (size_t)row * ldc + col0;
#pragma unroll
                for (int bj = 0; bj < 2; ++bj) {
                    f32x4 v0 = acc[ai][bj][m][0] * rs, v1 = acc[ai][bj][m][1] * rs;
                    if (ACT == 1) {
#pragma unroll
                        for (int e = 0; e < 4; ++e) { const float a = fmaxf(v0[e], 0.f), b = fmaxf(v1[e], 0.f); v0[e] = a * a; v1[e] = b * b; }
                    }
                    u32x4 w; w.x = cvt_pk_bf16(v0[0], v0[1]); w.y = cvt_pk_bf16(v0[2], v0[3]); w.z = cvt_pk_bf16(v1[0], v1[1]); w.w = cvt_pk_bf16(v1[2], v1[3]);
                    *(u32x4*)(rowp + bj * HALF) = w;
                }
            }
    }
};
struct EpiRes {
    static constexpr bool PERM = true, AFTER_DRAIN = false;
    float* h; bf16_t* hb; float* part_out;
    __device__ __forceinline__ void operator()(const f32x4 (&acc)[2][2][4][2], const Unit& u, int wr, int wc, int fr, int fq) const {
        const int row0 = u.pm * BM + wr * 64 + fr, col0 = u.pn * BM + wc * 32 + 8 * fq;
#pragma unroll
        for (int ai = 0; ai < 2; ++ai)
#pragma unroll
            for (int m = 0; m < 4; ++m) {
                const int row = row0 + ai * HALF + m * 16;
                float ssq = 0.f;
#pragma unroll
                for (int bj = 0; bj < 2; ++bj) {
                    float* hp = h + (size_t)row * 1024 + col0 + bj * HALF;
                    f32x4 h0 = *(const f32x4*)hp, h1 = *(const f32x4*)(hp + 4);
                    h0 = h0 + acc[ai][bj][m][0]; h1 = h1 + acc[ai][bj][m][1];
                    *(f32x4*)hp = h0; *(f32x4*)(hp + 4) = h1;
                    ssq += (h0[0] * h0[0] + h0[1] * h0[1]) + (h0[2] * h0[2] + h0[3] * h0[3]) + (h1[0] * h1[0] + h1[1] * h1[1]) + (h1[2] * h1[2] + h1[3] * h1[3]);
                    u32x4 w; w.x = cvt_pk_bf16(h0[0], h0[1]); w.y = cvt_pk_bf16(h0[2], h0[3]); w.z = cvt_pk_bf16(h1[0], h1[1]); w.w = cvt_pk_bf16(h1[2], h1[3]);
                    *(u32x4*)(hb + (size_t)row * 1024 + col0 + bj * HALF) = w;
                }
                ssq += __shfl_xor(ssq, 16); ssq += __shfl_xor(ssq, 32);
                if (fq == 0) part_out[(size_t)row * 16 + u.pn * 4 + wc] = ssq;
            }
    }
};
template <class Epi, class Sched, bool ALIGN_EPI = false, bool SP2 = false>
__device__ __forceinline__ void gemm_phase(PG8_LAS unsigned char* lds, const Gemm g, const Sched& S, const Epi& E) {
    int tid_o = threadIdx.x; asm volatile("" : "+v"(tid_o));
    const int tid = tid_o, wid = __builtin_amdgcn_readfirstlane(tid >> 6), lane = tid & 63, wr = wid >> 2, wc = wid & 3, fr = lane & 15, fq = lane >> 4;
    const int K = g.K, nt = K / BK;
    unsigned voffA[2], voffB[2];
#pragma unroll
    for (int i = 0; i < 2; ++i) { int R, C; stage_rc(tid * 16 + i * 8192, R, C); const int Rb = Epi::PERM ? ((R & ~31) + perm32(R & 31)) : R;
        voffA[i] = (unsigned)(R * K + C) * 2u; voffB[i] = (unsigned)(Rb * K + C) * 2u; }
    const size_t kstep = (size_t)(BK * 2);
    const size_t hstep = (size_t)HALF * K * 2;
    const size_t tstep = 2 * hstep;
    const unsigned ldsw = (unsigned)wid * 1024u;
    const int aoff = lds_byte(wr * 64 + fr, fq * 8), boff = lds_byte(wc * 32 + fr, fq * 8);
#define PG8_SA(b, h) (((b) * 2 + (h)) * HTB)
#define PG8_SB(b, h) ((4 + (b) * 2 + (h)) * HTB)
#define PG8_STAGE(bufoff, gbase, voff) do { _Pragma("unroll") for (int _i = 0; _i < 2; ++_i) \
        __builtin_amdgcn_global_load_lds((const unsigned*)((const char*)(gbase) + (voff)[_i]), (PG8_LAS unsigned*)(lds + (bufoff) + ldsw + _i * 8192), 16, 0, 0); } while (0)
#define PG8_LDA(dst, b, h) do { _Pragma("unroll") for (int m = 0; m < 4; ++m) _Pragma("unroll") for (int k = 0; k < 2; ++k) dst[m][k] = *(const PG8_LAS bf16x8*)(lds + PG8_SA(b, h) + aoff + m * 2048 + k * 1024); } while (0)
#define PG8_LDB(dst, b, h) do { _Pragma("unroll") for (int n = 0; n < 2; ++n) _Pragma("unroll") for (int k = 0; k < 2; ++k) dst[n][k] = *(const PG8_LAS bf16x8*)(lds + PG8_SB(b, h) + boff + n * 2048 + k * 1024); } while (0)
#define PG8_MMA(ai, bj, At, Bt) do { __builtin_amdgcn_s_setprio(1); _Pragma("unroll") for (int m = 0; m < 4; ++m) _Pragma("unroll") for (int n = 0; n < 2; ++n) _Pragma("unroll") for (int k = 0; k < 2; ++k) \
        acc[ai][bj][m][n] = __builtin_amdgcn_mfma_f32_16x16x32_bf16(Bt[n][k], At[m][k], acc[ai][bj][m][n], 0, 0, 0); __builtin_amdgcn_s_setprio(0); } while (0)
#define PG8_WAIT_V(n) asm volatile("s_waitcnt vmcnt(" #n ")" ::: "memory")
#define PG8_WAIT_L(n) asm volatile("s_waitcnt lgkmcnt(" #n ")" ::: "memory")
#define PG8_BAR __builtin_amdgcn_s_barrier()
#define PG8_SCHED __builtin_amdgcn_sched_barrier(0)
    Unit cur, nxt; int ui = 0;
    if (!S.next(0, cur)) return;
    f32x4 acc[2][2][4][2];
#pragma unroll
    for (int a = 0; a < 2; ++a)
#pragma unroll
        for (int b = 0; b < 2; ++b)
#pragma unroll
            for (int m = 0; m < 4; ++m)
#pragma unroll
                for (int n = 0; n < 2; ++n) acc[a][b][m][n] = (f32x4){0.f, 0.f, 0.f, 0.f};
    bf16x8 At[4][2], B0[2][2], B1[2][2];
    const char* cA = (const char*)g.A + (size_t)cur.pm * tstep; const char* cB = (const char*)g.Bt + (size_t)cur.pn * tstep;
    S.a_ready(cur);
    if constexpr (SP2) {
        PG8_STAGE(PG8_SB(0, 0), cB, voffB); PG8_STAGE(PG8_SB(0, 1), cB + hstep, voffB); PG8_STAGE(PG8_SA(0, 0), cA, voffA); PG8_STAGE(PG8_SA(0, 1), cA + hstep, voffA);
        if (wr == 1) PG8_BAR;
        PG8_WAIT_V(2); PG8_BAR;
        PG8_STAGE(PG8_SB(1, 0), cB + kstep, voffB); PG8_STAGE(PG8_SA(1, 0), cA + kstep, voffA); PG8_STAGE(PG8_SB(1, 1), cB + hstep + kstep, voffB);
        PG8_WAIT_V(6); PG8_BAR;
    } else {
        PG8_STAGE(PG8_SB(0, 0), cB, voffB); PG8_STAGE(PG8_SA(0, 0), cA, voffA); PG8_STAGE(PG8_SB(0, 1), cB + hstep, voffB); PG8_STAGE(PG8_SA(0, 1), cA + hstep, voffA);
        if (wr == 1) PG8_BAR;
        PG8_WAIT_V(4); PG8_BAR;
        PG8_STAGE(PG8_SB(1, 0), cB + kstep, voffB); PG8_STAGE(PG8_SA(1, 0), cA + kstep, voffA); PG8_STAGE(PG8_SB(1, 1), cB + hstep + kstep, voffB);
        PG8_WAIT_V(6); PG8_BAR;
    }
    for (;;) {
        const bool has_next = S.next(ui + 1, nxt);
        const char* nA = has_next ? (const char*)g.A + (size_t)nxt.pm * tstep : cA; const char* nB = has_next ? (const char*)g.Bt + (size_t)nxt.pn * tstep : cB;
        for (int t = 0; t < nt; t += 2) {
            const bool last = (t == nt - 2);
            const char* a1 = cA + (size_t)(t + 1) * kstep;
            const char* a2 = last ? nA : cA + (size_t)(t + 2) * kstep; const char* b2 = last ? nB : cB + (size_t)(t + 2) * kstep;
            const char* a3 = a2 + kstep; const char* b3 = b2 + kstep;
            if (last && has_next) S.a_ready(nxt);
            if constexpr (SP2) {
            PG8_LDB(B0, 0, 0); PG8_LDB(B1, 0, 1); PG8_SCHED; PG8_LDA(At, 0, 0); PG8_STAGE(PG8_SA(1, 1), a1 + hstep, voffA);
            PG8_WAIT_V(8); PG8_WAIT_L(0); PG8_BAR; PG8_MMA(0, 0, At, B0); PG8_MMA(0, 1, At, B1); PG8_BAR; PG8_SCHED;
            PG8_LDA(At, 0, 1); PG8_STAGE(PG8_SB(0, 0), b2, voffB); PG8_STAGE(PG8_SB(0, 1), b2 + hstep, voffB); PG8_STAGE(PG8_SA(0, 0), a2, voffA);
            PG8_WAIT_V(8); PG8_WAIT_L(0); PG8_BAR; PG8_MMA(1, 0, At, B0); PG8_MMA(1, 1, At, B1); PG8_BAR; PG8_SCHED;
            PG8_LDB(B0, 1, 0); PG8_LDB(B1, 1, 1); PG8_SCHED; PG8_LDA(At, 1, 0); PG8_STAGE(PG8_SA(0, 1), a2 + hstep, voffA);
            PG8_WAIT_V(8); PG8_WAIT_L(0); PG8_BAR; PG8_MMA(0, 0, At, B0); PG8_MMA(0, 1, At, B1); PG8_BAR; PG8_SCHED;
            PG8_LDA(At, 1, 1); PG8_STAGE(PG8_SB(1, 0), b3, voffB); PG8_STAGE(PG8_SB(1, 1), b3 + hstep, voffB); PG8_STAGE(PG8_SA(1, 0), a3, voffA);
            PG8_WAIT_V(8); PG8_WAIT_L(0); PG8_BAR; PG8_MMA(1, 0, At, B0); PG8_MMA(1, 1, At, B1); PG8_BAR; PG8_SCHED;
            } else {
            PG8_LDB(B0, 0, 0); PG8_SCHED; PG8_LDA(At, 0, 0); PG8_STAGE(PG8_SA(1, 1), a1 + hstep, voffA);
            PG8_WAIT_L(8); PG8_BAR; PG8_WAIT_L(0); PG8_MMA(0, 0, At, B0); PG8_BAR; PG8_SCHED;
            PG8_LDB(B1, 0, 1); PG8_STAGE(PG8_SB(0, 0), b2, voffB);
            PG8_BAR; PG8_WAIT_L(0); PG8_MMA(0, 1, At, B1); PG8_BAR;
            PG8_LDA(At, 0, 1); PG8_STAGE(PG8_SA(0, 0), a2, voffA);
            PG8_BAR; PG8_WAIT_L(0); PG8_MMA(1, 0, At, B0); PG8_BAR; PG8_SCHED;
            PG8_STAGE(PG8_SB(0, 1), b2 + hstep, voffB);
            PG8_WAIT_V(6); PG8_BAR; PG8_MMA(1, 1, At, B1); PG8_BAR;
            PG8_LDB(B0, 1, 0); PG8_SCHED; PG8_LDA(At, 1, 0); PG8_STAGE(PG8_SA(0, 1), a2 + hstep, voffA);
            PG8_WAIT_L(8); PG8_BAR; PG8_WAIT_L(0); PG8_MMA(0, 0, At, B0); PG8_BAR; PG8_SCHED;
            PG8_LDB(B1, 1, 1); PG8_STAGE(PG8_SB(1, 0), b3, voffB);
            PG8_BAR; PG8_WAIT_L(0); PG8_MMA(0, 1, At, B1); PG8_BAR;
            PG8_LDA(At, 1, 1); PG8_STAGE(PG8_SA(1, 0), a3, voffA);
            PG8_BAR; PG8_WAIT_L(0); PG8_MMA(1, 0, At, B0); PG8_BAR; PG8_SCHED;
            PG8_STAGE(PG8_SB(1, 1), b3 + hstep, voffB);
            PG8_WAIT_V(6); PG8_BAR; PG8_MMA(1, 1, At, B1); PG8_BAR;
            }
        }
        if constexpr (ALIGN_EPI) { if (wr == 0) PG8_BAR; }
        if constexpr (!Epi::AFTER_DRAIN) { E(acc, cur, wr, wc, fr, fq); S.done(cur); }
        if (!has_next) break;
#pragma unroll
        for (int a = 0; a < 2; ++a)
#pragma unroll
            for (int b = 0; b < 2; ++b)
#pragma unroll
                for (int m = 0; m < 4; ++m)
#pragma unroll
                    for (int n = 0; n < 2; ++n) acc[a][b][m][n] = (f32x4){0.f, 0.f, 0.f, 0.f};
        cur = nxt; cA = nA; cB = nB; ++ui;
        if constexpr (ALIGN_EPI) { if (wr == 1) PG8_BAR; }
    }
    PG8_WAIT_V(0);
    if constexpr (!ALIGN_EPI) { if (wr == 0) PG8_BAR; }
    PG8_BAR;
    if constexpr (Epi::AFTER_DRAIN) { E.fused(acc, cur, wr, wc, fr, fq, lds, wid, lane); S.done(cur); }
#undef PG8_SA
#undef PG8_SB
#undef PG8_STAGE
#undef PG8_LDA
#undef PG8_LDB
#undef PG8_MMA
#undef PG8_WAIT_V
#undef PG8_WAIT_L
#undef PG8_BAR
#undef PG8_SCHED
}
}

#ifndef PG8_SP2
#define PG8_SP2 true
#endif
#ifndef PG8_ALIGN
#define PG8_ALIGN true
#endif
#define GAS __attribute__((address_space(1)))
#define LAS __attribute__((address_space(3)))
typedef unsigned short bf16;
typedef unsigned v4u __attribute__((ext_vector_type(4)));
typedef float f32x4 __attribute__((ext_vector_type(4)));
typedef short bf16x8 __attribute__((ext_vector_type(8)));
typedef GAS unsigned gu32;
typedef GAS unsigned long long gu64;
#define RLX_AGENT __ATOMIC_RELAXED, __HIP_MEMORY_SCOPE_AGENT
#define LDS_WAIT() asm volatile("s_waitcnt lgkmcnt(0)" ::: "memory")
#define VM_WAIT() asm volatile("s_waitcnt vmcnt(0)" ::: "memory")
__device__ __forceinline__ unsigned long long rt() { return __builtin_amdgcn_s_memrealtime(); }
__device__ __forceinline__ unsigned f2bf(float f) { unsigned u = __builtin_bit_cast(unsigned, f); return (u + 0x7fffu + ((u >> 16) & 1u)) >> 16; }
__device__ __forceinline__ unsigned pk2(float lo, float hi) { return f2bf(lo) | (f2bf(hi) << 16); }

#define XB_TMO      128
#define XB_XCNT(j)  (256  + 64 * (j))
#define XB_XSUB(j)  (1280 + 64 * (j))
#define XB_XGEN(j)  (2304 + 64 * (j))
#define XB_TOP      3328
#define XB_TOPGEN   3392
#define XCD_BAR_WORDS 3456
#define XB_SPIN_CAP (1u << 18)

__device__ __forceinline__ unsigned xb_ld(unsigned* p)              { return __hip_atomic_load(p, __ATOMIC_RELAXED, __HIP_MEMORY_SCOPE_AGENT); }
__device__ __forceinline__ unsigned xb_add(unsigned* p, unsigned v) { return __hip_atomic_fetch_add(p, v, __ATOMIC_RELAXED, __HIP_MEMORY_SCOPE_AGENT); }
__device__ __forceinline__ unsigned xb_xcc_id() { return (unsigned)__builtin_amdgcn_s_getreg((3 << 11) | 20) & 0xFu; }
#define XB_SPIN(cond, bar) do { unsigned _sp = 0; while (cond) { __builtin_amdgcn_s_sleep(1); \
    if ((++_sp & 255u) == 0u) { if (xb_ld(&(bar)[XB_TMO])) break; if (_sp > XB_SPIN_CAP) { atomicAdd(&(bar)[XB_TMO], 1u); break; } } } } while (0)

struct XcdBarrier {
    unsigned* bar; unsigned x;
    volatile LAS unsigned* st;
};

__device__ __forceinline__ XcdBarrier xcd_barrier_post(unsigned* bar, volatile LAS unsigned* st) {
    XcdBarrier b; b.bar = bar; b.x = xb_xcc_id(); b.st = st;
    if (threadIdx.x == 0) (void)xb_add(&bar[XB_XCNT(b.x)], 1u);
    return b;
}
__device__ __forceinline__ void xcd_barrier_complete(unsigned* bar, unsigned x, unsigned& nloc, unsigned& nx) {
    const unsigned G = gridDim.x * gridDim.y * gridDim.z;
    unsigned sum, cnt, mine, sp = 0u;
    for (;;) {
        sum = 0u; cnt = 0u; mine = 0u;
#pragma unroll
        for (unsigned j = 0; j < 16; ++j) { const unsigned c = xb_ld(&bar[XB_XCNT(j)]); sum += c; cnt += (c > 0u) ? 1u : 0u; mine = (j == x) ? c : mine; }
        if (sum == G) break;
        __builtin_amdgcn_s_sleep(1);
        if ((++sp & 255u) == 0u) { if (xb_ld(&bar[XB_TMO])) break; if (sp > XB_SPIN_CAP) { atomicAdd(&bar[XB_TMO], 1u); break; } }
    }
    nloc = mine > 0u ? mine : 1u; nx = cnt > 0u ? cnt : 1u;
}

__device__ __forceinline__ void xcd_barrier(const XcdBarrier& b) {
    asm volatile("s_waitcnt vmcnt(0)" ::: "memory");
    __syncthreads();
    if (threadIdx.x == 0) {
        unsigned* bar = b.bar;
        __builtin_amdgcn_s_waitcnt(0);
        unsigned nloc = b.st[0], nx = b.st[1];
        if (nloc == 0u) { xcd_barrier_complete(bar, b.x, nloc, nx); b.st[0] = nloc; b.st[1] = nx; }
        const unsigned old = xb_add(&bar[XB_XSUB(b.x)], 1u);
        const unsigned gen = old / nloc;
        if (old + 1u == (gen + 1u) * nloc) {
            __builtin_amdgcn_fence(__ATOMIC_RELEASE, "agent");
            asm volatile("s_waitcnt vmcnt(0)" ::: "memory");
            const unsigned og = xb_add(&bar[XB_TOP], 1u);
            const unsigned tg = og / nx;
            if (og + 1u == (tg + 1u) * nx) xb_add(&bar[XB_TOPGEN], 1u);
            else XB_SPIN(xb_ld(&bar[XB_TOPGEN]) == tg, bar);
            __builtin_amdgcn_fence(__ATOMIC_ACQUIRE, "agent");
            xb_add(&bar[XB_XGEN(b.x)], 1u);
            asm volatile("s_waitcnt vmcnt(0)" ::: "memory");
        } else {
            XB_SPIN(xb_ld(&bar[XB_XGEN(b.x)]) == gen, bar);
            __builtin_amdgcn_fence(__ATOMIC_ACQUIRE, "agent");
            asm volatile("s_waitcnt vmcnt(0)" ::: "memory");
        }
    }
    __syncthreads();
}
constexpr int NB = 8, SEQ = 4096, DM = 1024, DEPTH = 4, M = NB * SEQ;
constexpr int NINP = 3840, DFF = 4096;
constexpr int PC_HQ = 0, PC_HF = 512, PC_HI = 1024, PC_HG = 1536, PC_MQA = 2048, PC_MKVA = 2304, PC_IK = 2304 + 160, PC_IW = 2304 + 224, PC_DQ = 2560, PC_DK = 2816, PC_DV = 3072, PC_IQ = 3328;
constexpr int NIN_SRC = 3752;
constexpr float EPS = 1e-6f;
constexpr float QSCALE = 0.10206207261596577f * 1.4426950408889634f;

constexpr size_t MiB = 1u << 20;
constexpr size_t WS_CTL = 0, CTL_ZERO_BYTES = 1 * MiB;
constexpr size_t WS_PARTA = 1 * MiB, WS_PARTB = 3 * MiB, WS_COS = 5 * MiB, WS_SIN = 7 * MiB, WS_WI = 9 * MiB;
constexpr size_t WS_WSLOT = 10 * MiB, WSLOT_BYTES = 26 * MiB;
constexpr size_t WO_IN = 0, WO_OUT = WO_IN + (size_t)NINP * DM * 2, WO_1 = WO_OUT + (size_t)DM * DM * 2, WO_2 = WO_1 + (size_t)DFF * DM * 2, WO_QB = WO_2 + (size_t)DM * DFF * 2, WO_KVB = WO_QB + (size_t)384 * 192 * 2, WO_END = WO_KVB + (size_t)512 * 128 * 2;
static_assert(WO_END <= WSLOT_BYTES, "weight slot");
constexpr size_t WS_X = 62 * MiB, WS_Y = 126 * MiB, WS_PROJ = 190 * MiB, WS_MASK = 430 * MiB, WS_KI = 446 * MiB, WS_DECAY = 450 * MiB, WS_AT = 452 * MiB, WS_END = 460 * MiB;
static_assert(WS_PROJ + (size_t)M * NINP * 2 == WS_MASK && WS_PROJ + (size_t)M * DFF * 2 == WS_KI, "proj / hidden overlay");
constexpr size_t MLA_Q = 0, MLA_K = 24 * MiB, MLA_VT = 48 * MiB;
constexpr int CW_BAR = 4096;
constexpr int N_BAR_REGIONS = 16;

constexpr int RING_OFF = 0, RING_BYTES = 131072;
constexpr int LDSCTL_OFF = RING_BYTES, MISC_OFF = LDSCTL_OFF + 320;
constexpr int LDS_BYTES = 147456;
constexpr int NWAVES = 8;

__device__ __forceinline__ float bf2f(bf16 v) { return __uint_as_float((unsigned)v << 16); }

__device__ __forceinline__ int in_colmap(int n) {
    if (n < 2240) return n;
    if (n < 2304) return -1;
    if (n < 2304 + 160) return 2240 + (n - 2304);
    if (n < 2304 + 224) return 3680 + (n - 2304 - 160);
    if (n < 2304 + 232) return 3744 + (n - 2304 - 224);
    if (n < 2560) return -1;
    if (n < 3328) return 2400 + (n - 2560);
    return 3168 + (n - 3328);
}

__device__ __forceinline__ float wave_sum(float v) {
#pragma unroll
    for (int o = 1; o < 64; o <<= 1) v += __shfl_xor(v, o);
    return v;
}

__device__ __forceinline__ void cvt_item(const float* W, int K, int Nsrc, const float* gain, bf16* WT, int Np, int mode, LAS float* scr, int item, int lane) {
    const int nblk = Np / 32, kb = item / nblk, nb = item % nblk, k0 = 64 * kb, n0 = 32 * nb;
    const int n = n0 + (lane & 31); const int c = mode ? in_colmap(n) : n;
#pragma unroll 8
    for (int i = 0; i < 32; ++i) { const int kk = 2 * i + (lane >> 5); float v = 0.f; if (c >= 0) { v = W[(size_t)(k0 + kk) * Nsrc + c]; if (gain) v *= gain[k0 + kk]; } scr[kk * 33 + (lane & 31)] = v; }
    LDS_WAIT(); asm volatile("" ::: "memory");
    const int cc = lane & 7;
#pragma unroll
    for (int j = 0; j < 4; ++j) { const int nn = (lane >> 3) + 8 * j; const LAS float* s = scr + (8 * cc) * 33 + nn;
        v4u o; o.x = pk2(s[0 * 33], s[1 * 33]); o.y = pk2(s[2 * 33], s[3 * 33]); o.z = pk2(s[4 * 33], s[5 * 33]); o.w = pk2(s[6 * 33], s[7 * 33]);
        *(GAS v4u*)(WT + (size_t)(n0 + nn) * K + k0 + 8 * cc) = o; }
    LDS_WAIT(); asm volatile("" ::: "memory");
}

struct Args { const void* in[18]; float* out; unsigned char* ws; int p_lo, p_hi, bar_region, pad; };
enum { IN_X = 0, IN_POS, IN_ATTN_NW, IN_WIN, IN_LB, IN_HNW, IN_QNW, IN_WQB, IN_KVNW, IN_WKVB, IN_IKW, IN_IKB, IN_REL, IN_WOUT, IN_MLPNW, IN_W1, IN_W2, IN_FNW };

__device__ __forceinline__ void convert_layer(const Args& args, int l, int slot, LAS unsigned char* lds, int gw, int NGW, int wave, int lane) {
    LAS float* scr = (LAS float*)(lds + RING_OFF + wave * 16384);
    unsigned char* sb = args.ws + WS_WSLOT + (size_t)slot * WSLOT_BYTES;
    constexpr int I_IN = 16 * (NINP / 32), I_OUT = 16 * 32, I_1 = 16 * (DFF / 32), I_2 = 64 * 32, I_QB = 3 * 12, I_KVB = 2 * 16;
    constexpr int NIT = I_IN + I_OUT + I_1 + I_2 + I_QB + I_KVB;
    for (int it = gw; it < NIT; it += NGW) {
        int r = it;
        if (r < I_IN) { cvt_item((const float*)args.in[IN_WIN] + (size_t)l * DM * NIN_SRC, DM, NIN_SRC, (const float*)args.in[IN_ATTN_NW] + l * DM, (bf16*)(sb + WO_IN), NINP, 1, scr, r, lane); continue; } r -= I_IN;
        if (r < I_OUT) { cvt_item((const float*)args.in[IN_WOUT] + (size_t)l * DM * DM, DM, DM, nullptr, (bf16*)(sb + WO_OUT), DM, 0, scr, r, lane); continue; } r -= I_OUT;
        if (r < I_1) { cvt_item((const float*)args.in[IN_W1] + (size_t)l * DM * DFF, DM, DFF, (const float*)args.in[IN_MLPNW] + l * DM, (bf16*)(sb + WO_1), DFF, 0, scr, r, lane); continue; } r -= I_1;
        if (r < I_2) { cvt_item((const float*)args.in[IN_W2] + (size_t)l * DFF * DM, DFF, DM, nullptr, (bf16*)(sb + WO_2), DM, 0, scr, r, lane); continue; } r -= I_2;
        if (r < I_QB) { cvt_item((const float*)args.in[IN_WQB] + (size_t)l * 192 * 384, 192, 384, (const float*)args.in[IN_QNW] + l * 192, (bf16*)(sb + WO_QB), 384, 0, scr, r, lane); continue; } r -= I_QB;
        cvt_item((const float*)args.in[IN_WKVB] + (size_t)l * 128 * 512, 128, 512, (const float*)args.in[IN_KVNW] + l * 128, (bf16*)(sb + WO_KVB), 512, 0, scr, r, lane);
    }
}

constexpr int PH_PER_LAYER = 8, PH_FINAL = 1 + PH_PER_LAYER * DEPTH, PH_COUNT = PH_FINAL + 1;
__global__ void __launch_bounds__(NWAVES * 64, 2) fwd(Args args) {
    extern __shared__ __attribute__((aligned(16))) unsigned char lds_raw[];
    LAS unsigned char* lds = (LAS unsigned char*)lds_raw;
    volatile LAS unsigned* MISC = (volatile LAS unsigned*)(lds + MISC_OFF);
    const int tid = threadIdx.x, lane = tid & 63, wave = __builtin_amdgcn_readfirstlane(tid >> 6);
    const int G = gridDim.x, gw = blockIdx.x * NWAVES + wave, NGW = G * NWAVES;
    unsigned char* ws = args.ws;
    gu32* ctl = (gu32*)(ws + WS_CTL);
    for (int u = tid; u < (LDS_BYTES - LDSCTL_OFF) / 4; u += NWAVES * 64) ((LAS unsigned*)(lds + LDSCTL_OFF))[u] = 0u;
    __syncthreads();
    XcdBarrier bar = xcd_barrier_post((unsigned*)(ctl + CW_BAR) + args.bar_region * XCD_BAR_WORDS, MISC + 8);
    const int lo = args.p_lo, hi = args.p_hi;
#define IN(k) (lo <= (k) && (k) < hi)
#define SEAM(k) do { if ((k) + 1 < hi) xcd_barrier(bar); } while (0)
    float* hres = args.out;
    float* partA = (float*)(ws + WS_PARTA); float* partB = (float*)(ws + WS_PARTB);

    if (IN(0)) {
        const float* x = (const float*)args.in[IN_X]; bf16* hb = (bf16*)(ws + WS_X);
        for (int m = gw; m < M; m += NGW) {
            const GAS f32x4* xr = (const GAS f32x4*)(x + (size_t)m * DM) + lane; GAS f32x4* hr = (GAS f32x4*)(hres + (size_t)m * DM) + lane;
            GAS unsigned long long* o8 = (GAS unsigned long long*)(hb + (size_t)m * DM) + lane;
            float s = 0.f;
#pragma unroll
            for (int j = 0; j < 4; ++j) { const f32x4 v = xr[64 * j]; hr[64 * j] = v; s += (v.x * v.x + v.y * v.y) + (v.z * v.z + v.w * v.w);
                o8[64 * j] = (unsigned long long)pk2(v.x, v.y) | ((unsigned long long)pk2(v.z, v.w) << 32); }
            s = wave_sum(s);
            if (lane < 16) partA[(size_t)m * 16 + lane] = (lane == 0) ? s : 0.f;
        }
        const int* pos = (const int*)args.in[IN_POS]; float* cs = (float*)(ws + WS_COS); float* sn = (float*)(ws + WS_SIN);
        for (int idx = blockIdx.x * (NWAVES * 64) + tid; idx < M * 16; idx += G * NWAVES * 64) {
            const int m = idx >> 4, i = idx & 15;
            const float invf = __builtin_amdgcn_exp2f(-(float)i * 0.8304820237218405f);
            const float ang = (float)pos[m] * invf;
            const double rev = (double)ang * 0.15915494309189535; const float fr = (float)(rev - rint(rev));
            cs[idx] = __builtin_amdgcn_cosf(fr); sn[idx] = __builtin_amdgcn_sinf(fr);
        }
        SEAM(0);
    }

#pragma unroll 1
    for (int l = 0; l < DEPTH; ++l) {
        const int pb = 1 + PH_PER_LAYER * l;
        unsigned char* sb = ws + WS_WSLOT + (size_t)(l & 1) * WSLOT_BYTES;
        unsigned char* bufIn = ws + ((l & 1) ? WS_Y : WS_X);
        unsigned char* bufOt = ws + ((l & 1) ? WS_X : WS_Y);
        if (IN(pb + 0)) { convert_layer(args, l, l & 1, lds, gw, NGW, wave, lane); SEAM(pb + 0); }
        if (IN(pb + 1)) {
            pg8::Gemm g{(const pg8::bf16_t*)bufIn, (const pg8::bf16_t*)(sb + WO_IN), M, NINP, DM}; pg8::StaticOrder S; S.init(M, NINP, G, (int)blockIdx.x);
            pg8::EpiScale<0> E{(pg8::bf16_t*)(ws + WS_PROJ), NINP, partA};
            pg8::gemm_phase<pg8::EpiScale<0>, pg8::StaticOrder, PG8_ALIGN, PG8_SP2>(lds + RING_OFF, g, S, E);
            SEAM(pb + 1);
        }
        if (IN(pb + 5)) {
            pg8::Gemm g{(const pg8::bf16_t*)bufOt, (const pg8::bf16_t*)(sb + WO_OUT), M, DM, DM}; pg8::StaticOrder S; S.init(M, DM, G, (int)blockIdx.x);
            pg8::EpiRes E{hres, (pg8::bf16_t*)bufIn, partB};
            pg8::gemm_phase<pg8::EpiRes, pg8::StaticOrder, PG8_ALIGN, PG8_SP2>(lds + RING_OFF, g, S, E);
            SEAM(pb + 5);
        }
        if (IN(pb + 6)) {
            pg8::Gemm g{(const pg8::bf16_t*)bufIn, (const pg8::bf16_t*)(sb + WO_1), M, DFF, DM}; pg8::StaticOrder S; S.init(M, DFF, G, (int)blockIdx.x);
            pg8::EpiScale<1> E{(pg8::bf16_t*)(ws + WS_PROJ), DFF, partB};
            pg8::gemm_phase<pg8::EpiScale<1>, pg8::StaticOrder, PG8_ALIGN, PG8_SP2>(lds + RING_OFF, g, S, E);
            SEAM(pb + 6);
        }
        if (IN(pb + 7)) {
            pg8::Gemm g{(const pg8::bf16_t*)(ws + WS_PROJ), (const pg8::bf16_t*)(sb + WO_2), M, DM, DFF}; pg8::StaticOrder S; S.init(M, DM, G, (int)blockIdx.x);
            pg8::EpiRes E{hres, (pg8::bf16_t*)bufOt, partA};
            pg8::gemm_phase<pg8::EpiRes, pg8::StaticOrder, PG8_ALIGN, PG8_SP2>(lds + RING_OFF, g, S, E);
            SEAM(pb + 7);
        }
    }
    if (IN(PH_FINAL)) {
        const float* fw = (const float*)args.in[IN_FNW];
        for (int m = gw; m < M; m += NGW) {
            const GAS f32x4* pp = (const GAS f32x4*)(partA + (size_t)m * 16);
            const f32x4 p0 = pp[0], p1 = pp[1], p2 = pp[2], p3 = pp[3];
            const float ss = ((p0.x + p0.y) + (p0.z + p0.w)) + ((p1.x + p1.y) + (p1.z + p1.w)) + ((p2.x + p2.y) + (p2.z + p2.w)) + ((p3.x + p3.y) + (p3.z + p3.w));
            const float rs = 1.0f / sqrtf(ss * (1.0f / 1024.0f) + EPS);
            GAS f32x4* hr = (GAS f32x4*)(hres + (size_t)m * DM) + lane; const GAS f32x4* wr4 = (const GAS f32x4*)fw + lane;
#pragma unroll
            for (int j = 0; j < 4; ++j) { f32x4 v = hr[64 * j]; const f32x4 w = wr4[64 * j]; v = v * rs * w; hr[64 * j] = v; }
        }
    }
#undef IN
#undef SEAM
}

__device__ __forceinline__ bf16 f2bf16(float f) { return (bf16)f2bf(f); }

__global__ void __launch_bounds__(128) hgrn_naive(const bf16* __restrict__ proj, const float* __restrict__ lb_logits, const float* __restrict__ norm_w, int layer, bf16* __restrict__ mixed) {
    const int b = blockIdx.x >> 2, hh = blockIdx.x & 3, v = threadIdx.x, lane = v & 63, wv = v >> 6;
    __shared__ float sf[128], sk[128], sq[128], red[2];
    const int c = hh * 128 + v;
    float lb;
    { float lg[4], mx = -INFINITY, sm = 0.f;
      for (int i = 0; i < 4; ++i) { lg[i] = lb_logits[i * 512 + c]; mx = fmaxf(mx, lg[i]); }
      for (int i = 0; i < 4; ++i) { lg[i] = expf(lg[i] - mx); sm += lg[i]; }
      lb = 0.f; for (int i = 1; i < 4; ++i) if (i <= layer) lb += lg[i] / sm; }
    const float nw = norm_w[layer * 128 + v];
    float S[128];
#pragma unroll
    for (int k = 0; k < 128; ++k) S[k] = 0.f;
    for (int t = 0; t < SEQ; ++t) {
        const size_t m = (size_t)b * SEQ + t; const bf16* row = proj + m * NINP;
        const float qv = bf2f(row[PC_HQ + c]) * 0.08838834764831845f, fp = bf2f(row[PC_HF + c]), iv = bf2f(row[PC_HI + c]), gv = bf2f(row[PC_HG + c]);
        const float sg = 1.0f / (1.0f + expf(-fp)), sgn = 1.0f / (1.0f + expf(fp));
        sf[v] = lb + (1.0f - lb) * sg; sk[v] = (1.0f - lb) * sgn; sq[v] = qv;
        __syncthreads();
        float o = 0.f;
#pragma unroll
        for (int k = 0; k < 128; ++k) { S[k] = sf[k] * S[k] + sk[k] * iv; o += sq[k] * S[k]; }
        float s2 = o * o;
#pragma unroll
        for (int off = 32; off >= 1; off >>= 1) s2 += __shfl_xor(s2, off);
        if (lane == 0) red[wv] = s2;
        __syncthreads();
        const float rs = 1.0f / sqrtf((red[0] + red[1]) * (1.0f / 128.0f) + EPS);
        const float y = o * rs * nw * (gv / (1.0f + expf(-gv)));
        mixed[m * DM + c] = f2bf16(y);
        __syncthreads();
    }
}

__global__ void __launch_bounds__(128) mla_prep_naive(const bf16* __restrict__ proj, const bf16* __restrict__ wqb_t, const bf16* __restrict__ wkvb_t, const float* __restrict__ cs, const float* __restrict__ sn,
                                                        bf16* __restrict__ Q, bf16* __restrict__ K, bf16* __restrict__ VT) {
    const int m = blockIdx.x, tid = threadIdx.x, b = m / SEQ, t = m % SEQ;
    __shared__ float qa[192], ckv[128], kpe[32], qout[384], red[2][2];
    const bf16* row = proj + (size_t)m * NINP;
    for (int k = tid; k < 192; k += 128) qa[k] = bf2f(row[PC_MQA + k]);
    ckv[tid] = bf2f(row[PC_MKVA + tid]);
    if (tid < 32) kpe[tid] = bf2f(row[PC_MKVA + 128 + tid]);
    __syncthreads();
    float s1 = 0.f; for (int k = tid; k < 192; k += 128) s1 += qa[k] * qa[k];
    float s2 = ckv[tid] * ckv[tid];
    for (int off = 32; off >= 1; off >>= 1) { s1 += __shfl_xor(s1, off); s2 += __shfl_xor(s2, off); }
    if ((tid & 63) == 0) { red[tid >> 6][0] = s1; red[tid >> 6][1] = s2; }
    __syncthreads();
    const float rq = 1.0f / sqrtf((red[0][0] + red[1][0]) * (1.0f / 192.0f) + EPS), rkv = 1.0f / sqrtf((red[0][1] + red[1][1]) * (1.0f / 128.0f) + EPS);
    for (int n = tid; n < 384; n += 128) { float a = 0.f; const bf16* w = wqb_t + (size_t)n * 192; for (int k = 0; k < 192; ++k) a += qa[k] * bf2f(w[k]); qout[n] = a * rq; }
    __syncthreads();
    for (int n = tid; n < 384; n += 128) {
        const int hh = n / 96, j = n % 96; float val;
        if (j < 64) val = qout[n];
        else { const int i = (j - 64) & 15, part = (j - 64) >> 4; const float x1 = qout[hh * 96 + 64 + i], x2 = qout[hh * 96 + 80 + i], c = cs[(size_t)m * 16 + i], s = sn[(size_t)m * 16 + i];
               val = part == 0 ? x1 * c - x2 * s : x2 * c + x1 * s; }
        Q[(size_t)m * 384 + n] = f2bf16(val * QSCALE);
    }
    for (int n = tid; n < 512; n += 128) {
        float a = 0.f; const bf16* w = wkvb_t + (size_t)n * 128; for (int k = 0; k < 128; ++k) a += ckv[k] * bf2f(w[k]); a *= rkv;
        const int hh = n >> 7, j = n & 127;
        if (j < 64) K[(size_t)m * 384 + hh * 96 + j] = f2bf16(a); else VT[((size_t)(b * 4 + hh) * 64 + (j - 64)) * SEQ + t] = f2bf16(a);
    }
    if (tid < 32) {
        const int i = tid & 15, part = tid >> 4; const float x1 = kpe[i], x2 = kpe[16 + i], c = cs[(size_t)m * 16 + i], s = sn[(size_t)m * 16 + i];
        const float val = part == 0 ? x1 * c - x2 * s : x2 * c + x1 * s;
        for (int hh = 0; hh < 4; ++hh) K[(size_t)m * 384 + hh * 96 + 64 + tid] = f2bf16(val);
    }
}

__global__ void __launch_bounds__(256) mla_attn_naive(const bf16* __restrict__ Q, const bf16* __restrict__ K, const bf16* __restrict__ VT, bf16* __restrict__ mixed) {
    const int lane = threadIdx.x & 63, gwv = blockIdx.x * 4 + (threadIdx.x >> 6);
    const int m = gwv >> 2, hh = gwv & 3, b = m / SEQ, t = m % SEQ;
    float q[96];
    { const bf16* qp = Q + (size_t)m * 384 + hh * 96;
#pragma unroll
      for (int d = 0; d < 96; ++d) q[d] = bf2f(qp[d]); }
    float o[64];
#pragma unroll
    for (int d = 0; d < 64; ++d) o[d] = 0.f;
    float mx = -INFINITY, l = 0.f;
    const bf16* vt = VT + (size_t)(b * 4 + hh) * 64 * SEQ;
    for (int j = lane; j <= t; j += 64) {
        const bf16* kr = K + ((size_t)b * SEQ + j) * 384 + hh * 96;
        float s = 0.f;
#pragma unroll
        for (int d8 = 0; d8 < 12; ++d8) { const v4u kk = *(const v4u*)(kr + d8 * 8);
            s += q[d8 * 8 + 0] * __uint_as_float(kk.x << 16) + q[d8 * 8 + 1] * __uint_as_float(kk.x & 0xffff0000u) + q[d8 * 8 + 2] * __uint_as_float(kk.y << 16) + q[d8 * 8 + 3] * __uint_as_float(kk.y & 0xffff0000u)
               + q[d8 * 8 + 4] * __uint_as_float(kk.z << 16) + q[d8 * 8 + 5] * __uint_as_float(kk.z & 0xffff0000u) + q[d8 * 8 + 6] * __uint_as_float(kk.w << 16) + q[d8 * 8 + 7] * __uint_as_float(kk.w & 0xffff0000u); }
        const float mn = fmaxf(mx, s), sc = exp2f(mx - mn), p = exp2f(s - mn);
        l = l * sc + p; mx = mn;
#pragma unroll
        for (int d = 0; d < 64; ++d) o[d] = o[d] * sc + p * bf2f(vt[(size_t)d * SEQ + j]);
    }
    float Mx = mx;
#pragma unroll
    for (int off = 32; off >= 1; off >>= 1) Mx = fmaxf(Mx, __shfl_xor(Mx, off));
    const float f = (mx == -INFINITY) ? 0.f : exp2f(mx - Mx);
    float lt = l * f;
#pragma unroll
    for (int off = 32; off >= 1; off >>= 1) lt += __shfl_xor(lt, off);
    float mine = 0.f;
#pragma unroll
    for (int d = 0; d < 64; ++d) { float v = o[d] * f;
#pragma unroll
        for (int off = 32; off >= 1; off >>= 1) v += __shfl_xor(v, off);
        if (lane == d) mine = v; }
    mixed[(size_t)m * DM + 512 + hh * 64 + lane] = f2bf16(mine / lt);
}

__global__ void __launch_bounds__(256) dsa_prep_naive(const bf16* __restrict__ proj, const float* __restrict__ lnw, const float* __restrict__ lnb, bf16* __restrict__ KI, float* __restrict__ WI) {
    const int lane = threadIdx.x & 63, m = blockIdx.x * 4 + (threadIdx.x >> 6);
    const bf16* row = proj + (size_t)m * NINP;
    const float x = bf2f(row[PC_IK + lane]);
    const float mu = wave_sum(x) * (1.0f / 64.0f), dx = x - mu, var = wave_sum(dx * dx) * (1.0f / 64.0f);
    KI[(size_t)m * 64 + lane] = f2bf16(dx * (1.0f / sqrtf(var + EPS)) * lnw[lane] + lnb[lane]);
    if (lane < 8) WI[(size_t)m * 8 + lane] = bf2f(row[PC_IW + lane]) * (0.35355339059327373f * 0.125f);
}

__device__ __forceinline__ unsigned mono_key(float s) { const unsigned u = __float_as_uint(s + 0.0f); return (u & 0x80000000u) ? ~u : (u | 0x80000000u); }

__global__ void __launch_bounds__(256) dsa_select_naive(const bf16* __restrict__ proj, const bf16* __restrict__ KI, const float* __restrict__ WI, unsigned* __restrict__ mask) {
    const int m = blockIdx.x, tid = threadIdx.x, lane = tid & 63, wv = tid >> 6, b = m / SEQ, t = m % SEQ, N = t + 1;
    __shared__ float iq[512]; __shared__ float wi[8]; __shared__ unsigned keys[SEQ]; __shared__ unsigned red[4];
    for (int i = tid; i < 512; i += 256) iq[i] = bf2f(proj[(size_t)m * NINP + PC_IQ + i]);
    if (tid < 8) wi[tid] = WI[(size_t)m * 8 + tid];
    __syncthreads();
    for (int j = tid; j < N; j += 256) {
        const bf16* kr = KI + ((size_t)b * SEQ + j) * 64; float kf[64];
#pragma unroll
        for (int d8 = 0; d8 < 8; ++d8) { const v4u kk = *(const v4u*)(kr + d8 * 8);
            kf[d8 * 8 + 0] = __uint_as_float(kk.x << 16); kf[d8 * 8 + 1] = __uint_as_float(kk.x & 0xffff0000u); kf[d8 * 8 + 2] = __uint_as_float(kk.y << 16); kf[d8 * 8 + 3] = __uint_as_float(kk.y & 0xffff0000u);
            kf[d8 * 8 + 4] = __uint_as_float(kk.z << 16); kf[d8 * 8 + 5] = __uint_as_float(kk.z & 0xffff0000u); kf[d8 * 8 + 6] = __uint_as_float(kk.w << 16); kf[d8 * 8 + 7] = __uint_as_float(kk.w & 0xffff0000u); }
        float sc = 0.f;
#pragma unroll
        for (int h = 0; h < 8; ++h) { float dsum = 0.f;
#pragma unroll
            for (int d = 0; d < 64; ++d) dsum += iq[h * 64 + d] * kf[d];
            sc += fmaxf(dsum, 0.f) * wi[h]; }
        keys[j] = mono_key(sc);
    }
    __syncthreads();
    unsigned T = 0u; int need = 256;
    const bool all = (N <= 256);
    if (!all) {
        for (int bit = 31; bit >= 0; --bit) {
            const unsigned cand = T | (1u << bit); unsigned cnt = 0;
            for (int j = tid; j < N; j += 256) cnt += (keys[j] >= cand) ? 1u : 0u;
#pragma unroll
            for (int off = 32; off >= 1; off >>= 1) cnt += __shfl_xor(cnt, off);
            if (lane == 0) red[wv] = cnt;
            __syncthreads();
            const unsigned tot = red[0] + red[1] + red[2] + red[3];
            __syncthreads();
            if (tot >= 256u) T = cand;
        }
        unsigned cnt = 0;
        for (int j = tid; j < N; j += 256) cnt += (keys[j] > T) ? 1u : 0u;
#pragma unroll
        for (int off = 32; off >= 1; off >>= 1) cnt += __shfl_xor(cnt, off);
        if (lane == 0) red[wv] = cnt;
        __syncthreads();
        need = 256 - (int)(red[0] + red[1] + red[2] + red[3]);
        __syncthreads();
    }
    int base = 0;
    for (int it = 0; it < SEQ / 256; ++it) {
        const int j = it * 256 + tid; const bool inr = j < N; const unsigned k = inr ? keys[j] : 0u;
        const bool eq = !all && inr && (k == T);
        const unsigned long long eb = __ballot(eq);
        if (lane == 0) red[wv] = (unsigned)__popcll(eb);
        __syncthreads();
        int pre = 0; for (int w = 0; w < wv; ++w) pre += (int)red[w];
        const int tot = (int)(red[0] + red[1] + red[2] + red[3]);
        const int rank = base + pre + (int)__popcll(eb & ((1ull << lane) - 1ull));
        const bool sel = inr && (all || k > T || (eq && rank < need));
        const unsigned long long sb = __ballot(sel);
        if (lane == 0) { mask[(size_t)m * 128 + (j >> 5)] = (unsigned)sb; mask[(size_t)m * 128 + (j >> 5) + 1] = (unsigned)(sb >> 32); }
        base += tot;
        __syncthreads();
    }
}

__device__ __forceinline__ int t5_bucket(int dist) {
    const int n = dist > 0 ? dist : 0;
    if (n < 16) return n;
    int lg = 16 + (int)(logf((float)n / 16.0f) / 2.0794415416798357f * 16.0f);
    return lg < 31 ? lg : 31;
}

__global__ void __launch_bounds__(256) dsa_attn_naive(const bf16* __restrict__ proj, const unsigned* __restrict__ mask, const int* __restrict__ pos, const float* __restrict__ rel, bf16* __restrict__ mixed) {
    const int m = blockIdx.x, tid = threadIdx.x, lane = tid & 63, wv = tid >> 6, b = m / SEQ;
    __shared__ int list[256]; __shared__ float dq[256]; __shared__ float p[256][4]; __shared__ float redm[4][4]; __shared__ int cnts[128]; __shared__ int nsel_s;
    unsigned w = tid < 128 ? mask[(size_t)m * 128 + tid] : 0u;
    if (tid < 128) cnts[tid] = __popc(w);
    dq[tid] = bf2f(proj[(size_t)m * NINP + PC_DQ + tid]);
    __syncthreads();
    if (tid == 0) { int a = 0; for (int i = 0; i < 128; ++i) { const int c = cnts[i]; cnts[i] = a; a += c; } nsel_s = a; }
    __syncthreads();
    if (tid < 128) { int off = cnts[tid]; while (w) { const int bit = __ffs(w) - 1; if (off < 256) list[off] = tid * 32 + bit; ++off; w &= w - 1u; } }
    __syncthreads();
    const int nsel = nsel_s < 256 ? nsel_s : 256;
    float lg[4] = {-INFINITY, -INFINITY, -INFINITY, -INFINITY};
    if (tid < nsel) {
        const int j = list[tid]; const bf16* kr = proj + ((size_t)b * SEQ + j) * NINP + PC_DK;
        const int bk = t5_bucket(pos[m] - pos[b * SEQ + j]);
#pragma unroll
        for (int h = 0; h < 4; ++h) { float a = 0.f;
            for (int d = 0; d < 64; ++d) a += dq[h * 64 + d] * bf2f(kr[h * 64 + d]);
            lg[h] = a * 0.125f + rel[bk * 4 + h]; }
    }
    float mxh[4], smh[4];
#pragma unroll
    for (int h = 0; h < 4; ++h) { float v = lg[h];
#pragma unroll
        for (int off = 32; off >= 1; off >>= 1) v = fmaxf(v, __shfl_xor(v, off));
        if (lane == 0) redm[wv][h] = v; }
    __syncthreads();
#pragma unroll
    for (int h = 0; h < 4; ++h) mxh[h] = fmaxf(fmaxf(redm[0][h], redm[1][h]), fmaxf(redm[2][h], redm[3][h]));
    __syncthreads();
    float pe[4];
#pragma unroll
    for (int h = 0; h < 4; ++h) { pe[h] = (tid < nsel) ? expf(lg[h] - mxh[h]) : 0.f; p[tid][h] = pe[h]; float v = pe[h];
#pragma unroll
        for (int off = 32; off >= 1; off >>= 1) v += __shfl_xor(v, off);
        if (lane == 0) redm[wv][h] = v; }
    __syncthreads();
#pragma unroll
    for (int h = 0; h < 4; ++h) smh[h] = (redm[0][h] + redm[1][h]) + (redm[2][h] + redm[3][h]);
    const int hh = tid >> 6;
    float acc = 0.f;
    for (int i = 0; i < nsel; ++i) acc += p[i][hh] * bf2f(proj[((size_t)b * SEQ + list[i]) * NINP + PC_DV + tid]);
    const float den = hh == 0 ? smh[0] : hh == 1 ? smh[1] : hh == 2 ? smh[2] : smh[3];
    mixed[(size_t)m * DM + 768 + tid] = f2bf16(acc / den);
}

extern "C" void kernel_launch(void* const* d_in, const int* in_sizes, int n_in, void* d_out, int out_size, void* d_ws, size_t ws_size, hipStream_t stream) {
    static int grid = 0;
    if (grid == 0) {
        if (n_in != 18 || in_sizes[0] != M * DM || out_size != M * DM || ws_size < WS_END) { fprintf(stderr, "kernel_launch: unexpected shapes (n_in %d, in0 %d, out %d, ws %zu); nothing launched\n", n_in, n_in > 0 ? in_sizes[0] : -1, out_size, ws_size); grid = -1; return; }
        int dev = 0, cus = 0, per_cu = 0;
        if (hipGetDevice(&dev) != hipSuccess || hipDeviceGetAttribute(&cus, hipDeviceAttributeMultiprocessorCount, dev) != hipSuccess) { grid = -1; return; }
        if (hipFuncSetAttribute((const void*)fwd, hipFuncAttributeMaxDynamicSharedMemorySize, LDS_BYTES) != hipSuccess) { fprintf(stderr, "kernel_launch: hipFuncSetAttribute failed\n"); grid = -1; return; }
        if (hipOccupancyMaxActiveBlocksPerMultiprocessor(&per_cu, (const void*)fwd, NWAVES * 64, LDS_BYTES) != hipSuccess || per_cu < 1) fprintf(stderr, "kernel_launch: occupancy query reports %d\n", per_cu);
        (void)hipGetLastError();
        grid = cus;
    }
    if (grid < 0) return;
    if (hipMemsetAsync((char*)d_ws + WS_CTL, 0, CTL_ZERO_BYTES, stream) != hipSuccess) return;
    Args a{};
    for (int i = 0; i < 18; ++i) a.in[i] = d_in[i];
    a.out = (float*)d_out; a.ws = (unsigned char*)d_ws; a.pad = 0;
    unsigned char* ws = (unsigned char*)d_ws;
    int region = 0;
    auto launch = [&](int lo, int hi) { a.p_lo = lo; a.p_hi = hi; a.bar_region = region++; hipLaunchKernelGGL(fwd, dim3(grid), dim3(NWAVES * 64), LDS_BYTES, stream, a); };
    launch(0, 1);
    for (int l = 0; l < DEPTH; ++l) {
        const int pb = 1 + PH_PER_LAYER * l;
        launch(pb, pb + 2);
        const bf16* proj = (const bf16*)(ws + WS_PROJ);
        unsigned char* sb = ws + WS_WSLOT + (size_t)(l & 1) * WSLOT_BYTES;
        unsigned char* bufIn = ws + ((l & 1) ? WS_Y : WS_X); bf16* mixed = (bf16*)(ws + ((l & 1) ? WS_X : WS_Y));
        bf16* Q = (bf16*)(bufIn + MLA_Q); bf16* K = (bf16*)(bufIn + MLA_K); bf16* VT = (bf16*)(bufIn + MLA_VT);
        hipLaunchKernelGGL(hgrn_naive, dim3(NB * 4), dim3(128), 0, stream, proj, (const float*)d_in[IN_LB], (const float*)d_in[IN_HNW], l, mixed);
        hipLaunchKernelGGL(mla_prep_naive, dim3(M), dim3(128), 0, stream, proj, (const bf16*)(sb + WO_QB), (const bf16*)(sb + WO_KVB), (const float*)(ws + WS_COS), (const float*)(ws + WS_SIN), Q, K, VT);
        hipLaunchKernelGGL(mla_attn_naive, dim3(M), dim3(256), 0, stream, (const bf16*)Q, (const bf16*)K, (const bf16*)VT, mixed);
        hipLaunchKernelGGL(dsa_prep_naive, dim3(M / 4), dim3(256), 0, stream, proj, (const float*)d_in[IN_IKW] + l * 64, (const float*)d_in[IN_IKB] + l * 64, (bf16*)(ws + WS_KI), (float*)(ws + WS_WI));
        hipLaunchKernelGGL(dsa_select_naive, dim3(M), dim3(256), 0, stream, proj, (const bf16*)(ws + WS_KI), (const float*)(ws + WS_WI), (unsigned*)(ws + WS_MASK));
        hipLaunchKernelGGL(dsa_attn_naive, dim3(M), dim3(256), 0, stream, proj, (const unsigned*)(ws + WS_MASK), (const int*)d_in[IN_POS], (const float*)d_in[IN_REL], mixed);
        launch(pb + 5, l == DEPTH - 1 ? PH_COUNT : pb + 8);
    }
}
```

```cpp
#include <hip/hip_runtime.h>
#include <hip/hip_bf16.h>
#include <cstdio>
#include <cstdint>
#include <cmath>
constexpr int NB = 8, SEQ = 4096, DM = 1024, DEPTH = 4, M = NB * SEQ;
constexpr int NINP = 3840, DFF = 4096;
constexpr int PC_HQ = 0, PC_HF = 512, PC_HI = 1024, PC_HG = 1536, PC_MQA = 2048, PC_MKVA = 2304, PC_IK = 2304 + 160, PC_IW = 2304 + 224, PC_DQ = 2560, PC_DK = 2816, PC_DV = 3072, PC_IQ = 3328;
constexpr int NIN_SRC = 3752;
constexpr float EPS = 1e-6f;
constexpr float QSCALE = 0.10206207261596577f * 1.4426950408889634f;
namespace pg8 {
#define PG8_LAS __attribute__((address_space(3)))
typedef unsigned short bf16_t;
typedef short bf16x8 __attribute__((ext_vector_type(8)));
typedef float f32x4 __attribute__((ext_vector_type(4)));
typedef unsigned u32x4 __attribute__((ext_vector_type(4)));
constexpr int BM = 256, BK = 64, HALF = 128, HTB = HALF * BK * 2  , STAGE_BYTES = 8 * HTB, NXCD = 8, WGM = 8;

__host__ __device__ __forceinline__ int lds_byte(int r, int c) { const int st = (r >> 4) * 2 + (c >> 5), rr = r & 15, cc = c & 31, ob = rr * 64 + cc * 2; return st * 1024 + (ob ^ (((ob >> 9) & 1) << 5)); }
__host__ __device__ __forceinline__ void stage_rc(int b, int& R, int& C) { const int st = b / 1024, sb = b % 1024, swz = sb ^ (((sb >> 9) & 1) << 5); R = (st >> 1) * 16 + swz / 64; C = (st & 1) * 32 + (swz % 64) / 2; }
__host__ __device__ __forceinline__ int perm32(int rho) { const int n = rho >> 4, i = rho & 15; return 8 * (i >> 2) + 4 * n + (i & 3); }

struct Unit { int pm, pn; };
struct Gemm { const bf16_t* A; const bf16_t* Bt; int M, N, K; int ablk = 0, bblk = 0; };

struct StaticOrder {
    int nM, nN, nwg, G, c; int rev = 0;
    __host__ __device__ void init(int M, int N, int G_, int c_) { nM = M / BM; nN = N / BM; nwg = nM * nN; G = G_; c = c_; }
    __host__ __device__ bool next(int i, Unit& u) const {
        if (rev) { const int nr = nwg / G; if (i >= nr) return false; i = nr - 1 - i; }
        const long L = (long)i * G + c; if (L >= nwg) return false;
        int wgid = (int)L; { const int q = nwg / NXCD, r = nwg % NXCD, xcd = wgid % NXCD, off = wgid / NXCD; wgid = (xcd < r ? xcd * (q + 1) : r * (q + 1) + (xcd - r) * q) + off; }
        const int nig = WGM * nN, gid = wgid / nig, fm = gid * WGM, gsz = (nM - fm) < WGM ? (nM - fm) : WGM;
        u.pm = fm + ((wgid % nig) % gsz); u.pn = (wgid % nig) / gsz; return true;
    }
    __device__ __forceinline__ void a_ready(const Unit&) const {}
    __device__ __forceinline__ void done(const Unit&) const {}
};

__device__ __forceinline__ unsigned cvt_pk_bf16(float lo, float hi) { unsigned r; asm volatile("v_cvt_pk_bf16_f32 %0, %1, %2" : "=v"(r) : "v"(lo), "v"(hi)); return r; }
typedef float f32x2 __attribute__((ext_vector_type(2)));
__device__ __forceinline__ f32x2 gelu_pk(f32x2 v) {
    const f32x2 av = __builtin_elementwise_abs(v), d = av * 0.2316418882f + 1.0f;
    f32x2 t; t.x = __builtin_amdgcn_rcpf(d.x); t.y = __builtin_amdgcn_rcpf(d.y);
    f32x2 q = t * 0.5307027145f + (-0.7265760135f); q = q * t + 0.7107068705f; q = q * t + (-0.142248368f); q = q * t + 0.127414796f; q = q * t;
    const f32x2 s = (v * v) * (-0.72134752044f);
    f32x2 e; e.x = __builtin_amdgcn_exp2f(s.x); e.y = __builtin_amdgcn_exp2f(s.y);
    const f32x2 m = v * (q * e), r = v - m;
    f32x2 o; o.x = v.x < 0.f ? m.x : r.x; o.y = v.y < 0.f ? m.y : r.y; return o;
}

template <int ACT  > struct EpiBf16 {
    static constexpr bool PERM = true, AFTER_DRAIN = false; static_assert(ACT == 0 || ACT == 1, "EpiBf16: ACT is 0 (none) or 1 (gelu_pk)");
    bf16_t* O; int ldc; const float* bias; int split_cols; size_t split_stride; float scale0;
    __device__ __forceinline__ void operator()(const f32x4 (&acc)[2][2][4][2], const Unit& u, int wr, int wc, int fr, int fq) const {
        const int row0 = u.pm * BM + wr * 64 + fr; int colt = u.pn * BM; bf16_t* base = O;
        float sc = 1.f; if (split_cols) { const int t = colt / split_cols; base += (size_t)t * split_stride; colt -= t * split_cols; if (t == 0) sc = scale0; }
        const int col0 = colt + wc * 32 + 8 * fq, bcol0 = u.pn * BM + wc * 32 + 8 * fq;
        f32x4 bv[2][2];
#pragma unroll
        for (int bj = 0; bj < 2; ++bj)
#pragma unroll
            for (int n = 0; n < 2; ++n) bv[bj][n] = bias ? *(const f32x4*)(bias + bcol0 + bj * HALF + 4 * n) : (f32x4){0.f, 0.f, 0.f, 0.f};
#pragma unroll
        for (int ai = 0; ai < 2; ++ai)
#pragma unroll
            for (int m = 0; m < 4; ++m) { bf16_t* rowp = base + (size_t)(row0 + ai * HALF + m * 16) * ldc + col0;
#pragma unroll
                for (int bj = 0; bj < 2; ++bj) { f32x4 v0 = acc[ai][bj][m][0] + bv[bj][0], v1 = acc[ai][bj][m][1] + bv[bj][1];
                    if (ACT == 1) { f32x2 a = gelu_pk((f32x2){v0[0], v0[1]}), b = gelu_pk((f32x2){v0[2], v0[3]}), c = gelu_pk((f32x2){v1[0], v1[1]}), d = gelu_pk((f32x2){v1[2], v1[3]});
                        v0 = (f32x4){a.x, a.y, b.x, b.y}; v1 = (f32x4){c.x, c.y, d.x, d.y}; }
                    v0 = v0 * sc; v1 = v1 * sc; u32x4 w; w.x = cvt_pk_bf16(v0[0], v0[1]); w.y = cvt_pk_bf16(v0[2], v0[3]); w.z = cvt_pk_bf16(v1[0], v1[1]); w.w = cvt_pk_bf16(v1[2], v1[3]);
                    *(u32x4*)(rowp + bj * HALF) = w; } }
    }
};
#ifndef REP_EPI
#define REP_EPI 1
#endif
template <int ACT  > struct EpiScale {
    static constexpr bool PERM = true, AFTER_DRAIN = false; static constexpr int REPS = REP_EPI;
    bf16_t* O; int ldc; const float* part; int blk = 0;
    mutable int cpm = -1; mutable float crs[8];
    __device__ __forceinline__ void operator()(const f32x4 (&acc)[2][2][4][2], const Unit& u, int wr, int wc, int fr, int fq) const {
        const int row0 = u.pm * BM + wr * 64 + fr, col0 = u.pn * BM + wc * 64 + 8 * fq;
        if (u.pm != cpm) {
            cpm = u.pm;
#pragma unroll
            for (int ai = 0; ai < 2; ++ai)
#pragma unroll
                for (int m = 0; m < 4; ++m) {
                    const f32x4* pp = (const f32x4*)(part + (size_t)(row0 + ai * HALF + m * 16) * 16);
                    const f32x4 p0 = pp[0], p1 = pp[1], p2 = pp[2], p3 = pp[3];
                    const float ss = ((p0[0] + p0[1]) + (p0[2] + p0[3])) + ((p1[0] + p1[1]) + (p1[2] + p1[3])) + ((p2[0] + p2[1]) + (p2[2] + p2[3])) + ((p3[0] + p3[1]) + (p3[2] + p3[3]));
                    crs[ai * 4 + m] = __builtin_amdgcn_rsqf(ss * (1.0f / 1024.0f) + 1e-6f);
                }
        }
#pragma unroll
        for (int ai = 0; ai < 2; ++ai)
#pragma unroll
            for (int m = 0; m < 4; ++m) {
                const int row = row0 + ai * HALF + m * 16;
                const float rs = crs[ai * 4 + m];
                bf16_t* rowp = blk ? O + (size_t)(row >> 8) * ((size_t)256 * ldc) + (size_t)(col0 >> 6) * (256 * 64) + (row & 255) * 64 + (col0 & 63) : O + (size_t)row * ldc + col0;
#pragma unroll
                for (int bj = 0; bj < 2; ++bj) {
                    f32x4 v0 = acc[ai][bj][m][0] * rs, v1 = acc[ai][bj][m][1] * rs;
                    if (ACT == 1) {
#pragma unroll
                        for (int e = 0; e < 4; ++e) { const float a = fmaxf(v0[e], 0.f), b = fmaxf(v1[e], 0.f); v0[e] = a * a; v1[e] = b * b; }
                    }
                    u32x4 w; w.x = cvt_pk_bf16(v0[0], v0[1]); w.y = cvt_pk_bf16(v0[2], v0[3]); w.z = cvt_pk_bf16(v1[0], v1[1]); w.w = cvt_pk_bf16(v1[2], v1[3]);
#ifndef EPI_NT
#define EPI_NT 0
#endif
                    if (EPI_NT == 2) { asm volatile("global_store_dwordx4 %0, %1, off sc1\n\ts_nop 1" :: "v"((const __attribute__((address_space(1))) void*)(rowp + bj * 32)), "v"(w) : "memory"); } else if (EPI_NT) __builtin_nontemporal_store(w, (u32x4*)(rowp + bj * 32)); else *(u32x4*)(rowp + bj * 32) = w;
                }
            }
    }
};
struct EpiRes {
    static constexpr bool PERM = true, AFTER_DRAIN = false; static constexpr int REPS = 1;
    bf16_t* hb; float* part_out; bf16_t* hbw = nullptr;
    __device__ __forceinline__ void operator()(const f32x4 (&acc)[2][2][4][2], const Unit& u, int wr, int wc, int fr, int fq) const {
        const int row0 = u.pm * BM + wr * 64 + fr, col0 = u.pn * BM + wc * 64 + 8 * fq;
        u32x4 oldv[8][2];
#define EPIRES_LD(k) do { _Pragma("unroll") for (int bj = 0; bj < 2; ++bj) oldv[k][bj] = *(const u32x4*)(hb + (size_t)(row0 + ((k) >> 2) * HALF + ((k) & 3) * 16) * 1024 + col0 + bj * 32); } while (0)
        EPIRES_LD(0); EPIRES_LD(1); EPIRES_LD(2); EPIRES_LD(3); EPIRES_LD(4); EPIRES_LD(5);
#pragma unroll
        for (int ai = 0; ai < 2; ++ai) {
#pragma unroll
            for (int m = 0; m < 4; ++m) {
                if (ai == 0 && m == 2) { EPIRES_LD(6); EPIRES_LD(7); }
                const int row = row0 + ai * HALF + m * 16;
                float ssq = 0.f;
#pragma unroll
                for (int bj = 0; bj < 2; ++bj) {
                    const u32x4 o = oldv[ai * 4 + m][bj];
                    f32x4 h0, h1;
                    h0[0] = __builtin_bit_cast(float, o.x << 16) + acc[ai][bj][m][0][0]; h0[1] = __builtin_bit_cast(float, o.x & 0xffff0000u) + acc[ai][bj][m][0][1];
                    h0[2] = __builtin_bit_cast(float, o.y << 16) + acc[ai][bj][m][0][2]; h0[3] = __builtin_bit_cast(float, o.y & 0xffff0000u) + acc[ai][bj][m][0][3];
                    h1[0] = __builtin_bit_cast(float, o.z << 16) + acc[ai][bj][m][1][0]; h1[1] = __builtin_bit_cast(float, o.z & 0xffff0000u) + acc[ai][bj][m][1][1];
                    h1[2] = __builtin_bit_cast(float, o.w << 16) + acc[ai][bj][m][1][2]; h1[3] = __builtin_bit_cast(float, o.w & 0xffff0000u) + acc[ai][bj][m][1][3];
                    ssq += (h0[0] * h0[0] + h0[1] * h0[1]) + (h0[2] * h0[2] + h0[3] * h0[3]) + (h1[0] * h1[0] + h1[1] * h1[1]) + (h1[2] * h1[2] + h1[3] * h1[3]);
                    u32x4 w; w.x = cvt_pk_bf16(h0[0], h0[1]); w.y = cvt_pk_bf16(h0[2], h0[3]); w.z = cvt_pk_bf16(h1[0], h1[1]); w.w = cvt_pk_bf16(h1[2], h1[3]);
                    *(u32x4*)((hbw ? hbw : hb) + (size_t)row * 1024 + col0 + bj * 32) = w;
                }
                ssq += __shfl_xor(ssq, 16); ssq += __shfl_xor(ssq, 32);
                if (fq == 0) part_out[(size_t)row * 16 + u.pn * 4 + wc] = ssq;
            }
        }
    }
};
template <class Epi, class Sched, bool ALIGN_EPI = false, bool SP2 = false>
__device__ __forceinline__ void gemm_phase(PG8_LAS unsigned char* lds, const Gemm g, const Sched& S, const Epi& E) {
    int tid_o = threadIdx.x; asm volatile("" : "+v"(tid_o));
    const int tid = tid_o, wid = __builtin_amdgcn_readfirstlane(tid >> 6), lane = tid & 63, wr = wid >> 2, wc = wid & 3, fr = lane & 15, fq = lane >> 4;
    const int K = g.K, nt = K / BK;
    unsigned voffA[2], voffB[2];
#pragma unroll
    for (int i = 0; i < 2; ++i) { int R, C; stage_rc(tid * 16 + i * 8192, R, C); const int Rb = Epi::PERM ? (2 * (R & ~31) + perm32(R & 31)) : R;
        voffA[i] = (unsigned)(R * (g.ablk ? BK : K) + C) * 2u; voffB[i] = (unsigned)(Rb * (g.bblk ? BK : K) + C) * 2u; }
    const size_t kstep = (size_t)(BK * 2);
    const size_t hstep = (size_t)HALF * K * 2;
    const size_t kstepB = g.bblk ? (size_t)BM * BK * 2 : kstep;
    const size_t hstepB = (Epi::PERM ? (size_t)32 : (size_t)HALF) * (g.bblk ? BK : K) * 2;
    const size_t hstepA = g.ablk ? (size_t)HALF * BK * 2 : hstep, kstepA = g.ablk ? (size_t)BM * BK * 2 : kstep;
    const size_t tstep = 2 * hstep;
    const unsigned ldsw = (unsigned)wid * 1024u;
    const int aoff = lds_byte(wr * 64 + fr, fq * 8), boff = lds_byte(wc * 32 + fr, fq * 8);
#define PG8_SA(b, h) (((b) * 2 + (h)) * HTB)
#define PG8_SB(b, h) ((4 + (b) * 2 + (h)) * HTB)
#define PG8_STAGE(bufoff, gbase, voff) do { _Pragma("unroll") for (int _i = 0; _i < 2; ++_i) \
        __builtin_amdgcn_global_load_lds((const unsigned*)((const char*)(gbase) + (voff)[_i]), (PG8_LAS unsigned*)(lds + (bufoff) + ldsw + _i * 8192), 16, 0, 0); } while (0)
#define PG8_LDA(dst, b, h) do { _Pragma("unroll") for (int m = 0; m < 4; ++m) _Pragma("unroll") for (int k = 0; k < 2; ++k) dst[m][k] = *(const PG8_LAS bf16x8*)(lds + PG8_SA(b, h) + aoff + m * 2048 + k * 1024); } while (0)
#define PG8_LDB(dst, b, h) do { _Pragma("unroll") for (int n = 0; n < 2; ++n) _Pragma("unroll") for (int k = 0; k < 2; ++k) dst[n][k] = *(const PG8_LAS bf16x8*)(lds + PG8_SB(b, h) + boff + n * 2048 + k * 1024); } while (0)
#define PG8_MMA(ai, bj, At, Bt) do { __builtin_amdgcn_s_setprio(1); _Pragma("unroll") for (int m = 0; m < 4; ++m) _Pragma("unroll") for (int n = 0; n < 2; ++n) _Pragma("unroll") for (int k = 0; k < 2; ++k) \
        acc[ai][bj][m][n] = __builtin_amdgcn_mfma_f32_16x16x32_bf16(Bt[n][k], At[m][k], acc[ai][bj][m][n], 0, 0, 0); __builtin_amdgcn_s_setprio(0); } while (0)
#define PG8_WAIT_V(n) asm volatile("s_waitcnt vmcnt(" #n ")" ::: "memory")
#define PG8_WAIT_L(n) asm volatile("s_waitcnt lgkmcnt(" #n ")" ::: "memory")
#define PG8_BAR __builtin_amdgcn_s_barrier()
#define PG8_SCHED __builtin_amdgcn_sched_barrier(0)
    Unit cur, nxt; int ui = 0;
    if (!S.next(0, cur)) return;
    f32x4 acc[2][2][4][2];
#pragma unroll
    for (int a = 0; a < 2; ++a)
#pragma unroll
        for (int b = 0; b < 2; ++b)
#pragma unroll
            for (int m = 0; m < 4; ++m)
#pragma unroll
                for (int n = 0; n < 2; ++n) acc[a][b][m][n] = (f32x4){0.f, 0.f, 0.f, 0.f};
    bf16x8 At[4][2], B0[2][2], B1[2][2];
    const char* cA = (const char*)g.A + (size_t)cur.pm * tstep; const char* cB = (const char*)g.Bt + (size_t)cur.pn * tstep;
    S.a_ready(cur);
    if constexpr (SP2) {
        PG8_STAGE(PG8_SB(0, 0), cB, voffB); PG8_STAGE(PG8_SB(0, 1), cB + hstepB, voffB); PG8_STAGE(PG8_SA(0, 0), cA, voffA); PG8_STAGE(PG8_SA(0, 1), cA + hstepA, voffA);
        if (wr == 1) PG8_BAR;
        PG8_WAIT_V(2); PG8_BAR;
        PG8_STAGE(PG8_SB(1, 0), cB + kstepB, voffB); PG8_STAGE(PG8_SA(1, 0), cA + kstepA, voffA); PG8_STAGE(PG8_SB(1, 1), cB + hstepB + kstepB, voffB);
        PG8_WAIT_V(6); PG8_BAR;
    } else {
        PG8_STAGE(PG8_SB(0, 0), cB, voffB); PG8_STAGE(PG8_SA(0, 0), cA, voffA); PG8_STAGE(PG8_SB(0, 1), cB + hstepB, voffB); PG8_STAGE(PG8_SA(0, 1), cA + hstepA, voffA);
        if (wr == 1) PG8_BAR;
        PG8_WAIT_V(4); PG8_BAR;
        PG8_STAGE(PG8_SB(1, 0), cB + kstepB, voffB); PG8_STAGE(PG8_SA(1, 0), cA + kstepA, voffA); PG8_STAGE(PG8_SB(1, 1), cB + hstepB + kstepB, voffB);
        PG8_WAIT_V(6); PG8_BAR;
    }
    for (;;) {
        const bool has_next = S.next(ui + 1, nxt);
        const char* nA0 = has_next ? (const char*)g.A + (size_t)nxt.pm * tstep : cA; const char* nB0 = has_next ? (const char*)g.Bt + (size_t)nxt.pn * tstep : cB;
#ifndef REP_KLOOP
#define REP_KLOOP 1
#endif
        for (int rk_ = 0; rk_ < REP_KLOOP; ++rk_) {
        const char* nA = (rk_ + 1 < REP_KLOOP) ? cA : nA0; const char* nB = (rk_ + 1 < REP_KLOOP) ? cB : nB0;
        if (rk_ > 0) {
#pragma unroll
            for (int a = 0; a < 2; ++a)
#pragma unroll
                for (int b = 0; b < 2; ++b)
#pragma unroll
                    for (int m = 0; m < 4; ++m)
#pragma unroll
                        for (int n = 0; n < 2; ++n) acc[a][b][m][n] = (f32x4){0.f, 0.f, 0.f, 0.f}; }
        for (int t = 0; t < nt; t += 2) {
            const bool last = (t == nt - 2);
            const char* a1 = cA + (size_t)(t + 1) * kstepA;
            const char* a2 = last ? nA : cA + (size_t)(t + 2) * kstepA; const char* b2 = last ? nB : cB + (size_t)(t + 2) * kstepB;
            const char* a3 = a2 + kstepA; const char* b3 = b2 + kstepB;
            if (last && has_next && rk_ + 1 == REP_KLOOP) S.a_ready(nxt);
            if constexpr (SP2) {
            PG8_LDB(B0, 0, 0); PG8_LDB(B1, 0, 1); PG8_SCHED; PG8_LDA(At, 0, 0); PG8_STAGE(PG8_SA(1, 1), a1 + hstepA, voffA);
            PG8_WAIT_V(8); PG8_WAIT_L(0); PG8_BAR; PG8_MMA(0, 0, At, B0); PG8_MMA(0, 1, At, B1); PG8_BAR; PG8_SCHED;
            PG8_LDA(At, 0, 1); PG8_STAGE(PG8_SB(0, 0), b2, voffB); PG8_STAGE(PG8_SB(0, 1), b2 + hstepB, voffB); PG8_STAGE(PG8_SA(0, 0), a2, voffA);
            PG8_WAIT_V(8); PG8_WAIT_L(0); PG8_BAR; PG8_MMA(1, 0, At, B0); PG8_MMA(1, 1, At, B1); PG8_BAR; PG8_SCHED;
            PG8_LDB(B0, 1, 0); PG8_LDB(B1, 1, 1); PG8_SCHED; PG8_LDA(At, 1, 0); PG8_STAGE(PG8_SA(0, 1), a2 + hstepA, voffA);
            PG8_WAIT_V(8); PG8_WAIT_L(0); PG8_BAR; PG8_MMA(0, 0, At, B0); PG8_MMA(0, 1, At, B1); PG8_BAR; PG8_SCHED;
            PG8_LDA(At, 1, 1); PG8_STAGE(PG8_SB(1, 0), b3, voffB); PG8_STAGE(PG8_SB(1, 1), b3 + hstepB, voffB); PG8_STAGE(PG8_SA(1, 0), a3, voffA);
            PG8_WAIT_V(8); PG8_WAIT_L(0); PG8_BAR; PG8_MMA(1, 0, At, B0); PG8_MMA(1, 1, At, B1); PG8_BAR; PG8_SCHED;
            } else {
            PG8_LDB(B0, 0, 0); PG8_SCHED; PG8_LDA(At, 0, 0); PG8_STAGE(PG8_SA(1, 1), a1 + hstepA, voffA);
            PG8_WAIT_L(8); PG8_BAR; PG8_WAIT_L(0); PG8_MMA(0, 0, At, B0); PG8_BAR; PG8_SCHED;
            PG8_LDB(B1, 0, 1); PG8_STAGE(PG8_SB(0, 0), b2, voffB);
            PG8_BAR; PG8_WAIT_L(0); PG8_MMA(0, 1, At, B1); PG8_BAR;
            PG8_LDA(At, 0, 1); PG8_STAGE(PG8_SA(0, 0), a2, voffA);
            PG8_BAR; PG8_WAIT_L(0); PG8_MMA(1, 0, At, B0); PG8_BAR; PG8_SCHED;
            PG8_STAGE(PG8_SB(0, 1), b2 + hstepB, voffB);
            PG8_WAIT_V(6); PG8_BAR; PG8_MMA(1, 1, At, B1); PG8_BAR;
            PG8_LDB(B0, 1, 0); PG8_SCHED; PG8_LDA(At, 1, 0); PG8_STAGE(PG8_SA(0, 1), a2 + hstepA, voffA);
            PG8_WAIT_L(8); PG8_BAR; PG8_WAIT_L(0); PG8_MMA(0, 0, At, B0); PG8_BAR; PG8_SCHED;
            PG8_LDB(B1, 1, 1); PG8_STAGE(PG8_SB(1, 0), b3, voffB);
            PG8_BAR; PG8_WAIT_L(0); PG8_MMA(0, 1, At, B1); PG8_BAR;
            PG8_LDA(At, 1, 1); PG8_STAGE(PG8_SA(1, 0), a3, voffA);
            PG8_BAR; PG8_WAIT_L(0); PG8_MMA(1, 0, At, B0); PG8_BAR; PG8_SCHED;
            PG8_STAGE(PG8_SB(1, 1), b3 + hstepB, voffB);
            PG8_WAIT_V(6); PG8_BAR; PG8_MMA(1, 1, At, B1); PG8_BAR;
            }
        }
        }
        const char* nA = nA0; const char* nB = nB0;
        if constexpr (ALIGN_EPI) { if (wr == 0) PG8_BAR; }
#ifndef PG8_NPF
#define PG8_NPF 0
#endif
        if (has_next && PG8_NPF > 0) {
            const char* pb_ = (tid < 256 ? nA : nB) + (size_t)(tid & 255) * K * 2 + 2 * (BK * 2);
            const unsigned scrap = (unsigned)(unsigned long long)(PG8_LAS unsigned char*)(lds + STAGE_BYTES);
#pragma unroll
            for (int j = 0; j < PG8_NPF; ++j) if (j + 2 < nt) {
                unsigned sv_; asm volatile("s_mov_b32 %0, m0\n\ts_mov_b32 m0, %2\n\ts_nop 0\n\tglobal_load_lds_dword %1, off\n\ts_mov_b32 m0, %0" : "=&s"(sv_) : "v"(pb_ + j * (BK * 2)), "s"(scrap) : "memory"); }
        }
        if constexpr (!Epi::AFTER_DRAIN) { for (int re_ = 0; re_ < Epi::REPS; ++re_) E(acc, cur, wr, wc, fr, fq); S.done(cur); }
        if (!has_next) break;
#pragma unroll
        for (int a = 0; a < 2; ++a)
#pragma unroll
            for (int b = 0; b < 2; ++b)
#pragma unroll
                for (int m = 0; m < 4; ++m)
#pragma unroll
                    for (int n = 0; n < 2; ++n) acc[a][b][m][n] = (f32x4){0.f, 0.f, 0.f, 0.f};
        cur = nxt; cA = nA; cB = nB; ++ui;
        if constexpr (ALIGN_EPI) { if (wr == 1) PG8_BAR; }
    }
    PG8_WAIT_V(0);
    if constexpr (!ALIGN_EPI) { if (wr == 0) PG8_BAR; }
    PG8_BAR;
    if constexpr (Epi::AFTER_DRAIN) { E.fused(acc, cur, wr, wc, fr, fq, lds, wid, lane); S.done(cur); }
#undef PG8_SA
#undef PG8_SB
#undef PG8_STAGE
#undef PG8_LDA
#undef PG8_LDB
#undef PG8_MMA
#undef PG8_WAIT_V
#undef PG8_WAIT_L
#undef PG8_BAR
#undef PG8_SCHED
}
}

#ifndef PG8_SP2
#define PG8_SP2 true
#endif
#ifndef PG8_ALIGN
#define PG8_ALIGN true
#endif
#define GAS __attribute__((address_space(1)))
#define LAS __attribute__((address_space(3)))
typedef unsigned short bf16;
typedef unsigned v4u __attribute__((ext_vector_type(4)));
typedef float f32x4 __attribute__((ext_vector_type(4)));
typedef short bf16x8 __attribute__((ext_vector_type(8)));
typedef GAS unsigned gu32;
typedef GAS unsigned long long gu64;
#define RLX_AGENT __ATOMIC_RELAXED, __HIP_MEMORY_SCOPE_AGENT
#define LDS_WAIT() asm volatile("s_waitcnt lgkmcnt(0)" ::: "memory")
#define VM_WAIT() asm volatile("s_waitcnt vmcnt(0)" ::: "memory")
__device__ __forceinline__ unsigned long long rt() { return __builtin_amdgcn_s_memrealtime(); }
__device__ __forceinline__ unsigned f2bf(float f) { unsigned u = __builtin_bit_cast(unsigned, f); return (u + 0x7fffu + ((u >> 16) & 1u)) >> 16; }
__device__ __forceinline__ unsigned pk2(float lo, float hi) { return f2bf(lo) | (f2bf(hi) << 16); }

#define XB_TMO      128
#define XB_XCNT(j)  (256  + 64 * (j))
#define XB_XSUB(j)  (1280 + 64 * (j))
#define XB_XGEN(j)  (2304 + 64 * (j))
#define XB_TOP      3328
#define XB_TOPGEN   3392
#define XCD_BAR_WORDS 3456
#define XB_SPIN_CAP (1u << 18)

__device__ __forceinline__ unsigned xb_ld(unsigned* p)              { return __hip_atomic_load(p, __ATOMIC_RELAXED, __HIP_MEMORY_SCOPE_AGENT); }
__device__ __forceinline__ unsigned xb_add(unsigned* p, unsigned v) { return __hip_atomic_fetch_add(p, v, __ATOMIC_RELAXED, __HIP_MEMORY_SCOPE_AGENT); }
__device__ __forceinline__ unsigned xb_xcc_id() { return (unsigned)__builtin_amdgcn_s_getreg((3 << 11) | 20) & 0xFu; }
#define XB_SPIN(cond, bar) do { unsigned _sp = 0; while (cond) { __builtin_amdgcn_s_sleep(1); \
    if ((++_sp & 255u) == 0u) { if (xb_ld(&(bar)[XB_TMO])) break; if (_sp > XB_SPIN_CAP) { atomicAdd(&(bar)[XB_TMO], 1u); break; } } } } while (0)

struct XcdBarrier {
    unsigned* bar; unsigned x;
    volatile LAS unsigned* st;
};

__device__ __forceinline__ XcdBarrier xcd_barrier_post(unsigned* bar, volatile LAS unsigned* st) {
    XcdBarrier b; b.bar = bar; b.x = xb_xcc_id(); b.st = st;
    if (threadIdx.x == 0) (void)xb_add(&bar[XB_XCNT(b.x)], 1u);
    return b;
}
__device__ __forceinline__ void xcd_barrier_complete(unsigned* bar, unsigned x, unsigned& nloc, unsigned& nx) {
    const unsigned G = gridDim.x * gridDim.y * gridDim.z;
    unsigned sum, cnt, mine, sp = 0u;
    for (;;) {
        sum = 0u; cnt = 0u; mine = 0u;
#pragma unroll
        for (unsigned j = 0; j < 16; ++j) { const unsigned c = xb_ld(&bar[XB_XCNT(j)]); sum += c; cnt += (c > 0u) ? 1u : 0u; mine = (j == x) ? c : mine; }
        if (sum == G) break;
        __builtin_amdgcn_s_sleep(1);
        if ((++sp & 255u) == 0u) { if (xb_ld(&bar[XB_TMO])) break; if (sp > XB_SPIN_CAP) { atomicAdd(&bar[XB_TMO], 1u); break; } }
    }
    nloc = mine > 0u ? mine : 1u; nx = cnt > 0u ? cnt : 1u;
}

__device__ __forceinline__ void xcd_barrier(const XcdBarrier& b) {
    asm volatile("s_waitcnt vmcnt(0)" ::: "memory");
    __syncthreads();
    if (threadIdx.x == 0) {
        unsigned* bar = b.bar;
        __builtin_amdgcn_s_waitcnt(0);
        unsigned nloc = b.st[0], nx = b.st[1];
        if (nloc == 0u) { xcd_barrier_complete(bar, b.x, nloc, nx); b.st[0] = nloc; b.st[1] = nx; }
        const unsigned old = xb_add(&bar[XB_XSUB(b.x)], 1u);
        const unsigned gen = old / nloc;
        if (old + 1u == (gen + 1u) * nloc) {
            __builtin_amdgcn_fence(__ATOMIC_RELEASE, "agent");
            asm volatile("s_waitcnt vmcnt(0)" ::: "memory");
            const unsigned og = xb_add(&bar[XB_TOP], 1u);
            const unsigned tg = og / nx;
            if (og + 1u == (tg + 1u) * nx) xb_add(&bar[XB_TOPGEN], 1u);
            else XB_SPIN(xb_ld(&bar[XB_TOPGEN]) == tg, bar);
            __builtin_amdgcn_fence(__ATOMIC_ACQUIRE, "agent");
            xb_add(&bar[XB_XGEN(b.x)], 1u);
            asm volatile("s_waitcnt vmcnt(0)" ::: "memory");
        } else {
            XB_SPIN(xb_ld(&bar[XB_XGEN(b.x)]) == gen, bar);
            __builtin_amdgcn_fence(__ATOMIC_ACQUIRE, "agent");
            asm volatile("s_waitcnt vmcnt(0)" ::: "memory");
        }
    }
    __syncthreads();
}
namespace att {
typedef float f32x16 __attribute__((ext_vector_type(16)));
typedef short s16x4 __attribute__((ext_vector_type(4)));
typedef unsigned v2u __attribute__((ext_vector_type(2)));
typedef float f32x2_t __attribute__((ext_vector_type(2))); typedef __bf16 bf16x2_t __attribute__((ext_vector_type(2)));
__device__ __forceinline__ unsigned cvtpk(float lo, float hi) { f32x2_t v = {lo, hi}; bf16x2_t b = __builtin_convertvector(v, bf16x2_t); return __builtin_bit_cast(unsigned, b); }
__device__ __forceinline__ float xhalf_max(float x) { const auto r = __builtin_amdgcn_permlane32_swap(__float_as_uint(x), __float_as_uint(x), false, false); return __builtin_elementwise_maximum(__uint_as_float(r[0]), __uint_as_float(r[1])); }
__device__ __forceinline__ int wave_max_i(int v) {
    v = max(v, __builtin_amdgcn_update_dpp(v, v, 0x111, 0xf, 0xf, false)); v = max(v, __builtin_amdgcn_update_dpp(v, v, 0x112, 0xf, 0xf, false));
    v = max(v, __builtin_amdgcn_update_dpp(v, v, 0x114, 0xf, 0xf, false)); v = max(v, __builtin_amdgcn_update_dpp(v, v, 0x118, 0xf, 0xf, false));
    v = max(v, __builtin_amdgcn_update_dpp(v, v, 0x142, 0xa, 0xf, false)); v = max(v, __builtin_amdgcn_update_dpp(v, v, 0x143, 0xc, 0xf, false));
    return __builtin_amdgcn_readlane(v, 63); }
constexpr int KT = 64, VP = 136;
template <int DQK> struct C { static constexpr int KP = (DQK == 96) ? 208 : 144, KS = DQK / 16, CPR = DQK / 8, KCH = KT * CPR, KBYTES = KT * KP, VBYTES = 64 * VP, STAGE = KBYTES + VBYTES; };
constexpr int LDS_NEED = 3 * C<96>::STAGE;
__device__ __forceinline__ int crow(int r, int hi) { return (r & 3) + 8 * (r >> 2) + 4 * hi; }

template <int DQK, bool SPARSE>
__device__ __forceinline__ void attn_unit(LAS unsigned char* lds, const bf16* Q, int qpitch, const bf16* K, int kpitch, const bf16* VT, bf16* O, int opitch, int q0,
                                          const unsigned* maskb, const int* posb, const LAS float* biastab, int h, float qs) {
    typedef C<DQK> CC;
    int tid_o = threadIdx.x; asm volatile("" : "+v"(tid_o));
    const int tid = tid_o, lane = tid & 63, wave = __builtin_amdgcn_readfirstlane(tid >> 6), r32 = lane & 31, hi = lane >> 5;
    const int qw0 = q0 + wave * 32, myq = qw0 + r32;
    bf16x8 qf[CC::KS];
#pragma unroll
    for (int s = 0; s < CC::KS; ++s) qf[s] = *(const bf16x8*)(Q + (size_t)myq * qpitch + 16 * s + 8 * hi);
    f32x16 o0, o1;
#pragma unroll
    for (int r = 0; r < 16; ++r) { o0[r] = 0.f; o1[r] = 0.f; }
    float mhat = 0.f, lrun = 0.f;
    f32x16 negm;
#pragma unroll
    for (int r = 0; r < 16; ++r) negm[r] = 0.f;
    constexpr float THR = 8.0f;
    const float b31 = SPARSE ? biastab[127 * 4 + h] : 0.f;
    (void)qs;
    int posq = 0, qmin = 0;
    if (SPARSE) { posq = posb[myq]; qmin = -wave_max_i(-posq); }
    const int ntiles = (q0 + 256) / KT;
    const int kc0 = tid, kc1 = tid + 512;
    const bool k1on = kc1 < CC::KCH;
    const int kr0 = kc0 / CC::CPR, kp0 = kc0 % CC::CPR, kr1 = k1on ? kc1 / CC::CPR : 0, kp1 = k1on ? kc1 % CC::CPR : 0;
    const bf16* kg0 = K + (size_t)kr0 * kpitch + kp0 * 8; const bf16* kg1 = K + (size_t)kr1 * kpitch + kp1 * 8;
    const bf16* vg = VT + (size_t)(tid >> 3) * SEQ + (tid & 7) * 8;
    const int kl0 = kr0 * CC::KP + kp0 * 16, kl1 = kr1 * CC::KP + kp1 * 16, vl = CC::KBYTES + (tid >> 3) * VP + (tid & 7) * 16;
    v4u sk0[2], sk1[2], sv[2];
    sk0[0] = *(const v4u*)kg0; sk1[0] = k1on ? *(const v4u*)kg1 : (v4u){0u, 0u, 0u, 0u}; sv[0] = *(const v4u*)vg;
    { const size_t ko = (size_t)KT * kpitch; sk0[1] = *(const v4u*)(kg0 + ko); sk1[1] = k1on ? *(const v4u*)(kg1 + ko) : (v4u){0u, 0u, 0u, 0u}; sv[1] = *(const v4u*)(vg + KT); }
    __syncthreads();
    *(LAS v4u*)(lds + kl0) = sk0[0]; if (k1on) *(LAS v4u*)(lds + kl1) = sk1[0]; *(LAS v2u*)(lds + vl) = (v2u){sv[0].x, sv[0].y}; *(LAS v2u*)(lds + vl + 8) = (v2u){sv[0].z, sv[0].w};
    __syncthreads();
    int scur = 0;
    unsigned mwa = 0u, mwb = 0u;
    if (SPARSE) { mwa = maskb[(size_t)myq]; mwb = maskb[(size_t)SEQ + myq]; }
    for (int it2 = 0; it2 < ntiles; it2 += 2) {
#pragma unroll
      for (int u2 = 0; u2 < 2; ++u2) {
        const int it = it2 + u2;
        const int j0 = it * KT; LAS unsigned char* st = lds + scur * CC::STAGE;
        const int snext = scur == 2 ? 0 : scur + 1;
        if (it + 2 < ntiles) { const size_t ko = (size_t)(j0 + 2 * KT) * kpitch; sk0[u2] = *(const v4u*)(kg0 + ko); if (k1on) sk1[u2] = *(const v4u*)(kg1 + ko); sv[u2] = *(const v4u*)(vg + j0 + 2 * KT); }
        unsigned nmwa = 0u, nmwb = 0u;
        if (SPARSE && it + 1 < ntiles) { nmwa = maskb[(size_t)((j0 + KT) >> 5) * SEQ + myq]; nmwb = maskb[(size_t)(((j0 + KT) >> 5) + 1) * SEQ + myq]; }
        if (j0 <= qw0 + 31) {
            f32x16 p0, p1;
            const LAS unsigned char* kb = st + r32 * CC::KP + hi * 16;
            bf16x8 ka0[CC::KS], ka1[CC::KS];
#pragma unroll
            for (int s = 0; s < CC::KS; ++s) { ka0[s] = *(const LAS bf16x8*)(kb + s * 32); ka1[s] = *(const LAS bf16x8*)(kb + 32 * CC::KP + s * 32); }
            __builtin_amdgcn_sched_barrier(0);
#pragma unroll
            for (int s = 0; s < CC::KS; ++s) {
                p0 = __builtin_amdgcn_mfma_f32_32x32x16_bf16(ka0[s], qf[s], s == 0 ? negm : p0, 0, 0, 0);
                p1 = __builtin_amdgcn_mfma_f32_32x32x16_bf16(ka1[s], qf[s], s == 0 ? negm : p1, 0, 0, 0);
            }
            const LAS unsigned char* vb = st + CC::KBYTES + r32 * VP + hi * 8;
            s16x4 va_lo[4], va_hi[4], vb_lo[4], vb_hi[4];
#pragma unroll
            for (int s = 0; s < 4; ++s) { va_lo[s] = *(const LAS s16x4*)(vb + s * 32); va_hi[s] = *(const LAS s16x4*)(vb + s * 32 + 16); vb_lo[s] = *(const LAS s16x4*)(vb + 32 * VP + s * 32); vb_hi[s] = *(const LAS s16x4*)(vb + 32 * VP + s * 32 + 16); }
            __builtin_amdgcn_sched_barrier(0);
            if (SPARSE) {
                const int kmax = wave_max_i(posb[j0 + lane]);
                const bool far = (qmin - kmax >= 113);
                if (!far) {
#pragma unroll
                    for (int r = 0; r < 16; ++r) { int d0 = posq - posb[j0 + crow(r, hi)], d1 = posq - posb[j0 + 32 + crow(r, hi)];
                        d0 = d0 < 0 ? 0 : (d0 > 127 ? 127 : d0); d1 = d1 < 0 ? 0 : (d1 > 127 ? 127 : d1);
                        p0[r] += biastab[d0 * 4 + h] - b31; p1[r] += biastab[d1 * 4 + h] - b31; } }
                const int w0 = (int)(mwa >> (4 * hi)), w1 = (int)(mwb >> (4 * hi));
#pragma unroll
                for (int r = 0; r < 16; ++r) { const unsigned m0 = (unsigned)__builtin_amdgcn_sbfe(w0, (r & 3) + 8 * (r >> 2), 1), m1 = (unsigned)__builtin_amdgcn_sbfe(w1, (r & 3) + 8 * (r >> 2), 1);
                    p0[r] = __uint_as_float((__float_as_uint(p0[r]) & m0) | (0xff800000u & ~m0)); p1[r] = __uint_as_float((__float_as_uint(p1[r]) & m1) | (0xff800000u & ~m1)); }
            } else if (j0 + KT - 1 > qw0) {
#pragma unroll
                for (int r = 0; r < 16; ++r) { const int key = j0 + crow(r, hi); if (key > myq) p0[r] = -INFINITY; if (key + 32 > myq) p1[r] = -INFINITY; }
            }
            float mx = __builtin_elementwise_maximum(p0[0], p1[0]), mxb = __builtin_elementwise_maximum(p0[1], p1[1]);
#pragma unroll
            for (int r = 2; r < 16; r += 2) { mx = __builtin_elementwise_maximum(__builtin_elementwise_maximum(mx, p0[r]), p1[r]); mxb = __builtin_elementwise_maximum(__builtin_elementwise_maximum(mxb, p0[r + 1]), p1[r + 1]); }
            mx = __builtin_elementwise_maximum(mx, mxb);
            mx = xhalf_max(mx);
            if (it == 0 || __any(mx > THR)) {
                const float dl = (it == 0) ? ((mx == -INFINITY) ? 0.f : mx) : fmaxf(mx, 0.f);
                mhat += dl;
#pragma unroll
                for (int r = 0; r < 16; ++r) { p0[r] -= dl; p1[r] -= dl; }
                const float alpha = __builtin_amdgcn_exp2f(-dl);
                lrun *= alpha;
#pragma unroll
                for (int r = 0; r < 16; ++r) { o0[r] *= alpha; o1[r] *= alpha; }
                const float nm = -mhat;
#pragma unroll
                for (int r = 0; r < 16; ++r) negm[r] = nm;
            }
            float rsa = 0.f, rsb = 0.f, rsc = 0.f, rsd = 0.f;
#pragma unroll
            for (int r = 0; r < 16; r += 2) { p0[r] = __builtin_amdgcn_exp2f(p0[r]); p1[r] = __builtin_amdgcn_exp2f(p1[r]); p0[r + 1] = __builtin_amdgcn_exp2f(p0[r + 1]); p1[r + 1] = __builtin_amdgcn_exp2f(p1[r + 1]);
                rsa += p0[r]; rsb += p1[r]; rsc += p0[r + 1]; rsd += p1[r + 1]; }
            lrun += (rsa + rsb) + (rsc + rsd);
#pragma unroll
            for (int s = 0; s < 4; ++s) {
                v4u pw;
                if (s < 2) { pw.x = cvtpk(p0[8 * s + 0], p0[8 * s + 1]); pw.y = cvtpk(p0[8 * s + 2], p0[8 * s + 3]); pw.z = cvtpk(p0[8 * s + 4], p0[8 * s + 5]); pw.w = cvtpk(p0[8 * s + 6], p0[8 * s + 7]); }
                else { const int q = s - 2; pw.x = cvtpk(p1[8 * q + 0], p1[8 * q + 1]); pw.y = cvtpk(p1[8 * q + 2], p1[8 * q + 3]); pw.z = cvtpk(p1[8 * q + 4], p1[8 * q + 5]); pw.w = cvtpk(p1[8 * q + 6], p1[8 * q + 7]); }
                const bf16x8 pf = __builtin_bit_cast(bf16x8, pw);
                const s16x4 a_lo = va_lo[s], a_hi = va_hi[s], b_lo = vb_lo[s], b_hi = vb_hi[s];
                const bf16x8 va = (bf16x8){a_lo[0], a_lo[1], a_lo[2], a_lo[3], a_hi[0], a_hi[1], a_hi[2], a_hi[3]};
                const bf16x8 vb2 = (bf16x8){b_lo[0], b_lo[1], b_lo[2], b_lo[3], b_hi[0], b_hi[1], b_hi[2], b_hi[3]};
                o0 = __builtin_amdgcn_mfma_f32_32x32x16_bf16(va, pf, o0, 0, 0, 0);
                o1 = __builtin_amdgcn_mfma_f32_32x32x16_bf16(vb2, pf, o1, 0, 0, 0);
            }
        }
        if (it + 1 < ntiles) { LAS unsigned char* sn = lds + snext * CC::STAGE; *(LAS v4u*)(sn + kl0) = sk0[u2 ^ 1]; if (k1on) *(LAS v4u*)(sn + kl1) = sk1[u2 ^ 1]; *(LAS v2u*)(sn + vl) = (v2u){sv[u2 ^ 1].x, sv[u2 ^ 1].y}; *(LAS v2u*)(sn + vl + 8) = (v2u){sv[u2 ^ 1].z, sv[u2 ^ 1].w}; }
        if (SPARSE) { mwa = nmwa; mwb = nmwb; }
        scur = snext;
        __syncthreads();
      }
    }
    float lt = lrun + __shfl_xor(lrun, 32);
    const float inv = 1.0f / lt;
    LAS unsigned char* ost = lds + wave * (32 * 144);
#pragma unroll
    for (int g = 0; g < 4; ++g) {
        v2u w0, w1;
        w0.x = cvtpk(o0[4 * g] * inv, o0[4 * g + 1] * inv); w0.y = cvtpk(o0[4 * g + 2] * inv, o0[4 * g + 3] * inv);
        w1.x = cvtpk(o1[4 * g] * inv, o1[4 * g + 1] * inv); w1.y = cvtpk(o1[4 * g + 2] * inv, o1[4 * g + 3] * inv);
        *(LAS v2u*)(ost + r32 * 144 + (8 * g + 4 * hi) * 2) = w0; *(LAS v2u*)(ost + r32 * 144 + (32 + 8 * g + 4 * hi) * 2) = w1;
    }
    asm volatile("s_waitcnt lgkmcnt(0)" ::: "memory");
#pragma unroll
    for (int ps = 0; ps < 4; ++ps) { const int rr = 8 * ps + (lane >> 3), pc = lane & 7;
        const v4u v = *(const LAS v4u*)(ost + rr * 144 + pc * 16);
        *(v4u*)(O + (size_t)(qw0 + rr) * opitch + pc * 8) = v; }
}
}
namespace prep {
typedef float f32x16 __attribute__((ext_vector_type(16)));
typedef unsigned v2u __attribute__((ext_vector_type(2)));
__device__ __forceinline__ int crow(int r, int hi) { return (r & 3) + 8 * (r >> 2) + 4 * hi; }
__device__ __forceinline__ float sumsq8(const bf16x8 v) {
    float s = 0.f;
#pragma unroll
    for (int j = 0; j < 8; ++j) { const float x = __uint_as_float((unsigned)(unsigned short)v[j] << 16); s += x * x; }
    return s;
}
constexpr int WQ_PITCH = 400, WKV_PITCH = 272, MLA_WLDS_BYTES = 384 * WQ_PITCH;
template <bool WLDS = false>
__device__ __forceinline__ void mla_prep_unit(const bf16* __restrict__ proj, const bf16* __restrict__ wqb_t, const bf16* __restrict__ wkvb_t, const float* __restrict__ cs, const float* __restrict__ sn,
                                              bf16* __restrict__ Q, bf16* __restrict__ K, bf16* __restrict__ VT, int u, int lane, int part, const LAS unsigned char* wl = nullptr) {
    int lane_o = lane; asm volatile("" : "+v"(lane_o));
    const int r32 = lane_o & 31, hi = lane_o >> 5, tok = u * 32 + r32, b = tok / SEQ, t = tok % SEQ;
    const bf16* row = proj + (size_t)tok * NINP;
    if (part == 0) {
        bf16x8 bq[12]; float ss = 0.f;
#pragma unroll
        for (int s = 0; s < 12; ++s) { bq[s] = *(const bf16x8*)(row + PC_MQA + 16 * s + 8 * hi); ss += sumsq8(bq[s]); }
        ss += __shfl_xor(ss, 32);
        const float rq = (1.0f / sqrtf(ss * (1.0f / 192.0f) + EPS)) * QSCALE;
        const f32x4 c0 = *(const f32x4*)(cs + (size_t)tok * 16 + 4 * hi), c1 = *(const f32x4*)(cs + (size_t)tok * 16 + 8 + 4 * hi);
        const f32x4 s0 = *(const f32x4*)(sn + (size_t)tok * 16 + 4 * hi), s1 = *(const f32x4*)(sn + (size_t)tok * 16 + 8 + 4 * hi);
        bf16x8 wf[12];
        if (!WLDS) {
#pragma unroll
            for (int s = 0; s < 12; ++s) wf[s] = *(const bf16x8*)(wqb_t + (size_t)r32 * 192 + 8 * hi + 16 * s); }
#pragma unroll 1
        for (int nt = 0; nt < 12; ++nt) {
            f32x16 acc;
#pragma unroll
            for (int r = 0; r < 16; ++r) acc[r] = 0.f;
            if (WLDS) {
#pragma unroll
                for (int s = 0; s < 12; ++s) wf[s] = *(const LAS bf16x8*)(wl + (nt * 32 + r32) * WQ_PITCH + (8 * hi + 16 * s) * 2); }
            const bf16* wr = wqb_t + (size_t)((nt < 11 ? nt + 1 : nt) * 32 + r32) * 192 + 8 * hi;
#pragma unroll
            for (int s = 0; s < 12; ++s) acc = __builtin_amdgcn_mfma_f32_32x32x16_bf16(wf[s], bq[s], acc, 0, 0, 0);
            if (!WLDS) {
#pragma unroll
                for (int s = 0; s < 12; ++s) wf[s] = *(const bf16x8*)(wr + 16 * s); }
            const int hh = nt / 3, part = nt % 3;
            bf16* qo = Q + (size_t)tok * 384 + hh * 96 + part * 32;
            if (part < 2) {
#pragma unroll
                for (int g = 0; g < 4; ++g) { v2u w; w.x = att::cvtpk(acc[4 * g] * rq, acc[4 * g + 1] * rq); w.y = att::cvtpk(acc[4 * g + 2] * rq, acc[4 * g + 3] * rq); *(v2u*)(qo + 8 * g + 4 * hi) = w; }
            } else {
                float o1[8], o2[8];
#pragma unroll
                for (int r = 0; r < 8; ++r) { const float c = r < 4 ? c0[r & 3] : c1[r & 3], s = r < 4 ? s0[r & 3] : s1[r & 3]; const float x1 = acc[r] * rq, x2 = acc[r + 8] * rq; o1[r] = x1 * c - x2 * s; o2[r] = x2 * c + x1 * s; }
#pragma unroll
                for (int g = 0; g < 2; ++g) { v2u w; w.x = att::cvtpk(o1[4 * g], o1[4 * g + 1]); w.y = att::cvtpk(o1[4 * g + 2], o1[4 * g + 3]); *(v2u*)(qo + 8 * g + 4 * hi) = w;
                    v2u w2; w2.x = att::cvtpk(o2[4 * g], o2[4 * g + 1]); w2.y = att::cvtpk(o2[4 * g + 2], o2[4 * g + 3]); *(v2u*)(qo + 16 + 8 * g + 4 * hi) = w2; }
            }
        }
    }
    if (part == 1) {
        bf16x8 bk[8]; float ss = 0.f;
#pragma unroll
        for (int s = 0; s < 8; ++s) { bk[s] = *(const bf16x8*)(row + PC_MKVA + 16 * s + 8 * hi); ss += sumsq8(bk[s]); }
        ss += __shfl_xor(ss, 32);
        const float rkv = 1.0f / sqrtf(ss * (1.0f / 128.0f) + EPS);
        bf16x8 wf[8];
        if (!WLDS) {
#pragma unroll
            for (int s = 0; s < 8; ++s) wf[s] = *(const bf16x8*)(wkvb_t + (size_t)r32 * 128 + 8 * hi + 16 * s); }
#pragma unroll 1
        for (int nt = 0; nt < 16; ++nt) {
            f32x16 acc;
#pragma unroll
            for (int r = 0; r < 16; ++r) acc[r] = 0.f;
            if (WLDS) {
#pragma unroll
                for (int s = 0; s < 8; ++s) wf[s] = *(const LAS bf16x8*)(wl + (nt * 32 + r32) * WKV_PITCH + (8 * hi + 16 * s) * 2); }
            const bf16* wr = wkvb_t + (size_t)((nt < 15 ? nt + 1 : nt) * 32 + r32) * 128 + 8 * hi;
#pragma unroll
            for (int s = 0; s < 8; ++s) acc = __builtin_amdgcn_mfma_f32_32x32x16_bf16(wf[s], bk[s], acc, 0, 0, 0);
            if (!WLDS) {
#pragma unroll
                for (int s = 0; s < 8; ++s) wf[s] = *(const bf16x8*)(wr + 16 * s); }
            const int hh = nt >> 2, part = nt & 3;
            if (part < 2) {
                bf16* ko = K + (size_t)tok * 384 + hh * 96 + part * 32;
#pragma unroll
                for (int g = 0; g < 4; ++g) { v2u w; w.x = att::cvtpk(acc[4 * g] * rkv, acc[4 * g + 1] * rkv); w.y = att::cvtpk(acc[4 * g + 2] * rkv, acc[4 * g + 3] * rkv); *(v2u*)(ko + 8 * g + 4 * hi) = w; }
            } else {
                bf16* vo = VT + ((size_t)(b * 4 + hh) * 64 + (part - 2) * 32) * SEQ + t;
#pragma unroll
                for (int r = 0; r < 16; ++r) vo[(size_t)crow(r, hi) * SEQ] = (bf16)f2bf(acc[r] * rkv);
            }
        }
    }
    if (part == 1) {
        const bf16x8 x1 = *(const bf16x8*)(row + PC_MKVA + 128 + 8 * hi), x2 = *(const bf16x8*)(row + PC_MKVA + 144 + 8 * hi);
        const f32x4 ca = *(const f32x4*)(cs + (size_t)tok * 16 + 8 * hi), cb = *(const f32x4*)(cs + (size_t)tok * 16 + 8 * hi + 4);
        const f32x4 sa = *(const f32x4*)(sn + (size_t)tok * 16 + 8 * hi), sb = *(const f32x4*)(sn + (size_t)tok * 16 + 8 * hi + 4);
        float o1[8], o2[8];
#pragma unroll
        for (int j = 0; j < 8; ++j) { const float a = __uint_as_float((unsigned)(unsigned short)x1[j] << 16), bb = __uint_as_float((unsigned)(unsigned short)x2[j] << 16);
            const float c = j < 4 ? ca[j & 3] : cb[j & 3], s = j < 4 ? sa[j & 3] : sb[j & 3]; o1[j] = a * c - bb * s; o2[j] = bb * c + a * s; }
        v4u w1, w2; w1.x = att::cvtpk(o1[0], o1[1]); w1.y = att::cvtpk(o1[2], o1[3]); w1.z = att::cvtpk(o1[4], o1[5]); w1.w = att::cvtpk(o1[6], o1[7]);
        w2.x = att::cvtpk(o2[0], o2[1]); w2.y = att::cvtpk(o2[2], o2[3]); w2.z = att::cvtpk(o2[4], o2[5]); w2.w = att::cvtpk(o2[6], o2[7]);
#pragma unroll
        for (int hh = 0; hh < 4; ++hh) { *(v4u*)(K + (size_t)tok * 384 + hh * 96 + 64 + 8 * hi) = w1; *(v4u*)(K + (size_t)tok * 384 + hh * 96 + 80 + 8 * hi) = w2; }
    }
}

__device__ __forceinline__ unsigned mono_key2(float s) { const unsigned u = __float_as_uint(s + 0.0f); return (u & 0x80000000u) ? ~u : (u | 0x80000000u); }

__device__ __forceinline__ void dsa_select_unit(LAS unsigned char* lds, const bf16* __restrict__ projb  , const bf16* __restrict__ KIb, const float* __restrict__ WIb, unsigned* __restrict__ maskb, int t0) {
    int tid_o = threadIdx.x; asm volatile("" : "+v"(tid_o));
    const int tid = tid_o, lane = tid & 63, wave = __builtin_amdgcn_readfirstlane(tid >> 6), r32 = lane & 31, hi = lane >> 5;
    LAS unsigned* keys = (LAS unsigned*)lds;
    bf16x8 aq[2][4];
    { const int i = r32, e = i & 3, g = (i >> 3), hh = (i >> 2) & 1; const int ql = 2 * hh + (g >> 1), head = 4 * (g & 1) + e;
#pragma unroll
      for (int rt = 0; rt < 2; ++rt)
#pragma unroll
          for (int s = 0; s < 4; ++s) aq[rt][s] = *(const bf16x8*)(projb + (size_t)(t0 + 4 * rt + ql) * NINP + PC_IQ + head * 64 + 16 * s + 8 * hi); }
    float wv[2][2][8];
#pragma unroll
    for (int rt = 0; rt < 2; ++rt)
#pragma unroll
        for (int w2 = 0; w2 < 2; ++w2) { const f32x4 a = *(const f32x4*)(WIb + (size_t)(t0 + 4 * rt + 2 * hi + w2) * 8), bq = *(const f32x4*)(WIb + (size_t)(t0 + 4 * rt + 2 * hi + w2) * 8 + 4);
            wv[rt][w2][0] = a[0]; wv[rt][w2][1] = a[1]; wv[rt][w2][2] = a[2]; wv[rt][w2][3] = a[3]; wv[rt][w2][4] = bq[0]; wv[rt][w2][5] = bq[1]; wv[rt][w2][6] = bq[2]; wv[rt][w2][7] = bq[3]; }
    const int ntile = (t0 + 8 + 31) >> 5;
    __syncthreads();
#ifndef SEL_REP_SCORE
#define SEL_REP_SCORE 1
#endif
#ifndef SEL_REP_SEARCH
#define SEL_REP_SEARCH 1
#endif
    for (int rsc = 0; rsc < SEL_REP_SCORE; ++rsc) {
    bf16x8 kf[4];
    if (wave < ntile) {
#pragma unroll
        for (int s = 0; s < 4; ++s) kf[s] = *(const bf16x8*)(KIb + (size_t)(wave * 32 + r32) * 64 + 16 * s + 8 * hi); }
    for (int tt = wave; tt < ntile; tt += 8) {
        const int j0 = tt * 32;
        bf16x8 kn[4];
        { const int jn = (tt + 8 < ntile) ? (tt + 8) * 32 : j0;
#pragma unroll
          for (int s = 0; s < 4; ++s) kn[s] = *(const bf16x8*)(KIb + (size_t)(jn + r32) * 64 + 16 * s + 8 * hi); }
#pragma unroll
        for (int rt = 0; rt < 2; ++rt) {
            f32x16 acc;
#pragma unroll
            for (int r = 0; r < 16; ++r) acc[r] = 0.f;
#pragma unroll
            for (int s = 0; s < 4; ++s) acc = __builtin_amdgcn_mfma_f32_32x32x16_bf16(aq[rt][s], kf[s], acc, 0, 0, 0);
#pragma unroll
            for (int w2 = 0; w2 < 2; ++w2) { float sc = 0.f;
#pragma unroll
                for (int hd = 0; hd < 8; ++hd) sc += fmaxf(acc[8 * w2 + hd], 0.f) * wv[rt][w2][hd];
                keys[(4 * rt + 2 * hi + w2) * SEQ + j0 + r32] = __float_as_uint(sc + 0.0f); }
        }
#pragma unroll
        for (int s = 0; s < 4; ++s) kf[s] = kn[s];
    }
    __syncthreads();
    }
    for (int rse = 0; rse < SEL_REP_SEARCH; ++rse) {
    const int t = t0 + wave, N = t + 1, R = (N + 63) >> 6, nl = N - lane;
    float sr[64];
#pragma unroll
    for (int r = 0; r < 64; ++r) sr[r] = (r < R && 64 * r < nl) ? __uint_as_float(keys[wave * SEQ + 64 * r + lane]) : 0.f;
    unsigned long long mysel = 0ull;
    if (N <= 256) {
#pragma unroll
        for (int r = 0; r < 4; ++r) { const unsigned long long sel = __ballot(64 * r < nl); if (lane == r) mysel = sel; }
    } else {
        LAS unsigned* hist = (LAS unsigned*)(lds + 131072) + wave * 512;
        LAS unsigned* list = (LAS unsigned*)(lds + 131072 + 16384) + wave * 64;
        bool fast = true; unsigned bstar = 0u; int need16 = 256; unsigned T32 = 0u;
        unsigned bp[32];
        {
            float lo = INFINITY, hi2 = -INFINITY;
#pragma unroll
            for (int r = 0; r < 64; ++r) if (r < R) { const bool v = 64 * r < nl; lo = fminf(lo, v ? sr[r] : INFINITY); hi2 = fmaxf(hi2, v ? sr[r] : -INFINITY); }
#pragma unroll
            for (int off = 32; off >= 1; off >>= 1) { lo = fminf(lo, __shfl_xor(lo, off)); hi2 = fmaxf(hi2, __shfl_xor(hi2, off)); }
            const float span = hi2 - lo;
            fast = (span > 0.f) && (span < 3.0e38f);
            const float inv = fast ? 511.9f / span : 0.f;
            { v4u z = {0u, 0u, 0u, 0u}; *(LAS v4u*)(hist + 8 * lane) = z; *(LAS v4u*)(hist + 8 * lane + 4) = z; }
            list[lane] = 0u;
#pragma unroll
            for (int r = 0; r < 64; ++r) {
                unsigned b = 0u;
                if (r < R) { b = (unsigned)((sr[r] - lo) * inv); b = b > 511u ? 511u : b; if (64 * r < nl) __hip_atomic_fetch_add(hist + b, 1u, __ATOMIC_RELAXED, __HIP_MEMORY_SCOPE_WORKGROUP); }
                if (r & 1) bp[r >> 1] |= b << 16; else bp[r >> 1] = b;
            }
            asm volatile("s_waitcnt lgkmcnt(0)" ::: "memory");
            const v4u h0 = *(const LAS v4u*)(hist + 8 * lane), h1 = *(const LAS v4u*)(hist + 8 * lane + 4);
            const unsigned own = (h0.x + h0.y) + (h0.z + h0.w) + (h1.x + h1.y) + (h1.z + h1.w);
            unsigned suf = own;
#pragma unroll
            for (int off = 1; off < 64; off <<= 1) { const unsigned o = __shfl_down(suf, off); suf += (lane + off < 64) ? o : 0u; }
            const int L = (int)__popcll(__ballot(suf >= 256u)) - 1;
            int c = (int)__shfl(suf - own, L);
            const unsigned g0 = __shfl(h0.x, L), g1 = __shfl(h0.y, L), g2 = __shfl(h0.z, L), g3 = __shfl(h0.w, L), g4 = __shfl(h1.x, L), g5 = __shfl(h1.y, L), g6 = __shfl(h1.z, L), g7 = __shfl(h1.w, L);
            int bsel = 0, cab = c; bool found = false;
#define STEP_BIN(gv, idx) if (!found) { if (c + (int)(gv) >= 256) { found = true; bsel = (idx); cab = c; } else c += (int)(gv); }
            STEP_BIN(g7, 7) STEP_BIN(g6, 6) STEP_BIN(g5, 5) STEP_BIN(g4, 4) STEP_BIN(g3, 3) STEP_BIN(g2, 2) STEP_BIN(g1, 1) STEP_BIN(g0, 0)
#undef STEP_BIN
            bstar = (unsigned)(8 * L + bsel); need16 = 256 - cab;
            fast = fast && found && (L >= 0);
            int base = 0;
            if (fast) {
                const unsigned long long ltm = (1ull << lane) - 1ull;
#pragma unroll
                for (int r = 0; r < 64; ++r) if (r < R) {
                    const unsigned b = (r & 1) ? (bp[r >> 1] >> 16) : (bp[r >> 1] & 0xffffu);
                    const bool inb = (b == bstar) && (64 * r < nl);
                    const unsigned long long m = __ballot(inb);
                    if (m) { const int pos = base + (int)__popcll(m & ltm); if (inb && pos < 64) list[pos] = mono_key2(sr[r]); base += (int)__popcll(m); }
                }
                fast = base <= 64;
            }
        }
        if (fast) {
            asm volatile("s_waitcnt lgkmcnt(0)" ::: "memory");
            const unsigned cv = list[lane];
#pragma unroll 1
            for (int bit = 31; bit >= 0; --bit) { const unsigned cand = T32 | (1u << bit); if ((int)__popcll(__ballot(cv >= cand)) >= need16) T32 = cand; }
        } else {
            need16 = 256;
#define CNT_GE(cand, out) do { int c_ = 0; _Pragma("unroll") for (int g8 = 0; g8 < 8; ++g8) if (g8 * 8 < R) { _Pragma("unroll") for (int q = 0; q < 8; ++q) \
                c_ += (int)__popcll(__ballot((64 * (g8 * 8 + q) < nl) && mono_key2(sr[g8 * 8 + q]) >= (cand))); } (out) = c_; } while (0)
#pragma unroll 1
            for (int bit = 31; bit >= 0; --bit) { const unsigned cand = T32 | (1u << bit); int cnt; CNT_GE(cand, cnt); if (cnt >= 256) T32 = cand; }
#undef CNT_GE
        }
        int taken = 0;
        int ngt = 0;
#pragma unroll
        for (int r = 0; r < 64; ++r) if (r < R) {
            const unsigned b = (r & 1) ? (bp[r >> 1] >> 16) : (bp[r >> 1] & 0xffffu);
            const bool v = 64 * r < nl, cand = v && (!fast || b == bstar);
            ngt += (int)__popcll(__ballot(cand && mono_key2(sr[r]) > T32));
        }
        const int need_eq = need16 - ngt;
#pragma unroll
        for (int r = 0; r < 64; ++r) {
            unsigned long long sel = 0ull;
            if (r < R) {
                const unsigned b = (r & 1) ? (bp[r >> 1] >> 16) : (bp[r >> 1] & 0xffffu);
                const bool v = 64 * r < nl, cand = v && (!fast || b == bstar);
                sel = fast ? __ballot(v && b > bstar) : 0ull;
                const unsigned long long cm = __ballot(cand);
                if (cm) { const unsigned mk = mono_key2(sr[r]);
                    unsigned long long eqm = __ballot(cand && mk == T32);
                    sel |= __ballot(cand && mk > T32);
                    int ce = (int)__popcll(eqm);
                    if (taken + ce > need_eq) { int keep = need_eq - taken; keep = keep < 0 ? 0 : keep; while (ce > keep) { eqm &= ~(1ull << (63 - __clzll((long long)eqm))); --ce; } }
                    taken += ce; sel |= eqm; }
            }
            if (lane == r) mysel = sel;
        }
    }
    *(v2u*)(maskb + (size_t)t * 128 + 2 * lane) = (v2u){(unsigned)mysel, (unsigned)(mysel >> 32)};
    }
}
}
namespace sel2 {
typedef float f32x16 __attribute__((ext_vector_type(16)));
typedef unsigned v2u __attribute__((ext_vector_type(2)));
constexpr int L_HIST = 0, L_MASK = 16384, L_MLIST = 20480, L_CTL = 24576, L_SKEYS = 32768, L_END = 49152;
constexpr int C_AMAX = 0, C_MCNT = 8, C_BSTAR = 16, C_NEED = 24, C_SLOW = 32;
__device__ __forceinline__ unsigned mono(float s) { const unsigned u = __float_as_uint(s + 0.0f); return (u & 0x80000000u) ? ~u : (u | 0x80000000u); }

__device__ __forceinline__ void slow_query(const LAS unsigned* skeys, LAS unsigned* maskrow, int N, int lane) {
    const int R = (N + 63) >> 6;
    unsigned kr[64];
#pragma unroll
    for (int r = 0; r < 64; ++r) { const int j = 64 * r + lane; kr[r] = (r < R && j < N) ? skeys[j] : 0u; }
    unsigned T = 0u;
#define CNT_GE(cand, out) do { int c_ = 0; _Pragma("unroll") for (int g8 = 0; g8 < 8; ++g8) if (g8 * 8 < R) { _Pragma("unroll") for (int q = 0; q < 8; ++q) c_ += (int)__popcll(__ballot(kr[g8 * 8 + q] >= (cand))); } (out) = c_; } while (0)
#pragma unroll 1
    for (int bit = 31; bit >= 0; --bit) { const unsigned cand = T | (1u << bit); int cnt; CNT_GE(cand, cnt); if (cnt >= 256) T = cand; }
    int gt; { const unsigned c4 = T + 1u; CNT_GE(c4, gt); }
#undef CNT_GE
    const int need = 256 - gt;
    int base = 0;
#pragma unroll
    for (int r = 0; r < 64; ++r) {
        const unsigned long long gtm = __ballot(kr[r] > T); unsigned long long eqm = __ballot(kr[r] == T && (64 * r + lane) < N);
        int c = (int)__popcll(eqm);
        if (base + c > need) { int keep = need - base; keep = keep < 0 ? 0 : keep; while (c > keep) { eqm &= ~(1ull << (63 - __clzll((long long)eqm))); --c; } }
        base += c; const unsigned long long sel = gtm | eqm;
        if (lane == 0) { maskrow[2 * r] = (unsigned)sel; maskrow[2 * r + 1] = (unsigned)(sel >> 32); }
    }
}

__device__ __forceinline__ void dsa_select_unit2(LAS unsigned char* lds, const bf16* __restrict__ projb  , const bf16* __restrict__ KIb, const float* __restrict__ WIb, unsigned* __restrict__ maskb, int t0) {
    int tid_o = threadIdx.x; asm volatile("" : "+v"(tid_o));
    const int tid = tid_o, lane = tid & 63, wave = __builtin_amdgcn_readfirstlane(tid >> 6), r32 = lane & 31, hi = lane >> 5;
    LAS unsigned* hist = (LAS unsigned*)(lds + L_HIST);
    LAS unsigned* maskL = (LAS unsigned*)(lds + L_MASK);
    LAS unsigned long long* mlist = (LAS unsigned long long*)(lds + L_MLIST);
    LAS unsigned* ctl = (LAS unsigned*)(lds + L_CTL);
    LAS unsigned* skeys = (LAS unsigned*)(lds + L_SKEYS);
    __syncthreads();
    { const v4u z = {0u, 0u, 0u, 0u}; *(LAS v4u*)(hist + tid * 8) = z; *(LAS v4u*)(hist + tid * 8 + 4) = z; *(LAS v2u*)(maskL + tid * 2) = (v2u){0u, 0u}; if (tid < 64) ctl[tid] = 0u; }
    bf16x8 aq[2][4];
    { const int i = r32, e = i & 3, g = (i >> 3), hh = (i >> 2) & 1; const int ql = 2 * hh + (g >> 1), head = 4 * (g & 1) + e;
#pragma unroll
      for (int rt = 0; rt < 2; ++rt)
#pragma unroll
          for (int s = 0; s < 4; ++s) aq[rt][s] = *(const bf16x8*)(projb + (size_t)(t0 + 4 * rt + ql) * NINP + PC_IQ + head * 64 + 16 * s + 8 * hi); }
    float wv[4][8];
#pragma unroll
    for (int c = 0; c < 4; ++c) { const int qg = t0 + 4 * (c >> 1) + 2 * hi + (c & 1); const f32x4 a = *(const f32x4*)(WIb + (size_t)qg * 8), bq = *(const f32x4*)(WIb + (size_t)qg * 8 + 4);
        wv[c][0] = a[0]; wv[c][1] = a[1]; wv[c][2] = a[2]; wv[c][3] = a[3]; wv[c][4] = bq[0]; wv[c][5] = bq[1]; wv[c][6] = bq[2]; wv[c][7] = bq[3]; }
    __syncthreads();
    const int ntile = (t0 + 8 + 31) >> 5;
    const int jl = wave * 32 + r32;
    const int jrel = jl - t0 - 2 * hi;
    float sc[16][4]; float mx[4] = {0.f, 0.f, 0.f, 0.f};
    bf16x8 kf[4];
    if (wave < ntile) {
#pragma unroll
        for (int s = 0; s < 4; ++s) kf[s] = *(const bf16x8*)(KIb + (size_t)jl * 64 + 16 * s + 8 * hi); }
#pragma unroll
    for (int i = 0; i < 16; ++i) {
        const int tt = wave + 8 * i;
        if (tt < ntile) {
            bf16x8 kn[4];
            { const int jn = ((tt + 8 < ntile) ? (tt + 8) : tt) * 32 + r32;
#pragma unroll
              for (int s = 0; s < 4; ++s) kn[s] = *(const bf16x8*)(KIb + (size_t)jn * 64 + 16 * s + 8 * hi); }
#pragma unroll
            for (int rt = 0; rt < 2; ++rt) {
                f32x16 acc;
#pragma unroll
                for (int r = 0; r < 16; ++r) acc[r] = 0.f;
#pragma unroll
                for (int s = 0; s < 4; ++s) acc = __builtin_amdgcn_mfma_f32_32x32x16_bf16(aq[rt][s], kf[s], acc, 0, 0, 0);
#pragma unroll
                for (int w2 = 0; w2 < 2; ++w2) { const int c = 2 * rt + w2; float s_ = 0.f;
#pragma unroll
                    for (int hd = 0; hd < 8; ++hd) s_ += fmaxf(acc[8 * w2 + hd], 0.f) * wv[c][hd];
                    s_ += 0.0f;
                    const bool v = (jrel + 256 * i) <= (4 * rt + w2);
                    sc[i][c] = s_; mx[c] = fmaxf(mx[c], v ? fabsf(s_) : 0.f); }
            }
#pragma unroll
            for (int s = 0; s < 4; ++s) kf[s] = kn[s];
        } else {
#pragma unroll
            for (int c = 0; c < 4; ++c) sc[i][c] = 0.f;
        }
    }
#pragma unroll
    for (int c = 0; c < 4; ++c) __hip_atomic_fetch_max(ctl + C_AMAX + 4 * (c >> 1) + 2 * hi + (c & 1), __float_as_uint(mx[c]), __ATOMIC_RELAXED, __HIP_MEMORY_SCOPE_WORKGROUP);
    __syncthreads();
    float inv[4];
#pragma unroll
    for (int c = 0; c < 4; ++c) { const float am = __uint_as_float(ctl[C_AMAX + 4 * (c >> 1) + 2 * hi + (c & 1)]); inv[c] = (am > 0.f && am < 3.0e38f) ? 255.95f / am : 0.f; }
#pragma unroll
    for (int i = 0; i < 16; ++i) if (wave + 8 * i < ntile) {
#pragma unroll
        for (int c = 0; c < 4; ++c) { unsigned b = (unsigned)fmaf(sc[i][c], inv[c], 255.95f); b = b > 511u ? 511u : b;
            if ((jrel + 256 * i) <= (4 * (c >> 1) + (c & 1))) __hip_atomic_fetch_add(hist + (4 * (c >> 1) + 2 * hi + (c & 1)) * 512 + b, 1u, __ATOMIC_RELAXED, __HIP_MEMORY_SCOPE_WORKGROUP); }
    }
    __syncthreads();
    {
        const int N = t0 + wave + 1;
        int bstar = -1, need16 = 0; bool slow = false;
        if (N > 256) {
            const float am = __uint_as_float(ctl[C_AMAX + wave]);
            slow = !(am > 0.f && am < 3.0e38f);
            const LAS unsigned* hq = hist + wave * 512;
            const v4u h0 = *(const LAS v4u*)(hq + 8 * lane), h1 = *(const LAS v4u*)(hq + 8 * lane + 4);
            const unsigned own = (h0.x + h0.y) + (h0.z + h0.w) + (h1.x + h1.y) + (h1.z + h1.w);
            unsigned suf = own;
#pragma unroll
            for (int off = 1; off < 64; off <<= 1) { const unsigned o = __shfl_down(suf, off); suf += (lane + off < 64) ? o : 0u; }
            const int L = (int)__popcll(__ballot(suf >= 256u)) - 1;
            if (L < 0) slow = true;
            const int Lc = L < 0 ? 0 : L;
            int c = (int)__shfl(suf - own, Lc);
            const unsigned g0 = __shfl(h0.x, Lc), g1 = __shfl(h0.y, Lc), g2 = __shfl(h0.z, Lc), g3 = __shfl(h0.w, Lc), g4 = __shfl(h1.x, Lc), g5 = __shfl(h1.y, Lc), g6 = __shfl(h1.z, Lc), g7 = __shfl(h1.w, Lc);
            int bsel = 0, cab = c; bool found = false;
#define STEP_BIN(gv, idx) if (!found) { if (c + (int)(gv) >= 256) { found = true; bsel = (idx); cab = c; } else c += (int)(gv); }
            STEP_BIN(g7, 7) STEP_BIN(g6, 6) STEP_BIN(g5, 5) STEP_BIN(g4, 4) STEP_BIN(g3, 3) STEP_BIN(g2, 2) STEP_BIN(g1, 1) STEP_BIN(g0, 0)
#undef STEP_BIN
            if (!found) slow = true;
            bstar = 8 * Lc + bsel; need16 = 256 - cab;
        }
        if (lane == 0) { ctl[C_BSTAR + wave] = (unsigned)bstar; ctl[C_NEED + wave] = (unsigned)need16; if (slow) __hip_atomic_fetch_or(ctl + C_SLOW, 1u << wave, __ATOMIC_RELAXED, __HIP_MEMORY_SCOPE_WORKGROUP); }
    }
    __syncthreads();
    {
        int bs[4];
#pragma unroll
        for (int c = 0; c < 4; ++c) bs[c] = (int)ctl[C_BSTAR + 4 * (c >> 1) + 2 * hi + (c & 1)];
#pragma unroll
        for (int i = 0; i < 16; ++i) if (wave + 8 * i < ntile) {
            const int tt = wave + 8 * i;
#pragma unroll
            for (int c = 0; c < 4; ++c) { const int ql = 4 * (c >> 1) + 2 * hi + (c & 1);
                unsigned b = (unsigned)fmaf(sc[i][c], inv[c], 255.95f); b = b > 511u ? 511u : b;
                const bool v = (jrel + 256 * i) <= (4 * (c >> 1) + (c & 1));
                const unsigned long long bm = __ballot(v && (int)b > bs[c]);
                if (r32 == 0) maskL[ql * 128 + tt] = hi ? (unsigned)(bm >> 32) : (unsigned)bm;
                if (v && (int)b == bs[c]) { const unsigned pos = __hip_atomic_fetch_add(ctl + C_MCNT + ql, 1u, __ATOMIC_RELAXED, __HIP_MEMORY_SCOPE_WORKGROUP);
                    if (pos < 64u) mlist[ql * 64 + pos] = ((unsigned long long)mono(sc[i][c]) << 32) | (unsigned)(tt * 32 + r32); }
            }
        }
    }
    __syncthreads();
    {
        const int N = t0 + wave + 1;
        const bool slowq = (ctl[C_SLOW] >> wave) & 1u;
        if (N > 256 && !slowq) {
            const int cnt = (int)ctl[C_MCNT + wave];
            if (cnt > 64) { if (lane == 0) __hip_atomic_fetch_or(ctl + C_SLOW, 1u << wave, __ATOMIC_RELAXED, __HIP_MEMORY_SCOPE_WORKGROUP); }
            else {
                const unsigned long long e = lane < cnt ? mlist[wave * 64 + lane] : 0ull;
                const unsigned key = (unsigned)(e >> 32), idx = (unsigned)e; const bool have = lane < cnt;
                const int need16 = (int)ctl[C_NEED + wave];
                unsigned T = 0u;
#pragma unroll 1
                for (int bit = 31; bit >= 0; --bit) { const unsigned cand = T | (1u << bit); if ((int)__popcll(__ballot(have && key >= cand)) >= need16) T = cand; }
                const unsigned long long gtm = __ballot(have && key > T), eqm = __ballot(have && key == T);
                const int need_eq = need16 - (int)__popcll(gtm);
                bool sel = have && key > T;
                if ((int)__popcll(eqm) <= need_eq) sel = sel || (have && key == T);
                else {
                    int rank = 0; unsigned long long m = eqm;
                    while (m) { const int src = (int)__builtin_ctzll(m); m &= m - 1ull; const unsigned io = (unsigned)__shfl((int)idx, src); rank += (io < idx) ? 1 : 0; }
                    sel = sel || (have && key == T && rank < need_eq);
                }
                if (sel) __hip_atomic_fetch_or(maskL + wave * 128 + (idx >> 5), 1u << (idx & 31u), __ATOMIC_RELAXED, __HIP_MEMORY_SCOPE_WORKGROUP);
            }
        }
    }
    __syncthreads();
    {
        unsigned sm = (unsigned)__builtin_amdgcn_readfirstlane((int)ctl[C_SLOW]);
        while (sm) {
            const int q = (int)__builtin_ctz(sm); sm &= sm - 1u;
#pragma unroll
            for (int i = 0; i < 16; ++i) if (wave + 8 * i < ntile) {
#pragma unroll
                for (int c = 0; c < 4; ++c) if ((4 * (c >> 1) + 2 * hi + (c & 1)) == q && (jrel + 256 * i) <= (4 * (c >> 1) + (c & 1))) skeys[(wave + 8 * i) * 32 + r32] = mono(sc[i][c]);
            }
            __syncthreads();
            if (wave == 0) slow_query(skeys, maskL + q * 128, t0 + q + 1, lane);
            __syncthreads();
        }
    }
    { const int q = tid >> 6, w = 2 * (tid & 63); const v2u mw = *(const LAS v2u*)(maskL + q * 128 + w); *(v2u*)(maskb + (size_t)(t0 + q) * 128 + w) = mw; }
}
}
#ifndef SEL3_SLOWCNT
#define SEL3_SLOWCNT 64
#endif
namespace sel3 {
typedef float f32x16 __attribute__((ext_vector_type(16)));
typedef unsigned v2u __attribute__((ext_vector_type(2)));
constexpr int L_HIST = 0, L_MASK = 16384  , L_MLIST = 24576, L_CTL = 28672  , L_SKEYS = 0  , L_RING = 32768  , L_IQ = 131072  , L_END = 149504;
constexpr int C_AMAX = 0, C_MCNT = 8, C_BSTAR = 16, C_NEED = 24, C_SLOW = 32;
__device__ __forceinline__ unsigned mono(float s) { const unsigned u = __float_as_uint(s + 0.0f); return (u & 0x80000000u) ? ~u : (u | 0x80000000u); }

__device__ __forceinline__ void slow_query(const LAS unsigned* skeys, LAS unsigned* maskrow, int N, int lane) {
    const int R = (N + 63) >> 6;
    unsigned kr[64];
#pragma unroll
    for (int r = 0; r < 64; ++r) { const int j = 64 * r + lane; kr[r] = (r < R && j < N) ? skeys[j] : 0u; }
    unsigned T = 0u;
#define CNT_GE(cand, out) do { int c_ = 0; _Pragma("unroll") for (int g8 = 0; g8 < 8; ++g8) if (g8 * 8 < R) { _Pragma("unroll") for (int q = 0; q < 8; ++q) c_ += (int)__popcll(__builtin_amdgcn_ballot_w64(kr[g8 * 8 + q] >= (cand))); } (out) = c_; } while (0)
#pragma unroll 1
    for (int bit = 31; bit >= 0; --bit) { const unsigned cand = T | (1u << bit); int cnt; CNT_GE(cand, cnt); if (cnt >= 256) T = cand; }
    int gt; { const unsigned c4 = T + 1u; CNT_GE(c4, gt); }
#undef CNT_GE
    const int need = 256 - gt;
    int base = 0;
#pragma unroll
    for (int r = 0; r < 64; ++r) {
        const unsigned long long gtm = __builtin_amdgcn_ballot_w64(kr[r] > T); unsigned long long eqm = __builtin_amdgcn_ballot_w64(kr[r] == T && (64 * r + lane) < N);
        int c = (int)__popcll(eqm);
        if (base + c > need) { int keep = need - base; keep = keep < 0 ? 0 : keep; while (c > keep) { eqm &= ~(1ull << (63 - __clzll((long long)eqm))); --c; } }
        base += c; const unsigned long long sel = gtm | eqm;
        if (lane == 0) { maskrow[2 * r] = (unsigned)sel; maskrow[2 * r + 1] = (unsigned)(sel >> 32); }
    }
}

__device__ __forceinline__ void glds16_asm(const void* g, unsigned lds_base) {
    unsigned sv; asm volatile("s_mov_b32 %0, m0\n\ts_mov_b32 m0, %2\n\ts_nop 0\n\tglobal_load_lds_dwordx4 %1, off\n\ts_mov_b32 m0, %0" : "=&s"(sv) : "v"(g), "s"(lds_base) : "memory"); }
constexpr int KSEL0 = 64, KEND = 64 + 512;
__device__ __forceinline__ void dsa_select_stream(LAS unsigned char* lds, volatile LAS unsigned* MISC, gu32* qcnt, const bf16* __restrict__ proj, const bf16* __restrict__ KI, const float* __restrict__ WI, unsigned* __restrict__ maskp, int kfirst, int bb) {
    int tid_o = threadIdx.x; asm volatile("" : "+v"(tid_o));
    const int tid0 = tid_o;
    LAS unsigned* hist = (LAS unsigned*)(lds + L_HIST);
    LAS unsigned long long* mlist = (LAS unsigned long long*)(lds + L_MLIST);
    LAS unsigned* skeys = (LAS unsigned*)(lds + L_SKEYS);
    __syncthreads();
    { unsigned z0_ = 0u; asm volatile("" : "+v"(z0_)); const v4u z = {z0_, z0_, z0_, z0_};     *(LAS v4u*)(hist + tid0 * 8) = z; *(LAS v4u*)(hist + tid0 * 8 + 4) = z; *(LAS v4u*)((LAS unsigned*)(lds + L_MASK) + tid0 * 4) = z; if (tid0 < 128) ((LAS unsigned*)(lds + L_CTL))[tid0] = 0u; }
    unsigned pend = 0u;
    if (tid0 == 0) pend = __hip_atomic_fetch_add(qcnt, 1u, __ATOMIC_RELAXED, __HIP_MEMORY_SCOPE_AGENT);
    bf16x8 aq[2][4];
    LAS float* wvL = (LAS float*)(lds + L_CTL + 512);
#define STAGE_OPERANDS(parity, kk) do { const int k2_ = (kk) - KSEL0, b_ = bb, t0_ = 8 * (511 - k2_); const int q_ = tid >> 6, pc_ = tid & 63; \
        const v4u v_ = *(const v4u*)(proj + ((size_t)b_ * SEQ + t0_ + q_) * NINP + PC_IQ + pc_ * 8); \
        *(LAS v4u*)(lds + L_IQ + (parity) * 9216 + (q_ * 8 + (pc_ >> 3)) * 144 + (pc_ & 7) * 16) = v_; \
        if (tid < 64) wvL[(parity) * 64 + tid] = WI[((size_t)b_ * SEQ + t0_) * 8 + tid]; } while (0)
    { const int tid = tid0; STAGE_OPERANDS(0, kfirst); }
    __syncthreads();
    int kcur = kfirst;
    bool pre = false;
#pragma unroll 1
    for (int par = 0; ; par ^= 1) {
    if (tid0 == 0) MISC[17] = pend;
    int tid_i = tid0; asm volatile("" : "+v"(tid_i)); const int tid = tid_i;
    const int lane = tid_i & 63, wave = __builtin_amdgcn_readfirstlane(tid_i >> 6), r32 = lane & 31, hi = lane >> 5;
    const int a_ql = 2 * ((r32 >> 2) & 1) + (r32 >> 4), a_head = 4 * ((r32 >> 3) & 1) + (r32 & 3);
    const int k2 = kcur - KSEL0, t0 = 8 * (511 - k2);
    const bf16* KIb = KI + (size_t)bb * SEQ * 64; unsigned* maskb = maskp + (size_t)bb * SEQ * 128;
    LAS unsigned* maskL = (LAS unsigned*)(lds + L_MASK) + par * 1024;
    LAS unsigned* ctl = (LAS unsigned*)(lds + L_CTL) + par * 64;
    { unsigned z0_ = 0u; asm volatile("" : "+v"(z0_)); const v4u z = {z0_, z0_, z0_, z0_};     *(LAS v4u*)(hist + tid * 8) = z; *(LAS v4u*)(hist + tid * 8 + 4) = z; *(LAS v2u*)(maskL + tid * 2) = (v2u){z0_, z0_}; }
    const int ntile = (t0 + 8 + 31) >> 5;
    const int jl = wave * 32 + r32;
    const int jrel = jl - t0 - 2 * hi;
#pragma unroll
    for (int rt = 0; rt < 2; ++rt)
#pragma unroll
        for (int s = 0; s < 4; ++s) aq[rt][s] = *(const LAS bf16x8*)(lds + L_IQ + par * 9216 + ((4 * rt + a_ql) * 8 + a_head) * 144 + (16 * s + 8 * hi) * 2);
    f32x4 wvr[4][2];
#pragma unroll
    for (int c = 0; c < 4; ++c) { wvr[c][0] = *(const LAS f32x4*)(wvL + par * 64 + (4 * (c >> 1) + 2 * hi + (c & 1)) * 8); wvr[c][1] = *(const LAS f32x4*)(wvL + par * 64 + (4 * (c >> 1) + 2 * hi + (c & 1)) * 8 + 4); }
    float sc[16][4]; float mx[4] = {0.f, 0.f, 0.f, 0.f};
    {
    const GAS bf16* kbase = (const GAS bf16*)KIb + (size_t)wave * 2048 + lane * 8;
    const GAS bf16* kptr = kbase;
    bf16x8 kq[2][4];
#define KLOAD(set, on) do { const GAS bf16* kp_ = (on) ? kptr : kbase; \
        asm volatile("global_load_dwordx4 %0, %4, off\n\tglobal_load_dwordx4 %1, %4, off offset:1024\n\tglobal_load_dwordx4 %2, %4, off offset:2048\n\tglobal_load_dwordx4 %3, %4, off offset:3072" \
                     : "=&v"(kq[set][0]), "=&v"(kq[set][1]), "=&v"(kq[set][2]), "=&v"(kq[set][3]) : "v"(kp_) : "memory"); } while (0)
#define KWAIT(set, n) asm volatile("s_waitcnt vmcnt(" #n ")" : "+v"(kq[set][0]), "+v"(kq[set][1]), "+v"(kq[set][2]), "+v"(kq[set][3]) :: "memory")
    if (wave < ntile) { KLOAD(0, true); kptr += 8 * 2048; asm volatile("" : "+v"(kptr)); KLOAD(1, wave + 8 < ntile); kptr += 8 * 2048; asm volatile("" : "+v"(kptr)); }
#pragma unroll
    for (int i = 0; i < 16; ++i) {
        const int tt = wave + 8 * i;
        if (tt < ntile) {
            const bool a2 = (i + 2 < 16) && (tt + 16 < ntile);
            const bool allv = (tt * 32 + 31) <= t0;
            f32x16 acc0, acc1;
#pragma unroll
            for (int r = 0; r < 16; ++r) { acc0[r] = 0.f; acc1[r] = 0.f; }
            if (i & 1) KWAIT(1, 4); else KWAIT(0, 4);
#pragma unroll
            for (int s = 0; s < 4; ++s) { acc0 = __builtin_amdgcn_mfma_f32_32x32x16_bf16(aq[0][s], kq[i & 1][s], acc0, 0, 0, 0); acc1 = __builtin_amdgcn_mfma_f32_32x32x16_bf16(aq[1][s], kq[i & 1][s], acc1, 0, 0, 0); }
            if (i & 1) KLOAD(1, a2); else KLOAD(0, a2);
            kptr += 8 * 2048; asm volatile("" : "+v"(kptr));
#pragma unroll
            for (int rt = 0; rt < 2; ++rt) {
                const f32x16& acc = rt ? acc1 : acc0;
#pragma unroll
                for (int w2 = 0; w2 < 2; ++w2) { const int c = 2 * rt + w2;
                    const f32x4 wa = wvr[c][0], wb = wvr[c][1];
#define RELU1(a_) __int_as_float(max(__float_as_int(a_), 0))
#define FMAC(acc_, a_, b_) asm("v_fmac_f32 %0, %1, %2" : "+v"(acc_) : "v"(a_), "v"(b_))
                    float e0 = RELU1(acc[8 * w2 + 0]) * wa[0], e1 = RELU1(acc[8 * w2 + 1]) * wa[1];
                    asm volatile("" : "+v"(e0), "+v"(e1));
                    { float r2 = RELU1(acc[8 * w2 + 2]), r3 = RELU1(acc[8 * w2 + 3]), r4 = RELU1(acc[8 * w2 + 4]), r5 = RELU1(acc[8 * w2 + 5]), r6 = RELU1(acc[8 * w2 + 6]), r7 = RELU1(acc[8 * w2 + 7]);
                      FMAC(e0, r2, wa[2]); FMAC(e1, r3, wa[3]); FMAC(e0, r4, wb[0]); FMAC(e1, r5, wb[1]); FMAC(e0, r6, wb[2]); FMAC(e1, r7, wb[3]); }
#undef RELU1
#undef FMAC
                    sc[i][c] = e0 + e1;
                }
            }
            if (allv) {
#pragma unroll
                for (int c = 0; c < 4; ++c) mx[c] = __builtin_elementwise_maximum(mx[c], fabsf(sc[i][c]));
            } else { asm volatile("" ::: "memory");
#pragma unroll
                for (int c = 0; c < 4; ++c) { const bool v = (jrel + 256 * i) <= (4 * (c >> 1) + (c & 1)); const float s_ = sc[i][c]; sc[i][c] = v ? s_ : -3.0e38f; mx[c] = __builtin_elementwise_maximum(mx[c], v ? fabsf(s_) : 0.f); }
            }
        } else {
#pragma unroll
            for (int c = 0; c < 4; ++c) sc[i][c] = 0.f;
        }
    }
    asm volatile("s_waitcnt vmcnt(0)" : "+v"(kq[0][0]), "+v"(kq[0][1]), "+v"(kq[0][2]), "+v"(kq[0][3]), "+v"(kq[1][0]), "+v"(kq[1][1]), "+v"(kq[1][2]), "+v"(kq[1][3]) :: "memory");
#undef KLOAD
#undef KWAIT
    }
#pragma unroll
    for (int c = 0; c < 4; ++c) __hip_atomic_fetch_max(ctl + C_AMAX + 4 * (c >> 1) + 2 * hi + (c & 1), __float_as_uint(mx[c]), __ATOMIC_RELAXED, __HIP_MEMORY_SCOPE_WORKGROUP);
    __syncthreads();
    const int knext = (int)MISC[17];
    if (tid0 == 0) pend = __hip_atomic_fetch_add(qcnt, 1u, __ATOMIC_RELAXED, __HIP_MEMORY_SCOPE_AGENT);
    v4u st_iq = {0u, 0u, 0u, 0u}; float st_w = 0.f;
    if (knext < KEND) { const int t0n_ = 8 * (511 - (knext - KSEL0)); const int q_ = tid >> 6, pc_ = tid & 63;
        st_iq = *(const v4u*)(proj + ((size_t)bb * SEQ + t0n_ + q_) * NINP + PC_IQ + pc_ * 8);
        if (tid < 64) st_w = WI[((size_t)bb * SEQ + t0n_) * 8 + tid]; }
    bool pre_n = false;
    if (false) {
        const int ntn = (8 * (511 - (knext - KSEL0)) + 8 + 31) >> 5;
        LAS unsigned char* ring = lds + L_RING + wave * 12288; const bf16* kptr = KIb + (size_t)wave * 2048 + lane * 8;
        const unsigned rbase = (unsigned)__builtin_amdgcn_readfirstlane((int)(unsigned)(unsigned long long)(LAS unsigned char*)ring);
#define DMA_TILE_N(slot, off) do { _Pragma("unroll") for (int s = 0; s < 4; ++s) glds16_asm(kptr + (off) + 512 * s, rbase + (slot) * 4096 + s * 1024); } while (0)
        if (wave < ntn) DMA_TILE_N(0, 0);
        if (wave + 8 < ntn) DMA_TILE_N(1, 16384);
        if (wave + 16 < ntn) DMA_TILE_N(2, 32768);
#undef DMA_TILE_N
        pre_n = true;
    }
    if (tid < 64) ((LAS unsigned*)(lds + L_CTL) + (par ^ 1) * 64)[tid] = 0u;
    float inv[4];
#pragma unroll
    for (int c = 0; c < 4; ++c) { const float am = __uint_as_float(ctl[C_AMAX + 4 * (c >> 1) + 2 * hi + (c & 1)]); inv[c] = (am > 0.f && am < 3.0e38f) ? 255.95f * __builtin_amdgcn_rcpf(am) : 0.f; }
    LAS unsigned* hrow[4];
#pragma unroll
    for (int c = 0; c < 4; ++c) { hrow[c] = hist + (4 * (c >> 1) + 2 * hi + (c & 1)) * 512; asm volatile("" : "+v"(hrow[c])); }
#pragma unroll
    for (int i = 0; i < 16; ++i) if (wave + 8 * i < ntile) {
#pragma unroll
        for (int c = 0; c < 4; ++c) { unsigned b = (unsigned)fmaf(sc[i][c], inv[c], 255.95f); b = b > 511u ? 511u : b;
            __hip_atomic_fetch_add(hrow[c] + b, 1u, __ATOMIC_RELAXED, __HIP_MEMORY_SCOPE_WORKGROUP); }
    }
#ifndef SEL3_REP_B
#define SEL3_REP_B 0
#endif
    for (int rb_ = 0; rb_ < SEL3_REP_B; ++rb_) {
#pragma unroll
        for (int i = 0; i < 16; ++i) if (wave + 8 * i < ntile) {
#pragma unroll
            for (int c = 0; c < 4; ++c) { unsigned b = (unsigned)fmaf(sc[i][c], inv[c], 255.95f); b = b > 511u ? 511u : b;
                __hip_atomic_fetch_add(hrow[c] + 8192 + b, 1u, __ATOMIC_RELAXED, __HIP_MEMORY_SCOPE_WORKGROUP); }
        }
    }
    if (knext < KEND) { const int q_ = tid >> 6, pc_ = tid & 63;
        *(LAS v4u*)(lds + L_IQ + (par ^ 1) * 9216 + (q_ * 8 + (pc_ >> 3)) * 144 + (pc_ & 7) * 16) = st_iq;
        if (tid < 64) wvL[(par ^ 1) * 64 + tid] = st_w; }
    __syncthreads();
    {
        const int N = t0 + wave + 1;
        int bstar = -1, need16 = 0; bool slow = false;
        if (N > 256) {
            const float am = __uint_as_float(ctl[C_AMAX + wave]);
            slow = !(am > 0.f && am < 3.0e38f);
            const LAS unsigned* hq = hist + wave * 512;
            const v4u h0 = *(const LAS v4u*)(hq + 8 * lane), h1 = *(const LAS v4u*)(hq + 8 * lane + 4);
            const unsigned own = (h0.x + h0.y) + (h0.z + h0.w) + (h1.x + h1.y) + (h1.z + h1.w);
            unsigned suf = own;
#define SUF_STEP(ctrl) suf += (unsigned)__builtin_amdgcn_update_dpp(0, (int)suf, ctrl, 0xf, 0xf, false)
            SUF_STEP(0x101); SUF_STEP(0x102); SUF_STEP(0x104); SUF_STEP(0x108);
#undef SUF_STEP
            { const unsigned t1 = (unsigned)__builtin_amdgcn_readlane((int)suf, 16), t2 = (unsigned)__builtin_amdgcn_readlane((int)suf, 32), t3 = (unsigned)__builtin_amdgcn_readlane((int)suf, 48);
              suf += lane < 16 ? t1 + t2 + t3 : lane < 32 ? t2 + t3 : lane < 48 ? t3 : 0u; }
            const int L = (int)__popcll(__builtin_amdgcn_ballot_w64(suf >= 256u)) - 1;
            if (L < 0) slow = true;
            const int Lc = L < 0 ? 0 : L;
            int c = __builtin_amdgcn_readlane((int)(suf - own), Lc);
            const unsigned g0 = (unsigned)__builtin_amdgcn_readlane((int)h0.x, Lc), g1 = (unsigned)__builtin_amdgcn_readlane((int)h0.y, Lc), g2 = (unsigned)__builtin_amdgcn_readlane((int)h0.z, Lc), g3 = (unsigned)__builtin_amdgcn_readlane((int)h0.w, Lc),
                           g4 = (unsigned)__builtin_amdgcn_readlane((int)h1.x, Lc), g5 = (unsigned)__builtin_amdgcn_readlane((int)h1.y, Lc), g6 = (unsigned)__builtin_amdgcn_readlane((int)h1.z, Lc), g7 = (unsigned)__builtin_amdgcn_readlane((int)h1.w, Lc);
            int bsel = 0, cab = c; bool found = false;
#define STEP_BIN(gv, idx) if (!found) { if (c + (int)(gv) >= 256) { found = true; bsel = (idx); cab = c; } else c += (int)(gv); }
            STEP_BIN(g7, 7) STEP_BIN(g6, 6) STEP_BIN(g5, 5) STEP_BIN(g4, 4) STEP_BIN(g3, 3) STEP_BIN(g2, 2) STEP_BIN(g1, 1) STEP_BIN(g0, 0)
#undef STEP_BIN
            if (!found) slow = true;
            bstar = 8 * Lc + bsel; need16 = 256 - cab;
        }
        if (lane == 0) { ctl[C_BSTAR + wave] = (unsigned)bstar; ctl[C_NEED + wave] = (unsigned)need16; if (slow) __hip_atomic_fetch_or(ctl + C_SLOW, 1u << wave, __ATOMIC_RELAXED, __HIP_MEMORY_SCOPE_WORKGROUP); }
    }
    __syncthreads();
    {
        int bs[4];
        LAS unsigned* mrow[4];
#pragma unroll
        for (int c = 0; c < 4; ++c) { mrow[c] = maskL + (4 * (c >> 1) + 2 * hi + (c & 1)) * 128; asm volatile("" : "+v"(mrow[c])); }
#pragma unroll
        for (int c = 0; c < 4; ++c) bs[c] = (int)ctl[C_BSTAR + 4 * (c >> 1) + 2 * hi + (c & 1)];
#pragma unroll
        for (int i = 0; i < 16; ++i) if (wave + 8 * i < ntile) {
            const int tt = wave + 8 * i;
            const bool allv = (tt * 32 + 31) <= t0;
            unsigned b4[4]; unsigned long long bm4[4];
#pragma unroll
            for (int c = 0; c < 4; ++c) { unsigned b = (unsigned)fmaf(sc[i][c], inv[c], 255.95f); b4[c] = b > 511u ? 511u : b;
                bm4[c] = __builtin_amdgcn_ballot_w64((int)b4[c] > bs[c]); }
            bool mem4[4];
#pragma unroll
            for (int c = 0; c < 4; ++c) mem4[c] = ((int)b4[c] == bs[c]);
            if (!allv) { asm volatile("" ::: "memory");
#pragma unroll
                for (int c = 0; c < 4; ++c) { const bool v = (jrel + 256 * i) <= (4 * (c >> 1) + (c & 1));
                    bm4[c] &= __builtin_amdgcn_ballot_w64(v);
                    mem4[c] = mem4[c] && v; }
            }
#pragma unroll
            for (int c = 0; c < 4; ++c) mrow[c][tt] = hi ? (unsigned)(bm4[c] >> 32) : (unsigned)bm4[c];
            if (__builtin_amdgcn_ballot_w64(mem4[0] || mem4[1] || mem4[2] || mem4[3]) != 0ull) {
                unsigned pos4[4];
#pragma unroll
                for (int c = 0; c < 4; ++c) { pos4[c] = 64u; if (mem4[c]) pos4[c] = __hip_atomic_fetch_add(ctl + C_MCNT + 4 * (c >> 1) + 2 * hi + (c & 1), 1u, __ATOMIC_RELAXED, __HIP_MEMORY_SCOPE_WORKGROUP); }
#pragma unroll
                for (int c = 0; c < 4; ++c) if (mem4[c] && pos4[c] < 64u) mlist[(4 * (c >> 1) + 2 * hi + (c & 1)) * 64 + pos4[c]] = ((unsigned long long)mono(sc[i][c]) << 32) | (unsigned)(tt * 32 + r32);
            }
        }
    }
    __syncthreads();
    {
        const int N = t0 + wave + 1;
        const bool slowq = (ctl[C_SLOW] >> wave) & 1u;
        if (N > 256 && !slowq) {
            const int cnt = (int)ctl[C_MCNT + wave];
            if (cnt > SEL3_SLOWCNT) { if (lane == 0) __hip_atomic_fetch_or(ctl + C_SLOW, 1u << wave, __ATOMIC_RELAXED, __HIP_MEMORY_SCOPE_WORKGROUP); }
            else {
                const unsigned long long e = lane < cnt ? mlist[wave * 64 + lane] : 0ull;
                const unsigned key = (unsigned)(e >> 32), idx = (unsigned)e; const bool have = lane < cnt;
                const int need16 = (int)ctl[C_NEED + wave];
                unsigned T = 0u;
#pragma unroll 1
                for (int bit = 31; bit >= 0; --bit) { const unsigned cand = T | (1u << bit); if ((int)__popcll(__builtin_amdgcn_ballot_w64(have && key >= cand)) >= need16) T = cand; }
                const unsigned long long gtm = __builtin_amdgcn_ballot_w64(have && key > T), eqm = __builtin_amdgcn_ballot_w64(have && key == T);
                const int need_eq = need16 - (int)__popcll(gtm);
                bool sel = have && key > T;
                if ((int)__popcll(eqm) <= need_eq) sel = sel || (have && key == T);
                else {
                    int rank = 0; unsigned long long m = eqm;
                    while (m) { const int src = (int)__builtin_ctzll(m); m &= m - 1ull; const unsigned io = (unsigned)__shfl((int)idx, src); rank += (io < idx) ? 1 : 0; }
                    sel = sel || (have && key == T && rank < need_eq);
                }
                if (sel) __hip_atomic_fetch_or(maskL + wave * 128 + (idx >> 5), 1u << (idx & 31u), __ATOMIC_RELAXED, __HIP_MEMORY_SCOPE_WORKGROUP);
            }
        }
    }
    __syncthreads();
    {
        unsigned sm = (unsigned)__builtin_amdgcn_readfirstlane((int)ctl[C_SLOW]);
        while (sm) {
            const int q = (int)__builtin_ctz(sm); sm &= sm - 1u;
            int jrel_o = jrel; asm volatile("" : "+v"(jrel_o));
#pragma unroll
            for (int i = 0; i < 16; ++i) if (wave + 8 * i < ntile) {
#pragma unroll
                for (int c = 0; c < 4; ++c) if ((4 * (c >> 1) + 2 * hi + (c & 1)) == q && (jrel_o + 256 * i) <= (4 * (c >> 1) + (c & 1))) { float sv_ = sc[i][c]; asm volatile("" : "+v"(sv_)); skeys[(wave + 8 * i) * 32 + r32] = mono(sv_); }
            }
            __syncthreads();
            if (wave == 0) slow_query(skeys, maskL + q * 128, t0 + q + 1, lane);
            __syncthreads();
        }
    }
    { const int q = tid & 7, w = tid >> 3; maskb[(size_t)w * SEQ + t0 + q] = maskL[q * 128 + w]; maskb[(size_t)(w + 64) * SEQ + t0 + q] = maskL[q * 128 + w + 64]; }
    if (knext >= KEND) break;
    kcur = knext; pre = pre_n;
    }
#undef STAGE_OPERANDS
    __syncthreads();
}
}
namespace hgrn {
typedef float f32x16 __attribute__((ext_vector_type(16)));
typedef unsigned v2u __attribute__((ext_vector_type(2)));
typedef short s16x4 __attribute__((ext_vector_type(4)));
__device__ __forceinline__ int crow(int r, int hi) { return (r & 3) + 8 * (r >> 2) + 4 * hi; }
constexpr int PPITCH = 264;
constexpr int PREP_LDS_PER_WAVE = 2 * 32 * PPITCH;

__device__ __forceinline__ bf16x8 ld_frag2(const bf16* p0, const bf16* p1) {
    const s16x4 a = *(const s16x4*)p0, b = *(const s16x4*)p1; return (bf16x8){a[0], a[1], a[2], a[3], b[0], b[1], b[2], b[3]};
}
__device__ __forceinline__ bf16x8 ld_frag2_lds(const LAS unsigned char* p0, const LAS unsigned char* p1) {
    const s16x4 a = *(const LAS s16x4*)p0, b = *(const LAS s16x4*)p1; return (bf16x8){a[0], a[1], a[2], a[3], b[0], b[1], b[2], b[3]};
}

template <bool DRY = false> __device__ __forceinline__ void prep_unit(LAS unsigned char* scr  , bf16* __restrict__ proj, const float* __restrict__ lbt  ,
                                          bf16* __restrict__ KSTT, float* __restrict__ DECAY, bf16* __restrict__ AT, int u, int lane) {
    const int hh = u & 3, cn = u >> 2;
    const size_t m0 = (size_t)cn * 32;
    const int k0 = 2 * lane, c0 = hh * 128 + k0;
    const float lb0 = lbt[c0], lb1 = lbt[c0 + 1];
    bf16* rowq = proj + m0 * NINP + PC_HQ + c0; bf16* rowf = proj + m0 * NINP + PC_HF + c0; bf16* rowi = proj + m0 * NINP + PC_HI + c0;
    LAS unsigned char* sq = scr; LAS unsigned char* sk = scr + 32 * PPITCH;
    float g0 = 0.f, g1 = 0.f;
    unsigned kiv[32];
    unsigned vtk[16];
    const float ol0 = 1.0f - lb0, ol1 = 1.0f - lb1;
    unsigned wfa[2][16], wqa[2][16], wia[2][16];
#pragma unroll
    for (int hf = 0; hf < 2; ++hf)
#pragma unroll
        for (int t = 0; t < 16; ++t) { const size_t ro = (size_t)(16 * hf + t) * NINP; wfa[hf][t] = *(const unsigned*)(rowf + ro); wqa[hf][t] = *(const unsigned*)(rowq + ro); wia[hf][t] = *(const unsigned*)(rowi + ro); }
#pragma unroll
    for (int hf = 0; hf < 2; ++hf) {
        unsigned (&wf)[16] = wfa[hf]; unsigned (&wq)[16] = wqa[hf]; unsigned (&wi)[16] = wia[hf];
        unsigned vt0[8], vt1[8];
#pragma unroll
        for (int t = 0; t < 16; ++t) {
            const float f0 = __uint_as_float(wf[t] << 16), f1 = __uint_as_float(wf[t] & 0xffff0000u), q0 = __uint_as_float(wq[t] << 16) * 0.08838834764831845f, q1 = __uint_as_float(wq[t] & 0xffff0000u) * 0.08838834764831845f;
            const float s0 = __builtin_amdgcn_rcpf(1.0f + __expf(-f0)), s1 = __builtin_amdgcn_rcpf(1.0f + __expf(-f1));
            const float kk0 = ol0 * (1.0f - s0), kk1 = ol1 * (1.0f - s1);
            g0 += __logf(lb0 + ol0 * s0); g1 += __logf(lb1 + ol1 * s1);
            const float e0 = __expf(g0), e1 = __expf(g1);
            const unsigned qd = att::cvtpk(q0 * e0, q1 * e1), ki = att::cvtpk(kk0 * __builtin_amdgcn_rcpf(e0), kk1 * __builtin_amdgcn_rcpf(e1));
            wq[t] = qd; kiv[16 * hf + t] = ki;
            *(LAS unsigned*)(sq + (16 * hf + t) * PPITCH + 4 * lane) = qd; *(LAS unsigned*)(sk + (16 * hf + t) * PPITCH + 4 * lane) = ki;
            if (t & 1) { vt0[t >> 1] = (wi[t - 1] & 0xffffu) | (wi[t] << 16); vt1[t >> 1] = (wi[t - 1] >> 16) | (wi[t] & 0xffff0000u); }
        }
#pragma unroll
        for (int t = 0; t < 16; ++t) if (!DRY) *(unsigned*)(rowq + (size_t)(16 * hf + t) * NINP) = wq[t];
        if (hf == 0) { vtk[0] = vt0[0]; vtk[1] = vt0[1]; vtk[2] = vt0[2]; vtk[3] = vt0[3]; vtk[4] = vt0[4]; vtk[5] = vt0[5]; vtk[6] = vt0[6]; vtk[7] = vt0[7];
                       vtk[8] = vt1[0]; vtk[9] = vt1[1]; vtk[10] = vt1[2]; vtk[11] = vt1[3]; vtk[12] = vt1[4]; vtk[13] = vt1[5]; vtk[14] = vt1[6]; vtk[15] = vt1[7]; }
        else if (!DRY) {
            v4u* d0 = (v4u*)(proj + (m0 + (k0 >> 2)) * NINP + PC_HI + hh * 128 + (k0 & 3) * 32); v4u* d1 = d0 + 4;
            d0[0] = (v4u){vtk[0], vtk[1], vtk[2], vtk[3]}; d0[1] = (v4u){vtk[4], vtk[5], vtk[6], vtk[7]}; d0[2] = (v4u){vt0[0], vt0[1], vt0[2], vt0[3]}; d0[3] = (v4u){vt0[4], vt0[5], vt0[6], vt0[7]};
            d1[0] = (v4u){vtk[8], vtk[9], vtk[10], vtk[11]}; d1[1] = (v4u){vtk[12], vtk[13], vtk[14], vtk[15]}; d1[2] = (v4u){vt1[0], vt1[1], vt1[2], vt1[3]}; d1[3] = (v4u){vt1[4], vt1[5], vt1[6], vt1[7]};
        }
    }
    {
        const float dc0 = __expf(g0), dc1 = __expf(g1);
        *(v2u*)(DECAY + (size_t)u * 128 + k0) = (v2u){__float_as_uint(dc0), __float_as_uint(dc1)};
        unsigned ks0[16], ks1[16];
#pragma unroll
        for (int tp = 0; tp < 16; ++tp) { const unsigned a = kiv[2 * tp], bq = kiv[2 * tp + 1];
            ks0[tp] = att::cvtpk(__uint_as_float(a << 16) * dc0, __uint_as_float(bq << 16) * dc0);
            ks1[tp] = att::cvtpk(__uint_as_float(a & 0xffff0000u) * dc1, __uint_as_float(bq & 0xffff0000u) * dc1); }
        v4u* d0 = (v4u*)(KSTT + ((size_t)u * 128 + k0) * 32); v4u* d1 = d0 + 4;
#pragma unroll
        for (int i = 0; i < 4; ++i) { d0[i] = (v4u){ks0[4 * i], ks0[4 * i + 1], ks0[4 * i + 2], ks0[4 * i + 3]}; d1[i] = (v4u){ks1[4 * i], ks1[4 * i + 1], ks1[4 * i + 2], ks1[4 * i + 3]}; }
    }
    asm volatile("s_waitcnt lgkmcnt(0)" ::: "memory");
    const int r32 = lane & 31, hi = lane >> 5;
    f32x16 acc;
#pragma unroll
    for (int r = 0; r < 16; ++r) acc[r] = 0.f;
#pragma unroll
    for (int s = 0; s < 8; ++s) {
        const bf16x8 a = ld_frag2_lds(sk + r32 * PPITCH + (16 * s + 8 * hi) * 2, sk + r32 * PPITCH + (16 * s + 8 * hi) * 2 + 8);
        const bf16x8 bq = ld_frag2_lds(sq + r32 * PPITCH + (16 * s + 8 * hi) * 2, sq + r32 * PPITCH + (16 * s + 8 * hi) * 2 + 8);
        acc = __builtin_amdgcn_mfma_f32_32x32x16_bf16(a, bq, acc, 0, 0, 0);
    }
    bf16* ao = AT + (size_t)u * 1024 + r32 * 32;
#pragma unroll
    for (int g = 0; g < 4; ++g) { float x[4];
#pragma unroll
        for (int e = 0; e < 4; ++e) { const int s = 8 * g + 4 * hi + e; x[e] = (s <= r32) ? acc[4 * g + e] : 0.f; }
        v2u w; w.x = att::cvtpk(x[0], x[1]); w.y = att::cvtpk(x[2], x[3]); *(v2u*)(ao + 8 * g + 4 * hi) = w; }
    asm volatile("s_waitcnt lgkmcnt(0)" ::: "memory");
}

constexpr int CP_Q = 264, CP_V = 72;
constexpr int CO_QD = 0, CO_VT = CO_QD + 32 * CP_Q, CO_KS = CO_VT + 128 * CP_V, CO_GT = CO_KS + 128 * CP_V, CO_A = CO_GT + 32 * CP_Q, CO_DC = CO_A + 32 * CP_V, CH_PAIR = CO_DC + 512;
constexpr int CH_STAGE = 2 * CH_PAIR, CH_XCH = 2 * CH_STAGE, CH_LDS = CH_XCH + 2048;
__device__ __forceinline__ void st16(LAS unsigned char* p, const v4u v) { *(LAS v2u*)p = (v2u){v.x, v.y}; *(LAS v2u*)(p + 8) = (v2u){v.z, v.w}; }
__device__ __forceinline__ bf16x8 ldl2(const LAS unsigned char* p0, const LAS unsigned char* p1) { const s16x4 a = *(const LAS s16x4*)p0, b = *(const LAS s16x4*)p1; return (bf16x8){a[0], a[1], a[2], a[3], b[0], b[1], b[2], b[3]}; }

__device__ __forceinline__ void chain(LAS unsigned char* lds, const bf16* __restrict__ proj, const bf16* __restrict__ KSTT, const float* __restrict__ DECAY, const bf16* __restrict__ AT,
                                      const float* __restrict__ nw  , bf16* __restrict__ mixed, int pair0, int npairs  ) {
    int tid_o = threadIdx.x; asm volatile("" : "+v"(tid_o));
    const int tid = tid_o, lane = tid & 63, wave = __builtin_amdgcn_readfirstlane(tid >> 6), r32 = lane & 31, hi = lane >> 5;
    const int pr = wave >> 2; const bool active = pr < npairs; const int bh = pair0 + (active ? pr : 0), b = bh >> 2, hh = bh & 3, vs = wave & 3;
    const int t256 = tid & 255;
    LAS float* xch = (LAS float*)(lds + CH_XCH);
    f32x16 S[4];
#pragma unroll
    for (int kt = 0; kt < 4; ++kt)
#pragma unroll
        for (int r = 0; r < 16; ++r) S[kt][r] = 0.f;
    float nwv[16];
#pragma unroll
    for (int r = 0; r < 16; ++r) nwv[r] = nw[vs * 32 + crow(r, hi)];
    const int vcol = vs * 32 + r32;
    v4u gq[2], gg[2], gv[2], gk[2], ga;
    auto issue = [&](int n) {
        if (!active) return;
        const int cn = b * 128 + n, u = cn * 4 + hh; const size_t m0 = (size_t)cn * 32;
#pragma unroll
        for (int i = 0; i < 2; ++i) { const int p = t256 + 256 * i;
            gq[i] = *(const v4u*)(proj + (m0 + (p >> 4)) * NINP + PC_HQ + hh * 128 + (p & 15) * 8);
            gg[i] = *(const v4u*)(proj + (m0 + (p >> 4)) * NINP + PC_HG + hh * 128 + (p & 15) * 8);
            gv[i] = *(const v4u*)(proj + (m0 + (p >> 4)) * NINP + PC_HI + hh * 128 + (p & 15) * 8);
            gk[i] = *(const v4u*)(KSTT + (size_t)u * 4096 + p * 8); }
        if (t256 < 128) ga = *(const v4u*)(AT + (size_t)u * 1024 + t256 * 8);
        else if (t256 < 160) ga = *(const v4u*)(DECAY + (size_t)u * 128 + (t256 - 128) * 4);
    };
    auto commit = [&](int stage) {
        if (!active) return;
        LAS unsigned char* st = lds + stage * CH_STAGE + pr * CH_PAIR;
#pragma unroll
        for (int i = 0; i < 2; ++i) { const int p = t256 + 256 * i;
            st16(st + CO_QD + (p >> 4) * CP_Q + (p & 15) * 16, gq[i]);
            st16(st + CO_GT + (p >> 4) * CP_Q + (p & 15) * 16, gg[i]);
            st16(st + CO_VT + (4 * (p >> 4) + ((p & 15) >> 2)) * CP_V + (p & 3) * 16, gv[i]);
            st16(st + CO_KS + (p >> 2) * CP_V + (p & 3) * 16, gk[i]); }
        if (t256 < 128) st16(st + CO_A + (t256 >> 2) * CP_V + (t256 & 3) * 16, ga);
        else if (t256 < 160) *(LAS v4u*)(st + CO_DC + (t256 - 128) * 16) = ga;
    };
    __syncthreads();
    issue(0); commit(0);
    __syncthreads();
#pragma unroll 1
    for (int n = 0; n < SEQ / 32; ++n) {
        const int cn = b * 128 + n; const size_t m0 = (size_t)cn * 32;
        const LAS unsigned char* st = lds + (n & 1) * CH_STAGE + pr * CH_PAIR;
        if (n + 1 < SEQ / 32) issue(n + 1);
        f32x16 O; v2u gw2[4]; LAS float* xb = xch + (n & 1) * 256;
        if (active) {
        const LAS unsigned char* qrow = st + CO_QD + r32 * CP_Q;
        const LAS unsigned char* vrow = st + CO_VT + vcol * CP_V;
        const LAS unsigned char* arow = st + CO_A + r32 * CP_V;
#pragma unroll
        for (int r = 0; r < 16; ++r) O[r] = 0.f;
#pragma unroll
        for (int s2 = 0; s2 < 2; ++s2) {
            const bf16x8 va = ldl2(vrow + (16 * s2 + 4 * hi) * 2, vrow + (16 * s2 + 8 + 4 * hi) * 2);
            const bf16x8 ab = ldl2(arow + (16 * s2 + 4 * hi) * 2, arow + (16 * s2 + 8 + 4 * hi) * 2);
            O = __builtin_amdgcn_mfma_f32_32x32x16_bf16(va, ab, O, 0, 0, 0);
        }
#pragma unroll
        for (int kt = 0; kt < 4; ++kt)
#pragma unroll
            for (int s2 = 0; s2 < 2; ++s2) {
                v4u pw; pw.x = att::cvtpk(S[kt][8 * s2 + 0], S[kt][8 * s2 + 1]); pw.y = att::cvtpk(S[kt][8 * s2 + 2], S[kt][8 * s2 + 3]); pw.z = att::cvtpk(S[kt][8 * s2 + 4], S[kt][8 * s2 + 5]); pw.w = att::cvtpk(S[kt][8 * s2 + 6], S[kt][8 * s2 + 7]);
                const bf16x8 sa = __builtin_bit_cast(bf16x8, pw);
                const bf16x8 qb = ldl2(qrow + (32 * kt + 16 * s2 + 4 * hi) * 2, qrow + (32 * kt + 16 * s2 + 8 + 4 * hi) * 2);
                O = __builtin_amdgcn_mfma_f32_32x32x16_bf16(sa, qb, O, 0, 0, 0);
            }
        float ssq = 0.f;
#pragma unroll
        for (int r = 0; r < 16; ++r) ssq += O[r] * O[r];
        ssq += __shfl_xor(ssq, 32);
        if (hi == 0) xb[wave * 32 + r32] = ssq;
#pragma unroll
        for (int kt = 0; kt < 4; ++kt) {
#pragma unroll
            for (int g = 0; g < 4; ++g) { const f32x4 dc = *(const LAS f32x4*)(st + CO_DC + (32 * kt + 8 * g + 4 * hi) * 4);
                S[kt][4 * g] *= dc[0]; S[kt][4 * g + 1] *= dc[1]; S[kt][4 * g + 2] *= dc[2]; S[kt][4 * g + 3] *= dc[3]; }
            const LAS unsigned char* krow = st + CO_KS + (32 * kt + r32) * CP_V;
#pragma unroll
            for (int ts = 0; ts < 2; ++ts) {
                const bf16x8 ka = ldl2(krow + (16 * ts + 8 * hi) * 2, krow + (16 * ts + 8 * hi) * 2 + 8);
                const bf16x8 vb = ldl2(vrow + (16 * ts + 8 * hi) * 2, vrow + (16 * ts + 8 * hi) * 2 + 8);
                S[kt] = __builtin_amdgcn_mfma_f32_32x32x16_bf16(ka, vb, S[kt], 0, 0, 0);
            }
        }
#pragma unroll
        for (int g = 0; g < 4; ++g) gw2[g] = *(const LAS v2u*)(st + CO_GT + r32 * CP_Q + (vs * 32 + 8 * g + 4 * hi) * 2);
        }
        if (n + 1 < SEQ / 32) commit((n + 1) & 1);
        __syncthreads();
        if (active) {
        const int w0 = wave & 4;
        const float tot = (xb[(w0 + 0) * 32 + r32] + xb[(w0 + 1) * 32 + r32]) + (xb[(w0 + 2) * 32 + r32] + xb[(w0 + 3) * 32 + r32]);
        const float rs = __builtin_amdgcn_rsqf(tot * (1.0f / 128.0f) + EPS);
        bf16* orow = mixed + (m0 + r32) * DM + hh * 128 + vs * 32;
#pragma unroll
        for (int g = 0; g < 4; ++g) {
            const float g0 = __uint_as_float(gw2[g].x << 16), g1 = __uint_as_float(gw2[g].x & 0xffff0000u), g2 = __uint_as_float(gw2[g].y << 16), g3 = __uint_as_float(gw2[g].y & 0xffff0000u);
            const float y0 = O[4 * g] * rs * nwv[4 * g] * (g0 * __builtin_amdgcn_rcpf(1.0f + __expf(-g0))), y1 = O[4 * g + 1] * rs * nwv[4 * g + 1] * (g1 * __builtin_amdgcn_rcpf(1.0f + __expf(-g1)));
            const float y2 = O[4 * g + 2] * rs * nwv[4 * g + 2] * (g2 * __builtin_amdgcn_rcpf(1.0f + __expf(-g2))), y3 = O[4 * g + 3] * rs * nwv[4 * g + 3] * (g3 * __builtin_amdgcn_rcpf(1.0f + __expf(-g3)));
            v2u w; w.x = att::cvtpk(y0, y1); w.y = att::cvtpk(y2, y3); *(v2u*)(orow + 8 * g + 4 * hi) = w;
        }
        }
    }
    __syncthreads();
}
}

constexpr size_t MiB = 1u << 20;
constexpr size_t WS_CTL = 0, CTL_ZERO_BYTES = 1 * MiB, WS_LBT = 768 * 1024;
constexpr size_t WS_PARTA = 1 * MiB, WS_PARTB = 3 * MiB, WS_COS = 5 * MiB, WS_SIN = 7 * MiB, WS_WI = 9 * MiB;
constexpr size_t WS_WSLOT = 10 * MiB, WSLOT_BYTES = 26 * MiB;
constexpr size_t WO_IN = 0, WO_OUT = WO_IN + (size_t)NINP * DM * 2, WO_1 = WO_OUT + (size_t)DM * DM * 2, WO_2 = WO_1 + (size_t)DFF * DM * 2, WO_QB = WO_2 + (size_t)DM * DFF * 2, WO_KVB = WO_QB + (size_t)384 * 192 * 2, WO_END = WO_KVB + (size_t)512 * 128 * 2;
static_assert(WO_END <= WSLOT_BYTES, "weight slot");
constexpr size_t WS_X = 62 * MiB, WS_Y = 126 * MiB, WS_PROJ = 190 * MiB, WS_MASK = 430 * MiB, WS_KI = 446 * MiB, WS_DECAY = 450 * MiB, WS_AT = 452 * MiB, WS_DVT = 460 * MiB, WS_KSTT = 476 * MiB, WS_END = 508 * MiB;
static_assert(WS_PROJ + (size_t)M * NINP * 2 == WS_MASK && WS_PROJ + (size_t)M * DFF * 2 == WS_KI, "proj / hidden overlay");
constexpr size_t MLA_Q = 0, MLA_K = 24 * MiB, MLA_VT = 48 * MiB;
constexpr int CW_BAR = 4096, CW_Q = 65536;
constexpr int N_BAR_REGIONS = 16;

constexpr int RING_OFF = 0, RING_BYTES = 131072;
constexpr int LDS_BYTES = 163840;
constexpr int LDSCTL_OFF = LDS_BYTES - 1024, MISC_OFF = LDSCTL_OFF + 320;
static_assert(8 * hgrn::PREP_LDS_PER_WAVE <= LDSCTL_OFF && hgrn::CH_LDS <= LDSCTL_OFF && prep::MLA_WLDS_BYTES <= LDSCTL_OFF && 512 * prep::WKV_PITCH <= LDSCTL_OFF, "LDS map");
constexpr int NWAVES = 8;

__device__ __forceinline__ float bf2f(bf16 v) { return __uint_as_float((unsigned)v << 16); }

__device__ __forceinline__ int in_colmap(int n) {
    if (n < 2240) return n;
    if (n < 2304) return -1;
    if (n < 2304 + 160) return 2240 + (n - 2304);
    if (n < 2304 + 224) return 3680 + (n - 2304 - 160);
    if (n < 2304 + 232) return 3744 + (n - 2304 - 224);
    if (n < 2560) return -1;
    if (n < 3328) return 2400 + (n - 2560);
    return 3168 + (n - 3328);
}

__device__ __forceinline__ float wave_sum(float v) {
#define WS_STEP(ctrl, rmask) v += __uint_as_float((unsigned)__builtin_amdgcn_update_dpp(0, (int)__float_as_uint(v), ctrl, rmask, 0xf, false))
    WS_STEP(0x111, 0xf); WS_STEP(0x112, 0xf); WS_STEP(0x114, 0xf); WS_STEP(0x118, 0xf); WS_STEP(0x142, 0xa); WS_STEP(0x143, 0xc);
#undef WS_STEP
    return __uint_as_float((unsigned)__builtin_amdgcn_readlane((int)__float_as_uint(v), 63));
}

template <int BLK = 0  >
__device__ __forceinline__ void cvt_item(const float* W, int K, int Nsrc, const float* gain, bf16* WT, int Np, int mode, LAS float* scr, int item, int lane) {
    const int nblk = Np / 32, kb = item / nblk, nb = item % nblk, k0 = 64 * kb, n0 = 32 * nb;
    const int n = n0 + (lane & 31); const int c = mode ? in_colmap(n) : n;
    float vals[32], gn[32];
#pragma unroll
    for (int i = 0; i < 32; ++i) { const int kk = 2 * i + (lane >> 5); vals[i] = (c >= 0) ? W[(size_t)(k0 + kk) * Nsrc + c] : 0.f; gn[i] = gain ? gain[k0 + kk] : 1.0f; }
    const float cscale = (mode && n >= PC_DQ && n < PC_DQ + 256) ? 0.125f * 1.4426950408889634f : 1.0f;
#pragma unroll
    for (int i = 0; i < 32; ++i) { const int kk = 2 * i + (lane >> 5); scr[kk * 33 + (lane & 31)] = vals[i] * gn[i] * cscale; }
    LDS_WAIT(); asm volatile("" ::: "memory");
    const int cc = lane & 7;
#pragma unroll
    for (int j = 0; j < 4; ++j) { const int nn = (lane >> 3) + 8 * j; const LAS float* s = scr + (8 * cc) * 33 + nn;
        v4u o; o.x = pk2(s[0 * 33], s[1 * 33]); o.y = pk2(s[2 * 33], s[3 * 33]); o.z = pk2(s[4 * 33], s[5 * 33]); o.w = pk2(s[6 * 33], s[7 * 33]);
        const int nrow = n0 + nn;
        *(GAS v4u*)(WT + (BLK ? (size_t)(nrow >> 8) * ((size_t)256 * K) + (size_t)(k0 >> 6) * (256 * 64) + (nrow & 255) * 64 + 8 * cc : (size_t)nrow * K + k0 + 8 * cc)) = o; }
    LDS_WAIT(); asm volatile("" ::: "memory");
}

__device__ __forceinline__ int t5_bucket(int dist) {
    const int n = dist > 0 ? dist : 0;
    if (n < 16) return n;
    int lg = 16 + (int)(logf((float)n / 16.0f) / 2.0794415416798357f * 16.0f);
    return lg < 31 ? lg : 31;
}

struct Args { const void* in[18]; float* out; unsigned char* ws; int p_lo, p_hi, bar_region, pad; };
enum { IN_X = 0, IN_POS, IN_ATTN_NW, IN_WIN, IN_LB, IN_HNW, IN_QNW, IN_WQB, IN_KVNW, IN_WKVB, IN_IKW, IN_IKB, IN_REL, IN_WOUT, IN_MLPNW, IN_W1, IN_W2, IN_FNW };

#ifndef STAG_TICKS
#define STAG_TICKS 0
#endif
__device__ __forceinline__ void stagger_delay() {
    if (STAG_TICKS > 0) { const unsigned long long t0 = rt(), d = (unsigned long long)((((int)blockIdx.x >> 3) & 7) * STAG_TICKS); while (rt() - t0 < d) __builtin_amdgcn_s_sleep(4); }
}
__device__ __forceinline__ void convert_layer(const Args& args, int l, int slot, LAS unsigned char* lds, int gw, int NGW, int wave, int lane) {
    LAS float* scr = (LAS float*)(lds + RING_OFF + wave * 16384);
    unsigned char* sb = args.ws + WS_WSLOT + (size_t)slot * WSLOT_BYTES;
    constexpr int I_IN = 16 * (NINP / 32), I_OUT = 16 * 32, I_1 = 16 * (DFF / 32), I_2 = 64 * 32, I_QB = 3 * 12, I_KVB = 2 * 16;
    constexpr int NIT = I_IN + I_OUT + I_1 + I_2 + I_QB + I_KVB;
    for (int it = gw; it < NIT; it += NGW) {
        int r = it;
        if (r < I_IN) { cvt_item((const float*)args.in[IN_WIN] + (size_t)l * DM * NIN_SRC, DM, NIN_SRC, (const float*)args.in[IN_ATTN_NW] + l * DM, (bf16*)(sb + WO_IN), NINP, 1, scr, r, lane); continue; } r -= I_IN;
        if (r < I_OUT) { cvt_item((const float*)args.in[IN_WOUT] + (size_t)l * DM * DM, DM, DM, nullptr, (bf16*)(sb + WO_OUT), DM, 0, scr, r, lane); continue; } r -= I_OUT;
        if (r < I_1) { cvt_item((const float*)args.in[IN_W1] + (size_t)l * DM * DFF, DM, DFF, (const float*)args.in[IN_MLPNW] + l * DM, (bf16*)(sb + WO_1), DFF, 0, scr, r, lane); continue; } r -= I_1;
        if (r < I_2) { cvt_item<1>((const float*)args.in[IN_W2] + (size_t)l * DFF * DM, DFF, DM, nullptr, (bf16*)(sb + WO_2), DM, 0, scr, r, lane); continue; } r -= I_2;
        if (r < I_QB) { cvt_item((const float*)args.in[IN_WQB] + (size_t)l * 192 * 384, 192, 384, (const float*)args.in[IN_QNW] + l * 192, (bf16*)(sb + WO_QB), 384, 0, scr, r, lane); continue; } r -= I_QB;
        cvt_item((const float*)args.in[IN_WKVB] + (size_t)l * 128 * 512, 128, 512, (const float*)args.in[IN_KVNW] + l * 128, (bf16*)(sb + WO_KVB), 512, 0, scr, r, lane);
    }
}

#ifndef REP_INPROJ
#define REP_INPROJ 1
#endif
#ifndef REP_MLPIN
#define REP_MLPIN 1
#endif
#ifndef REP_MIX1
#define REP_MIX1 1
#endif
#ifndef REP_MIX2
#define REP_MIX2 1
#endif
#ifndef REP_SEL
#define REP_SEL 1
#endif
#ifndef REP_MLA
#define REP_MLA 1
#endif
#ifndef REP_CHAIN
#define REP_CHAIN 1
#endif
#ifndef REP_CONV
#define REP_CONV 1
#endif
constexpr int PH_PER_LAYER = 8, PH_FINAL = 1 + PH_PER_LAYER * DEPTH, PH_COUNT = PH_FINAL + 1;
__global__ void __launch_bounds__(NWAVES * 64, 2) fwd(Args args) {
    extern __shared__ __attribute__((aligned(16))) unsigned char lds_raw[];
    LAS unsigned char* lds = (LAS unsigned char*)lds_raw;
    volatile LAS unsigned* MISC = (volatile LAS unsigned*)(lds + MISC_OFF);
    const int G = gridDim.x, NGW = G * NWAVES;
#define PHASE_IDS int tid_p = threadIdx.x; asm volatile("" : "+v"(tid_p)); const int tid = tid_p, lane = tid & 63, wave = __builtin_amdgcn_readfirstlane(tid >> 6), gw = blockIdx.x * NWAVES + wave; (void)lane; (void)gw; \
    unsigned char* ws_p = args.ws; asm volatile("" : "+s"(ws_p)); unsigned char* const ws = ws_p; (void)ws;
    unsigned char* ws0 = args.ws;
    gu32* ctl = (gu32*)(ws0 + WS_CTL);
    for (int u = threadIdx.x; u < (LDS_BYTES - LDSCTL_OFF) / 4; u += NWAVES * 64) ((LAS unsigned*)(lds + LDSCTL_OFF))[u] = 0u;
    __syncthreads();
    XcdBarrier bar = xcd_barrier_post((unsigned*)(ctl + CW_BAR) + args.bar_region * XCD_BAR_WORDS, MISC + 8);
    const int lo = args.p_lo, hi = args.p_hi;
#define IN(k) (lo <= (k) && (k) < hi)
#define SEAM(k) do { if ((k) + 1 < hi) xcd_barrier(bar); } while (0)
    unsigned char* mlab = (unsigned char*)args.out;

    if (IN(0)) {
        PHASE_IDS
        float* partA = (float*)(ws + WS_PARTA);
        const float* x = (const float*)args.in[IN_X]; bf16* hb = (bf16*)(ws + WS_X);
        for (int m = gw; m < M; m += NGW) {
            const GAS f32x4* xr = (const GAS f32x4*)(x + (size_t)m * DM) + lane;
            GAS unsigned long long* o8 = (GAS unsigned long long*)(hb + (size_t)m * DM) + lane;
            float s = 0.f;
#pragma unroll
            for (int j = 0; j < 4; ++j) { const f32x4 v = xr[64 * j]; s += (v.x * v.x + v.y * v.y) + (v.z * v.z + v.w * v.w);
                o8[64 * j] = (unsigned long long)pk2(v.x, v.y) | ((unsigned long long)pk2(v.z, v.w) << 32); }
            s = wave_sum(s);
            if (lane < 16) partA[(size_t)m * 16 + lane] = (lane == 0) ? s : 0.f;
        }
        const int* pos = (const int*)args.in[IN_POS]; float* cs = (float*)(ws + WS_COS); float* sn = (float*)(ws + WS_SIN);
        for (int idx = blockIdx.x * (NWAVES * 64) + tid; idx < M * 16; idx += G * NWAVES * 64) {
            const int m = idx >> 4, i = idx & 15;
            const float invf = __builtin_amdgcn_exp2f(-(float)i * 0.8304820237218405f);
            const float ang = (float)pos[m] * invf;
            const double rev = (double)ang * 0.15915494309189535; const float fr = (float)(rev - rint(rev));
            cs[idx] = __builtin_amdgcn_cosf(fr); sn[idx] = __builtin_amdgcn_sinf(fr);
        }
        {
            const float* lg = (const float*)args.in[IN_LB]; float* lbt = (float*)(ws + WS_LBT);
            for (int c = blockIdx.x * (NWAVES * 64) + tid; c < 512; c += G * NWAVES * 64) {
                float e[DEPTH], mx = -INFINITY, sm = 0.f;
#pragma unroll
                for (int i = 0; i < DEPTH; ++i) { e[i] = lg[i * 512 + c]; mx = fmaxf(mx, e[i]); }
#pragma unroll
                for (int i = 0; i < DEPTH; ++i) { e[i] = expf(e[i] - mx); sm += e[i]; }
                float cum = 0.f;
#pragma unroll
                for (int i = 0; i < DEPTH; ++i) { if (i > 0) cum += e[i] / sm; lbt[i * 512 + c] = cum; }
            }
        }
        if (!IN(1)) SEAM(0);
    }

#pragma unroll 1
    for (int l = 0; l < DEPTH; ++l) {
        const int pb = 1 + PH_PER_LAYER * l;
#define LAYER_PTRS unsigned char* sb = ws + WS_WSLOT + (size_t)(l & 1) * WSLOT_BYTES; unsigned char* bufIn = ws + WS_X; unsigned char* bufOt = ws + WS_Y; \
    float* partA = (float*)(ws + WS_PARTA); float* partB = (float*)(ws + WS_PARTB); (void)sb; (void)bufIn; (void)bufOt; (void)partA; (void)partB;
        const bool conv_early = (G == 256);
        if (IN(pb + 0) && (l == 0 || !conv_early)) { PHASE_IDS for (int rep = 0; rep < REP_CONV; ++rep) { convert_layer(args, l, l & 1, lds, gw, NGW, wave, lane); if (rep + 1 < REP_CONV) xcd_barrier(bar); } SEAM(pb + 0); }
        if (IN(pb + 1)) {
            PHASE_IDS LAYER_PTRS
            pg8::Gemm g{(const pg8::bf16_t*)bufIn, (const pg8::bf16_t*)(sb + WO_IN), M, NINP, DM}; pg8::StaticOrder S; S.init(M, NINP, G, (int)blockIdx.x);
            pg8::EpiScale<0> E{(pg8::bf16_t*)(ws + WS_PROJ), NINP, partA};
            stagger_delay();
            for (int rep = 0; rep < REP_INPROJ; ++rep) { pg8::gemm_phase<pg8::EpiScale<0>, pg8::StaticOrder, PG8_ALIGN, PG8_SP2>(lds + RING_OFF, g, S, E); if (rep + 1 < REP_INPROJ) xcd_barrier(bar); }
            if (conv_early && l + 1 < DEPTH && (int)blockIdx.x >= 128) {
                __syncthreads();
                convert_layer(args, l + 1, (l + 1) & 1, lds, ((int)blockIdx.x - 128) * NWAVES + wave, 128 * NWAVES, wave, lane);
            }
            SEAM(pb + 1);
        }
        if (IN(pb + 2)) {
            PHASE_IDS LAYER_PTRS
            const bf16* proj = (const bf16*)(ws + WS_PROJ);
            const bool aff = (G == 256);
            const int lwi = aff ? ((int)blockIdx.x >> 3) * NWAVES + wave : gw, lstr = aff ? 256 : NGW, bq = aff ? ((int)blockIdx.x & 7) : 0, nbat = aff ? 1 : NB;
#ifndef REP_PREPA
#define REP_PREPA 1
#endif
#ifndef REP_HDRY
#define REP_HDRY 0
#endif
            for (int r5 = 0; r5 < REP_PREPA; ++r5) {
            {
                const float* lnw = (const float*)args.in[IN_IKW] + l * 64; const float* lnb = (const float*)args.in[IN_IKB] + l * 64; bf16* KI = (bf16*)(ws + WS_KI); float* WI = (float*)(ws + WS_WI);
                const float lw = lnw[lane], lb2 = lnb[lane];
                const int glim = nbat * (SEQ / 4);
                for (int g0 = lwi; g0 < glim; g0 += 4 * lstr) {
                    unsigned short xr[4][4], wr_[4][4];
#pragma unroll
                    for (int q = 0; q < 4; ++q) { const int g4 = g0 + q * lstr; const int m4 = bq * SEQ + (g4 < glim ? g4 : g0) * 4;
#pragma unroll
                        for (int j = 0; j < 4; ++j) { const bf16* row = proj + (size_t)(m4 + j) * NINP; xr[q][j] = row[PC_IK + lane]; wr_[q][j] = row[PC_IW + (lane & 7)]; } }
#pragma unroll
                    for (int q = 0; q < 4; ++q) { const int g4 = g0 + q * lstr; if (g4 < glim) { const int m4 = bq * SEQ + g4 * 4;
                    float xs[4], ws4[4];
#pragma unroll
                    for (int j = 0; j < 4; ++j) { xs[j] = bf2f(xr[q][j]); ws4[j] = bf2f(wr_[q][j]); }
#pragma unroll
                    for (int j = 0; j < 4; ++j) { const int m = m4 + j;
                        const float mu = wave_sum(xs[j]) * (1.0f / 64.0f), dx = xs[j] - mu, var = wave_sum(dx * dx) * (1.0f / 64.0f);
                        KI[(size_t)(m >> 5) * 2048 + (lane >> 4) * 512 + ((lane >> 3) & 1) * 256 + (m & 31) * 8 + (lane & 7)] = (bf16)f2bf(dx * __builtin_amdgcn_rsqf(var + EPS) * lw + lb2);
                        if (lane < 8) WI[(size_t)m * 8 + lane] = ws4[j] * (0.35355339059327373f * 0.125f); }
                    } }
                }
            }
            {
                bf16* DVT = (bf16*)(ws + WS_DVT);
                for (int itl = lwi; itl < nbat * (SEQ / 64) * 4; itl += lstr) { const int it = bq * (SEQ / 64) * 4 + itl;
                    const int tile = it >> 2, hh = it & 3, m0 = tile * 64, b = m0 / SEQ, t0 = m0 % SEQ;
                    const int p = lane & 31, th = lane >> 5;
                    unsigned raw[32];
#pragma unroll
                    for (int i = 0; i < 32; ++i) raw[i] = *(const unsigned*)(proj + (size_t)(m0 + th * 32 + i) * NINP + PC_DV + hh * 64 + 2 * p);
                    v4u* d0 = (v4u*)(DVT + ((size_t)(b * 4 + hh) * 64 + 2 * p) * SEQ + t0 + th * 32); v4u* d1 = (v4u*)(DVT + ((size_t)(b * 4 + hh) * 64 + 2 * p + 1) * SEQ + t0 + th * 32);
#pragma unroll
                    for (int i = 0; i < 4; ++i) {
                        v4u a, c;
                        a.x = (raw[8 * i] & 0xffffu) | (raw[8 * i + 1] << 16); a.y = (raw[8 * i + 2] & 0xffffu) | (raw[8 * i + 3] << 16); a.z = (raw[8 * i + 4] & 0xffffu) | (raw[8 * i + 5] << 16); a.w = (raw[8 * i + 6] & 0xffffu) | (raw[8 * i + 7] << 16);
                        c.x = (raw[8 * i] >> 16) | (raw[8 * i + 1] & 0xffff0000u); c.y = (raw[8 * i + 2] >> 16) | (raw[8 * i + 3] & 0xffff0000u); c.z = (raw[8 * i + 4] >> 16) | (raw[8 * i + 5] & 0xffff0000u); c.w = (raw[8 * i + 6] >> 16) | (raw[8 * i + 7] & 0xffff0000u);
                        d0[i] = a; d1[i] = c; }
                }
            }
            }
            {
                const int wv = wave;
                for (int r6 = 0; r6 < REP_HDRY; ++r6)
                for (int ul = lwi; ul < nbat * (SEQ / 32) * 4; ul += lstr) { const int u = bq * (SEQ / 32) * 4 + ul;
                    hgrn::prep_unit<true>(lds + wv * hgrn::PREP_LDS_PER_WAVE, (bf16*)(ws + WS_PROJ), (const float*)(ws + WS_LBT) + l * 512, (bf16*)(ws + WS_KSTT), (float*)(ws + WS_DECAY), (bf16*)(ws + WS_AT), u, lane); }
                for (int ul = lwi; ul < nbat * (SEQ / 32) * 4; ul += lstr) { const int u = bq * (SEQ / 32) * 4 + ul;
                    hgrn::prep_unit<false>(lds + wv * hgrn::PREP_LDS_PER_WAVE, (bf16*)(ws + WS_PROJ), (const float*)(ws + WS_LBT) + l * 512, (bf16*)(ws + WS_KSTT), (float*)(ws + WS_DECAY), (bf16*)(ws + WS_AT), u, lane); }
            }
#ifndef REP_MLAPREP
#define REP_MLAPREP 1
#endif
            for (int r4 = 0; r4 < REP_MLAPREP; ++r4)
            if (aff) {
                const int rk = (int)blockIdx.x >> 3, kind = rk & 1, j = rk >> 1;
                __syncthreads();
#define MLA_WSTAGE(WOFF, CPR, PITCH, NCH, NPI) do { const bf16* wsrc = (const bf16*)(sb + (WOFF)); _Pragma("unroll 1") for (int c0 = tid; c0 < (NCH); c0 += (NPI) * 512) { v4u wv_[NPI]; \
                    _Pragma("unroll") for (int q_ = 0; q_ < (NPI); ++q_) wv_[q_] = *(const v4u*)(wsrc + (size_t)(c0 + q_ * 512) * 8);                        \
                    _Pragma("unroll") for (int q_ = 0; q_ < (NPI); ++q_) { const int c_ = c0 + q_ * 512; *(LAS v4u*)(lds + (c_ / (CPR)) * (PITCH) + (c_ % (CPR)) * 16) = wv_[q_]; } } } while (0)
                if (kind) MLA_WSTAGE(WO_KVB, 16, prep::WKV_PITCH, 512 * 16, 8); else MLA_WSTAGE(WO_QB, 24, prep::WQ_PITCH, 384 * 24, 6);
#undef MLA_WSTAGE
                __syncthreads();
                prep::mla_prep_unit<true>(proj, (const bf16*)(sb + WO_QB), (const bf16*)(sb + WO_KVB), (const float*)(ws + WS_COS), (const float*)(ws + WS_SIN),
                                          (bf16*)(mlab + MLA_Q), (bf16*)(mlab + MLA_K), (bf16*)(mlab + MLA_VT), bq * (SEQ / 32) + j * 8 + wave, lane, kind, lds);
                __syncthreads();
            } else
            for (int ul = lwi; ul < nbat * (SEQ / 32) * 2; ul += lstr) { const int u2 = bq * (SEQ / 32) * 2 + ul;
                prep::mla_prep_unit<false>(proj, (const bf16*)(sb + WO_QB), (const bf16*)(sb + WO_KVB), (const float*)(ws + WS_COS), (const float*)(ws + WS_SIN),
                                    (bf16*)(mlab + MLA_Q), (bf16*)(mlab + MLA_K), (bf16*)(mlab + MLA_VT), u2 >> 1, lane, u2 & 1); }
            SEAM(pb + 2);
        }
        if (IN(pb + 3)) {
            PHASE_IDS LAYER_PTRS
            for (int rep = 0; rep < REP_MIX1; ++rep) {
            for (int r3 = 0; r3 < REP_CHAIN; ++r3)
            for (int pp = (int)blockIdx.x; pp < 32; pp += G)
                hgrn::chain(lds + RING_OFF, (const bf16*)(ws + WS_PROJ), (const bf16*)(ws + WS_KSTT), (const float*)(ws + WS_DECAY), (const bf16*)(ws + WS_AT), (const float*)args.in[IN_HNW] + l * 128, (bf16*)bufOt, pp, 1);
            const bf16* proj = (const bf16*)(ws + WS_PROJ); const bf16* KI = (const bf16*)(ws + WS_KI); const float* WI = (const float*)(ws + WS_WI); unsigned* maskp = (unsigned*)(ws + WS_MASK);
            const bf16* Qb = (const bf16*)(mlab + MLA_Q); const bf16* Kb = (const bf16*)(mlab + MLA_K); const bf16* VTb = (const bf16*)(mlab + MLA_VT); bf16* mixed = (bf16*)bufOt;
            for (int qi = 0; qi < 8; ++qi) {
                const int b = ((int)blockIdx.x + qi) & 7;
                gu32* qcnt = ctl + CW_Q + ((rep * DEPTH + l) * 8 + b) * 64;
                if (qi == 1) {
                    int t8 = threadIdx.x; asm volatile("" : "+v"(t8));
                    if (t8 < 8) MISC[24 + t8] = __hip_atomic_load(ctl + CW_Q + ((rep * DEPTH + l) * 8 + t8) * 64, __ATOMIC_RELAXED, __HIP_MEMORY_SCOPE_AGENT);
                    __syncthreads();
                }
                if (qi >= 1 && (int)MISC[24 + b] >= sel3::KEND) continue;
                for (;;) {
                    if (tid == 0) MISC[16] = __hip_atomic_fetch_add(qcnt, 1u, __ATOMIC_RELAXED, __HIP_MEMORY_SCOPE_AGENT);
                    __syncthreads();
                    const int k = (int)MISC[16];
                    __syncthreads();
                    if (k >= sel3::KEND) break;
                    if (k < sel3::KSEL0) {
                        const int qb = 15 - (k >> 2), hh = k & 3;
                        for (int r2 = 0; r2 < REP_MLA; ++r2)
                        att::attn_unit<96, false>(lds + RING_OFF, Qb + (size_t)b * SEQ * 384 + hh * 96, 384, Kb + (size_t)b * SEQ * 384 + hh * 96, 384, VTb + (size_t)(b * 4 + hh) * 64 * SEQ,
                                                  mixed + (size_t)b * SEQ * DM + 512 + hh * 64, DM, qb * 256, nullptr, nullptr, nullptr, hh, 1.0f);
                    } else {
                        sel3::dsa_select_stream(lds + RING_OFF, MISC, qcnt, proj, KI, WI, maskp, k, b);
                        break;
                    }
                }
            }
            __syncthreads();
            if (rep + 1 < REP_MIX1) xcd_barrier(bar);
            }
            SEAM(pb + 3);
        }
        if (IN(pb + 4)) {
            LAS float* biastab = (LAS float*)(lds + RING_OFF + 98304);
            PHASE_IDS LAYER_PTRS
            { const float* rel = (const float*)args.in[IN_REL]; const int d = tid >> 2, hh = tid & 3; biastab[tid] = rel[t5_bucket(d) * 4 + hh] * 1.4426950408889634f; }
            __syncthreads();
            const bf16* proj = (const bf16*)(ws + WS_PROJ); const bf16* DVT = (const bf16*)(ws + WS_DVT); bf16* mixed = (bf16*)bufOt;
            const unsigned* maskp = (const unsigned*)(ws + WS_MASK); const int* pos = (const int*)args.in[IN_POS];
            for (int rep = 0; rep < REP_MIX2; ++rep) { if (rep) xcd_barrier(bar);
            for (int i = 0; ; ++i) {
                int qb, b, hh;
                if (G == 256) { if (i >= 2) break; b = (int)blockIdx.x & 7; const int jj = (int)blockIdx.x >> 3; hh = jj & 3; qb = (i == 0) ? 15 - (jj >> 2) : (jj >> 2); }
                else { const int k = (int)blockIdx.x + i * G; if (k >= 512) break; qb = 15 - (k >> 5); b = (k & 31) >> 2; hh = k & 3; }
                att::attn_unit<64, true>(lds + RING_OFF, proj + (size_t)b * SEQ * NINP + PC_DQ + hh * 64, NINP, proj + (size_t)b * SEQ * NINP + PC_DK + hh * 64, NINP, DVT + (size_t)(b * 4 + hh) * 64 * SEQ,
                                         mixed + (size_t)b * SEQ * DM + 768 + hh * 64, DM, qb * 256, maskp + (size_t)b * SEQ * 128, pos + b * SEQ, biastab, hh, 1.0f);
            }
            }
            SEAM(pb + 4);
        }
        if (IN(pb + 5)) {
            PHASE_IDS LAYER_PTRS
            pg8::Gemm g{(const pg8::bf16_t*)bufOt, (const pg8::bf16_t*)(sb + WO_OUT), M, DM, DM}; pg8::StaticOrder S; S.init(M, DM, G, (int)blockIdx.x);
            pg8::EpiRes E{(pg8::bf16_t*)bufIn, partB};
#ifndef REP_RES_O
#define REP_RES_O 1
#endif
#ifndef REP_RES_M
#define REP_RES_M 1
#endif
            if (REP_RES_O > 1) { pg8::EpiRes E0{(pg8::bf16_t*)bufIn, partA, (pg8::bf16_t*)(ws + WS_PROJ)}; pg8::gemm_phase<pg8::EpiRes, pg8::StaticOrder, PG8_ALIGN, PG8_SP2>(lds + RING_OFF, g, S, E0); xcd_barrier(bar); }
            pg8::gemm_phase<pg8::EpiRes, pg8::StaticOrder, PG8_ALIGN, PG8_SP2>(lds + RING_OFF, g, S, E);
            SEAM(pb + 5);
        }
        if (IN(pb + 6)) {
            PHASE_IDS LAYER_PTRS
            pg8::Gemm g{(const pg8::bf16_t*)bufIn, (const pg8::bf16_t*)(sb + WO_1), M, DFF, DM}; pg8::StaticOrder S; S.init(M, DFF, G, (int)blockIdx.x);
            pg8::EpiScale<1> E{(pg8::bf16_t*)(ws + WS_PROJ), DFF, partB, 1};
            stagger_delay();
            for (int rep = 0; rep < REP_MLPIN; ++rep) { pg8::gemm_phase<pg8::EpiScale<1>, pg8::StaticOrder, PG8_ALIGN, PG8_SP2>(lds + RING_OFF, g, S, E); if (rep + 1 < REP_MLPIN) xcd_barrier(bar); }
            SEAM(pb + 6);
        }
        if (IN(pb + 7)) {
            PHASE_IDS LAYER_PTRS
            pg8::Gemm g{(const pg8::bf16_t*)(ws + WS_PROJ), (const pg8::bf16_t*)(sb + WO_2), M, DM, DFF, 1, 1}; pg8::StaticOrder S; S.init(M, DM, G, (int)blockIdx.x); S.rev = (512 % G == 0);
            pg8::EpiRes E{(pg8::bf16_t*)bufIn, partA};
            if (REP_RES_M > 1) { pg8::EpiRes E0{(pg8::bf16_t*)bufIn, partB, (pg8::bf16_t*)bufOt}; pg8::gemm_phase<pg8::EpiRes, pg8::StaticOrder, PG8_ALIGN, PG8_SP2>(lds + RING_OFF, g, S, E0); xcd_barrier(bar); }
            pg8::gemm_phase<pg8::EpiRes, pg8::StaticOrder, PG8_ALIGN, PG8_SP2>(lds + RING_OFF, g, S, E);
            SEAM(pb + 7);
        }
    }
    if (IN(PH_FINAL)) {
        PHASE_IDS
        float* partA = (float*)(ws + WS_PARTA);
        const float* fw = (const float*)args.in[IN_FNW];
        for (int m = gw; m < M; m += NGW) {
            const GAS f32x4* pp = (const GAS f32x4*)(partA + (size_t)m * 16);
            const f32x4 p0 = pp[0], p1 = pp[1], p2 = pp[2], p3 = pp[3];
            const float ss = ((p0.x + p0.y) + (p0.z + p0.w)) + ((p1.x + p1.y) + (p1.z + p1.w)) + ((p2.x + p2.y) + (p2.z + p2.w)) + ((p3.x + p3.y) + (p3.z + p3.w));
            const float rs = 1.0f / sqrtf(ss * (1.0f / 1024.0f) + EPS);
            GAS f32x4* orow = (GAS f32x4*)(args.out + (size_t)m * DM) + lane; const GAS f32x4* wr4 = (const GAS f32x4*)fw + lane;
            const GAS unsigned long long* h8 = (const GAS unsigned long long*)((const bf16*)(ws + WS_X) + (size_t)m * DM) + lane;
#pragma unroll
            for (int j = 0; j < 4; ++j) { const unsigned long long hv = h8[64 * j]; const unsigned lo = (unsigned)hv, hi2 = (unsigned)(hv >> 32); const f32x4 w = wr4[64 * j];
                f32x4 v; v.x = __uint_as_float(lo << 16); v.y = __uint_as_float(lo & 0xffff0000u); v.z = __uint_as_float(hi2 << 16); v.w = __uint_as_float(hi2 & 0xffff0000u);
                orow[64 * j] = v * rs * w; }
        }
    }
#undef IN
#undef SEAM
#undef PHASE_IDS
#undef LAYER_PTRS
}

__device__ __forceinline__ bf16 f2bf16(float f) { return (bf16)f2bf(f); }

__global__ void __launch_bounds__(128) hgrn_naive(const bf16* __restrict__ proj, const float* __restrict__ lb_logits, const float* __restrict__ norm_w, int layer, bf16* __restrict__ mixed) {
    const int b = blockIdx.x >> 2, hh = blockIdx.x & 3, v = threadIdx.x, lane = v & 63, wv = v >> 6;
    __shared__ float sf[128], sk[128], sq[128], red[2];
    const int c = hh * 128 + v;
    float lb;
    { float lg[4], mx = -INFINITY, sm = 0.f;
      for (int i = 0; i < 4; ++i) { lg[i] = lb_logits[i * 512 + c]; mx = fmaxf(mx, lg[i]); }
      for (int i = 0; i < 4; ++i) { lg[i] = expf(lg[i] - mx); sm += lg[i]; }
      lb = 0.f; for (int i = 1; i < 4; ++i) if (i <= layer) lb += lg[i] / sm; }
    const float nw = norm_w[layer * 128 + v];
    float S[128];
#pragma unroll
    for (int k = 0; k < 128; ++k) S[k] = 0.f;
    for (int t = 0; t < SEQ; ++t) {
        const size_t m = (size_t)b * SEQ + t; const bf16* row = proj + m * NINP;
        const float qv = bf2f(row[PC_HQ + c]) * 0.08838834764831845f, fp = bf2f(row[PC_HF + c]), iv = bf2f(row[PC_HI + c]), gv = bf2f(row[PC_HG + c]);
        const float sg = 1.0f / (1.0f + expf(-fp)), sgn = 1.0f / (1.0f + expf(fp));
        sf[v] = lb + (1.0f - lb) * sg; sk[v] = (1.0f - lb) * sgn; sq[v] = qv;
        __syncthreads();
        float o = 0.f;
#pragma unroll
        for (int k = 0; k < 128; ++k) { S[k] = sf[k] * S[k] + sk[k] * iv; o += sq[k] * S[k]; }
        float s2 = o * o;
#pragma unroll
        for (int off = 32; off >= 1; off >>= 1) s2 += __shfl_xor(s2, off);
        if (lane == 0) red[wv] = s2;
        __syncthreads();
        const float rs = 1.0f / sqrtf((red[0] + red[1]) * (1.0f / 128.0f) + EPS);
        const float y = o * rs * nw * (gv / (1.0f + expf(-gv)));
        mixed[m * DM + c] = f2bf16(y);
        __syncthreads();
    }
}

__global__ void __launch_bounds__(128) mla_prep_naive(const bf16* __restrict__ proj, const bf16* __restrict__ wqb_t, const bf16* __restrict__ wkvb_t, const float* __restrict__ cs, const float* __restrict__ sn,
                                                        bf16* __restrict__ Q, bf16* __restrict__ K, bf16* __restrict__ VT) {
    const int m = blockIdx.x, tid = threadIdx.x, b = m / SEQ, t = m % SEQ;
    __shared__ float qa[192], ckv[128], kpe[32], qout[384], red[2][2];
    const bf16* row = proj + (size_t)m * NINP;
    for (int k = tid; k < 192; k += 128) qa[k] = bf2f(row[PC_MQA + k]);
    ckv[tid] = bf2f(row[PC_MKVA + tid]);
    if (tid < 32) kpe[tid] = bf2f(row[PC_MKVA + 128 + tid]);
    __syncthreads();
    float s1 = 0.f; for (int k = tid; k < 192; k += 128) s1 += qa[k] * qa[k];
    float s2 = ckv[tid] * ckv[tid];
    for (int off = 32; off >= 1; off >>= 1) { s1 += __shfl_xor(s1, off); s2 += __shfl_xor(s2, off); }
    if ((tid & 63) == 0) { red[tid >> 6][0] = s1; red[tid >> 6][1] = s2; }
    __syncthreads();
    const float rq = 1.0f / sqrtf((red[0][0] + red[1][0]) * (1.0f / 192.0f) + EPS), rkv = 1.0f / sqrtf((red[0][1] + red[1][1]) * (1.0f / 128.0f) + EPS);
    for (int n = tid; n < 384; n += 128) { float a = 0.f; const bf16* w = wqb_t + (size_t)n * 192; for (int k = 0; k < 192; ++k) a += qa[k] * bf2f(w[k]); qout[n] = a * rq; }
    __syncthreads();
    for (int n = tid; n < 384; n += 128) {
        const int hh = n / 96, j = n % 96; float val;
        if (j < 64) val = qout[n];
        else { const int i = (j - 64) & 15, part = (j - 64) >> 4; const float x1 = qout[hh * 96 + 64 + i], x2 = qout[hh * 96 + 80 + i], c = cs[(size_t)m * 16 + i], s = sn[(size_t)m * 16 + i];
               val = part == 0 ? x1 * c - x2 * s : x2 * c + x1 * s; }
        Q[(size_t)m * 384 + n] = f2bf16(val * QSCALE);
    }
    for (int n = tid; n < 512; n += 128) {
        float a = 0.f; const bf16* w = wkvb_t + (size_t)n * 128; for (int k = 0; k < 128; ++k) a += ckv[k] * bf2f(w[k]); a *= rkv;
        const int hh = n >> 7, j = n & 127;
        if (j < 64) K[(size_t)m * 384 + hh * 96 + j] = f2bf16(a); else VT[((size_t)(b * 4 + hh) * 64 + (j - 64)) * SEQ + t] = f2bf16(a);
    }
    if (tid < 32) {
        const int i = tid & 15, part = tid >> 4; const float x1 = kpe[i], x2 = kpe[16 + i], c = cs[(size_t)m * 16 + i], s = sn[(size_t)m * 16 + i];
        const float val = part == 0 ? x1 * c - x2 * s : x2 * c + x1 * s;
        for (int hh = 0; hh < 4; ++hh) K[(size_t)m * 384 + hh * 96 + 64 + tid] = f2bf16(val);
    }
}

__global__ void __launch_bounds__(256) mla_attn_naive(const bf16* __restrict__ Q, const bf16* __restrict__ K, const bf16* __restrict__ VT, bf16* __restrict__ mixed) {
    const int lane = threadIdx.x & 63, gwv = blockIdx.x * 4 + (threadIdx.x >> 6);
    const int m = gwv >> 2, hh = gwv & 3, b = m / SEQ, t = m % SEQ;
    float q[96];
    { const bf16* qp = Q + (size_t)m * 384 + hh * 96;
#pragma unroll
      for (int d = 0; d < 96; ++d) q[d] = bf2f(qp[d]); }
    float o[64];
#pragma unroll
    for (int d = 0; d < 64; ++d) o[d] = 0.f;
    float mx = -INFINITY, l = 0.f;
    const bf16* vt = VT + (size_t)(b * 4 + hh) * 64 * SEQ;
    for (int j = lane; j <= t; j += 64) {
        const bf16* kr = K + ((size_t)b * SEQ + j) * 384 + hh * 96;
        float s = 0.f;
#pragma unroll
        for (int d8 = 0; d8 < 12; ++d8) { const v4u kk = *(const v4u*)(kr + d8 * 8);
            s += q[d8 * 8 + 0] * __uint_as_float(kk.x << 16) + q[d8 * 8 + 1] * __uint_as_float(kk.x & 0xffff0000u) + q[d8 * 8 + 2] * __uint_as_float(kk.y << 16) + q[d8 * 8 + 3] * __uint_as_float(kk.y & 0xffff0000u)
               + q[d8 * 8 + 4] * __uint_as_float(kk.z << 16) + q[d8 * 8 + 5] * __uint_as_float(kk.z & 0xffff0000u) + q[d8 * 8 + 6] * __uint_as_float(kk.w << 16) + q[d8 * 8 + 7] * __uint_as_float(kk.w & 0xffff0000u); }
        const float mn = fmaxf(mx, s), sc = exp2f(mx - mn), p = exp2f(s - mn);
        l = l * sc + p; mx = mn;
#pragma unroll
        for (int d = 0; d < 64; ++d) o[d] = o[d] * sc + p * bf2f(vt[(size_t)d * SEQ + j]);
    }
    float Mx = mx;
#pragma unroll
    for (int off = 32; off >= 1; off >>= 1) Mx = fmaxf(Mx, __shfl_xor(Mx, off));
    const float f = (mx == -INFINITY) ? 0.f : exp2f(mx - Mx);
    float lt = l * f;
#pragma unroll
    for (int off = 32; off >= 1; off >>= 1) lt += __shfl_xor(lt, off);
    float mine = 0.f;
#pragma unroll
    for (int d = 0; d < 64; ++d) { float v = o[d] * f;
#pragma unroll
        for (int off = 32; off >= 1; off >>= 1) v += __shfl_xor(v, off);
        if (lane == d) mine = v; }
    mixed[(size_t)m * DM + 512 + hh * 64 + lane] = f2bf16(mine / lt);
}

__global__ void __launch_bounds__(256) dsa_prep_naive(const bf16* __restrict__ proj, const float* __restrict__ lnw, const float* __restrict__ lnb, bf16* __restrict__ KI, float* __restrict__ WI) {
    const int lane = threadIdx.x & 63, m = blockIdx.x * 4 + (threadIdx.x >> 6);
    const bf16* row = proj + (size_t)m * NINP;
    const float x = bf2f(row[PC_IK + lane]);
    const float mu = wave_sum(x) * (1.0f / 64.0f), dx = x - mu, var = wave_sum(dx * dx) * (1.0f / 64.0f);
    KI[(size_t)m * 64 + lane] = f2bf16(dx * (1.0f / sqrtf(var + EPS)) * lnw[lane] + lnb[lane]);
    if (lane < 8) WI[(size_t)m * 8 + lane] = bf2f(row[PC_IW + lane]) * (0.35355339059327373f * 0.125f);
}

__device__ __forceinline__ unsigned mono_key(float s) { const unsigned u = __float_as_uint(s + 0.0f); return (u & 0x80000000u) ? ~u : (u | 0x80000000u); }

__global__ void __launch_bounds__(256) dsa_select_naive(const bf16* __restrict__ proj, const bf16* __restrict__ KI, const float* __restrict__ WI, unsigned* __restrict__ mask) {
    const int m = blockIdx.x, tid = threadIdx.x, lane = tid & 63, wv = tid >> 6, b = m / SEQ, t = m % SEQ, N = t + 1;
    __shared__ float iq[512]; __shared__ float wi[8]; __shared__ unsigned keys[SEQ]; __shared__ unsigned red[4];
    for (int i = tid; i < 512; i += 256) iq[i] = bf2f(proj[(size_t)m * NINP + PC_IQ + i]);
    if (tid < 8) wi[tid] = WI[(size_t)m * 8 + tid];
    __syncthreads();
    for (int j = tid; j < N; j += 256) {
        const bf16* kr = KI + ((size_t)b * SEQ + j) * 64; float kf[64];
#pragma unroll
        for (int d8 = 0; d8 < 8; ++d8) { const v4u kk = *(const v4u*)(kr + d8 * 8);
            kf[d8 * 8 + 0] = __uint_as_float(kk.x << 16); kf[d8 * 8 + 1] = __uint_as_float(kk.x & 0xffff0000u); kf[d8 * 8 + 2] = __uint_as_float(kk.y << 16); kf[d8 * 8 + 3] = __uint_as_float(kk.y & 0xffff0000u);
            kf[d8 * 8 + 4] = __uint_as_float(kk.z << 16); kf[d8 * 8 + 5] = __uint_as_float(kk.z & 0xffff0000u); kf[d8 * 8 + 6] = __uint_as_float(kk.w << 16); kf[d8 * 8 + 7] = __uint_as_float(kk.w & 0xffff0000u); }
        float sc = 0.f;
#pragma unroll
        for (int h = 0; h < 8; ++h) { float dsum = 0.f;
#pragma unroll
            for (int d = 0; d < 64; ++d) dsum += iq[h * 64 + d] * kf[d];
            sc += fmaxf(dsum, 0.f) * wi[h]; }
        keys[j] = mono_key(sc);
    }
    __syncthreads();
    unsigned T = 0u; int need = 256;
    const bool all = (N <= 256);
    if (!all) {
        for (int bit = 31; bit >= 0; --bit) {
            const unsigned cand = T | (1u << bit); unsigned cnt = 0;
            for (int j = tid; j < N; j += 256) cnt += (keys[j] >= cand) ? 1u : 0u;
#pragma unroll
            for (int off = 32; off >= 1; off >>= 1) cnt += __shfl_xor(cnt, off);
            if (lane == 0) red[wv] = cnt;
            __syncthreads();
            const unsigned tot = red[0] + red[1] + red[2] + red[3];
            __syncthreads();
            if (tot >= 256u) T = cand;
        }
        unsigned cnt = 0;
        for (int j = tid; j < N; j += 256) cnt += (keys[j] > T) ? 1u : 0u;
#pragma unroll
        for (int off = 32; off >= 1; off >>= 1) cnt += __shfl_xor(cnt, off);
        if (lane == 0) red[wv] = cnt;
        __syncthreads();
        need = 256 - (int)(red[0] + red[1] + red[2] + red[3]);
        __syncthreads();
    }
    int base = 0;
    for (int it = 0; it < SEQ / 256; ++it) {
        const int j = it * 256 + tid; const bool inr = j < N; const unsigned k = inr ? keys[j] : 0u;
        const bool eq = !all && inr && (k == T);
        const unsigned long long eb = __ballot(eq);
        if (lane == 0) red[wv] = (unsigned)__popcll(eb);
        __syncthreads();
        int pre = 0; for (int w = 0; w < wv; ++w) pre += (int)red[w];
        const int tot = (int)(red[0] + red[1] + red[2] + red[3]);
        const int rank = base + pre + (int)__popcll(eb & ((1ull << lane) - 1ull));
        const bool sel = inr && (all || k > T || (eq && rank < need));
        const unsigned long long sb = __ballot(sel);
        if (lane == 0) { mask[(size_t)m * 128 + (j >> 5)] = (unsigned)sb; mask[(size_t)m * 128 + (j >> 5) + 1] = (unsigned)(sb >> 32); }
        base += tot;
        __syncthreads();
    }
}


__global__ void __launch_bounds__(256) dsa_attn_naive(const bf16* __restrict__ proj, const unsigned* __restrict__ mask, const int* __restrict__ pos, const float* __restrict__ rel, bf16* __restrict__ mixed) {
    const int m = blockIdx.x, tid = threadIdx.x, lane = tid & 63, wv = tid >> 6, b = m / SEQ;
    __shared__ int list[256]; __shared__ float dq[256]; __shared__ float p[256][4]; __shared__ float redm[4][4]; __shared__ int cnts[128]; __shared__ int nsel_s;
    unsigned w = tid < 128 ? mask[(size_t)m * 128 + tid] : 0u;
    if (tid < 128) cnts[tid] = __popc(w);
    dq[tid] = bf2f(proj[(size_t)m * NINP + PC_DQ + tid]);
    __syncthreads();
    if (tid == 0) { int a = 0; for (int i = 0; i < 128; ++i) { const int c = cnts[i]; cnts[i] = a; a += c; } nsel_s = a; }
    __syncthreads();
    if (tid < 128) { int off = cnts[tid]; while (w) { const int bit = __ffs(w) - 1; if (off < 256) list[off] = tid * 32 + bit; ++off; w &= w - 1u; } }
    __syncthreads();
    const int nsel = nsel_s < 256 ? nsel_s : 256;
    float lg[4] = {-INFINITY, -INFINITY, -INFINITY, -INFINITY};
    if (tid < nsel) {
        const int j = list[tid]; const bf16* kr = proj + ((size_t)b * SEQ + j) * NINP + PC_DK;
        const int bk = t5_bucket(pos[m] - pos[b * SEQ + j]);
#pragma unroll
        for (int h = 0; h < 4; ++h) { float a = 0.f;
            for (int d = 0; d < 64; ++d) a += dq[h * 64 + d] * bf2f(kr[h * 64 + d]);
            lg[h] = a * 0.125f + rel[bk * 4 + h]; }
    }
    float mxh[4], smh[4];
#pragma unroll
    for (int h = 0; h < 4; ++h) { float v = lg[h];
#pragma unroll
        for (int off = 32; off >= 1; off >>= 1) v = fmaxf(v, __shfl_xor(v, off));
        if (lane == 0) redm[wv][h] = v; }
    __syncthreads();
#pragma unroll
    for (int h = 0; h < 4; ++h) mxh[h] = fmaxf(fmaxf(redm[0][h], redm[1][h]), fmaxf(redm[2][h], redm[3][h]));
    __syncthreads();
    float pe[4];
#pragma unroll
    for (int h = 0; h < 4; ++h) { pe[h] = (tid < nsel) ? expf(lg[h] - mxh[h]) : 0.f; p[tid][h] = pe[h]; float v = pe[h];
#pragma unroll
        for (int off = 32; off >= 1; off >>= 1) v += __shfl_xor(v, off);
        if (lane == 0) redm[wv][h] = v; }
    __syncthreads();
#pragma unroll
    for (int h = 0; h < 4; ++h) smh[h] = (redm[0][h] + redm[1][h]) + (redm[2][h] + redm[3][h]);
    const int hh = tid >> 6;
    float acc = 0.f;
    for (int i = 0; i < nsel; ++i) acc += p[i][hh] * bf2f(proj[((size_t)b * SEQ + list[i]) * NINP + PC_DV + tid]);
    const float den = hh == 0 ? smh[0] : hh == 1 ? smh[1] : hh == 2 ? smh[2] : smh[3];
    mixed[(size_t)m * DM + 768 + tid] = f2bf16(acc / den);
}

__global__ void __launch_bounds__(64) dvt_naive(const bf16* __restrict__ proj, bf16* __restrict__ DVT) {
    const int tile = blockIdx.x >> 2, hh = blockIdx.x & 3, d = threadIdx.x, m0 = tile * 64, b = m0 / SEQ, t0 = m0 % SEQ;
    unsigned pk[32];
#pragma unroll
    for (int i = 0; i < 32; ++i) { const unsigned lo = proj[(size_t)(m0 + 2 * i) * NINP + PC_DV + hh * 64 + d], hi = proj[(size_t)(m0 + 2 * i + 1) * NINP + PC_DV + hh * 64 + d]; pk[i] = lo | (hi << 16); }
    v4u* dst = (v4u*)(DVT + ((size_t)(b * 4 + hh) * 64 + d) * SEQ + t0);
#pragma unroll
    for (int i = 0; i < 8; ++i) dst[i] = (v4u){pk[4 * i], pk[4 * i + 1], pk[4 * i + 2], pk[4 * i + 3]};
}

extern "C" void kernel_launch(void* const* d_in, const int* in_sizes, int n_in, void* d_out, int out_size, void* d_ws, size_t ws_size, hipStream_t stream) {
    static int grid = 0;
    if (grid == 0) {
        if (n_in != 18 || in_sizes[0] != M * DM || out_size != M * DM || ws_size < WS_END) { fprintf(stderr, "kernel_launch: unexpected shapes (n_in %d, in0 %d, out %d, ws %zu); nothing launched\n", n_in, n_in > 0 ? in_sizes[0] : -1, out_size, ws_size); grid = -1; return; }
        int dev = 0, cus = 0, per_cu = 0;
        if (hipGetDevice(&dev) != hipSuccess || hipDeviceGetAttribute(&cus, hipDeviceAttributeMultiprocessorCount, dev) != hipSuccess) { grid = -1; return; }
        if (hipFuncSetAttribute((const void*)fwd, hipFuncAttributeMaxDynamicSharedMemorySize, LDS_BYTES) != hipSuccess) { fprintf(stderr, "kernel_launch: hipFuncSetAttribute failed\n"); grid = -1; return; }
        if (hipOccupancyMaxActiveBlocksPerMultiprocessor(&per_cu, (const void*)fwd, NWAVES * 64, LDS_BYTES) != hipSuccess || per_cu < 1) fprintf(stderr, "kernel_launch: occupancy query reports %d\n", per_cu);
        (void)hipGetLastError();
        grid = cus;
    }
    if (grid < 0) return;
    if (hipMemsetAsync((char*)d_ws + WS_CTL, 0, CTL_ZERO_BYTES, stream) != hipSuccess) return;
    Args a{};
    for (int i = 0; i < 18; ++i) a.in[i] = d_in[i];
    a.out = (float*)d_out; a.ws = (unsigned char*)d_ws; a.pad = 0;
    unsigned char* ws = (unsigned char*)d_ws;
    int region = 0;
    auto launch = [&](int lo, int hi) { a.p_lo = lo; a.p_hi = hi; a.bar_region = region++; hipLaunchKernelGGL(fwd, dim3(grid), dim3(NWAVES * 64), LDS_BYTES, stream, a); };
    launch(0, PH_COUNT);
}
```

```cpp
#include <hip/hip_runtime.h>
#include <hip/hip_bf16.h>
#include <cstdio>
#include <cstdint>
#include <cmath>
constexpr int NB = 8, SEQ = 4096, DM = 1024, DEPTH = 4, M = NB * SEQ;
constexpr int NINP = 3840, DFF = 4096;
constexpr int PC_HQ = 0, PC_HF = 512, PC_HI = 1024, PC_HG = 1536, PC_MQA = 2048, PC_MKVA = 2304, PC_IK = 2304 + 160, PC_IW = 2304 + 224, PC_DQ = 2560, PC_DK = 2816, PC_DV = 3072, PC_IQ = 3328;
constexpr int NIN_SRC = 3752;
constexpr float EPS = 1e-6f;
constexpr float QSCALE = 0.10206207261596577f * 1.4426950408889634f;
namespace pg8 {
#define PG8_LAS __attribute__((address_space(3)))
typedef unsigned short bf16_t;
typedef short bf16x8 __attribute__((ext_vector_type(8)));
typedef float f32x4 __attribute__((ext_vector_type(4)));
typedef unsigned u32x4 __attribute__((ext_vector_type(4)));
constexpr int BM = 256, BK = 64, HALF = 128, HTB = HALF * BK * 2  , STAGE_BYTES = 8 * HTB, NXCD = 8, WGM = 8;

__host__ __device__ __forceinline__ int lds_byte(int r, int c) { const int st = (r >> 4) * 2 + (c >> 5), rr = r & 15, cc = c & 31, ob = rr * 64 + cc * 2; return st * 1024 + (ob ^ (((ob >> 9) & 1) << 5)); }
__host__ __device__ __forceinline__ void stage_rc(int b, int& R, int& C) { const int st = b / 1024, sb = b % 1024, swz = sb ^ (((sb >> 9) & 1) << 5); R = (st >> 1) * 16 + swz / 64; C = (st & 1) * 32 + (swz % 64) / 2; }
__host__ __device__ __forceinline__ int perm32(int rho) { const int n = rho >> 4, i = rho & 15; return 8 * (i >> 2) + 4 * n + (i & 3); }

struct Unit { int pm, pn; };
struct Gemm { const bf16_t* A; const bf16_t* Bt; int M, N, K; int ablk = 0, bblk = 0; };

struct StaticOrder {
    int nM, nN, nwg, G, c; int rev = 0;
    __host__ __device__ void init(int M, int N, int G_, int c_) { nM = M / BM; nN = N / BM; nwg = nM * nN; G = G_; c = c_; }
    __host__ __device__ bool next(int i, Unit& u) const {
        if (rev) { const int nr = nwg / G; if (i >= nr) return false; i = nr - 1 - i; }
        const long L = (long)i * G + c; if (L >= nwg) return false;
        int wgid = (int)L; { const int q = nwg / NXCD, r = nwg % NXCD, xcd = wgid % NXCD, off = wgid / NXCD; wgid = (xcd < r ? xcd * (q + 1) : r * (q + 1) + (xcd - r) * q) + off; }
        const int nig = WGM * nN, gid = wgid / nig, fm = gid * WGM, gsz = (nM - fm) < WGM ? (nM - fm) : WGM;
        u.pm = fm + ((wgid % nig) % gsz); u.pn = (wgid % nig) / gsz; return true;
    }
    __device__ __forceinline__ void a_ready(const Unit&) const {}
    __device__ __forceinline__ void done(const Unit&) const {}
};

__device__ __forceinline__ unsigned cvt_pk_bf16(float lo, float hi) { unsigned r; asm volatile("v_cvt_pk_bf16_f32 %0, %1, %2" : "=v"(r) : "v"(lo), "v"(hi)); return r; }
typedef float f32x2 __attribute__((ext_vector_type(2)));
__device__ __forceinline__ f32x2 gelu_pk(f32x2 v) {
    const f32x2 av = __builtin_elementwise_abs(v), d = av * 0.2316418882f + 1.0f;
    f32x2 t; t.x = __builtin_amdgcn_rcpf(d.x); t.y = __builtin_amdgcn_rcpf(d.y);
    f32x2 q = t * 0.5307027145f + (-0.7265760135f); q = q * t + 0.7107068705f; q = q * t + (-0.142248368f); q = q * t + 0.127414796f; q = q * t;
    const f32x2 s = (v * v) * (-0.72134752044f);
    f32x2 e; e.x = __builtin_amdgcn_exp2f(s.x); e.y = __builtin_amdgcn_exp2f(s.y);
    const f32x2 m = v * (q * e), r = v - m;
    f32x2 o; o.x = v.x < 0.f ? m.x : r.x; o.y = v.y < 0.f ? m.y : r.y; return o;
}

template <int ACT  > struct EpiBf16 {
    static constexpr bool PERM = true, AFTER_DRAIN = false; static_assert(ACT == 0 || ACT == 1, "EpiBf16: ACT is 0 (none) or 1 (gelu_pk)");
    bf16_t* O; int ldc; const float* bias; int split_cols; size_t split_stride; float scale0;
    __device__ __forceinline__ void operator()(const f32x4 (&acc)[2][2][4][2], const Unit& u, int wr, int wc, int fr, int fq) const {
        const int row0 = u.pm * BM + wr * 64 + fr; int colt = u.pn * BM; bf16_t* base = O;
        float sc = 1.f; if (split_cols) { const int t = colt / split_cols; base += (size_t)t * split_stride; colt -= t * split_cols; if (t == 0) sc = scale0; }
        const int col0 = colt + wc * 32 + 8 * fq, bcol0 = u.pn * BM + wc * 32 + 8 * fq;
        f32x4 bv[2][2];
#pragma unroll
        for (int bj = 0; bj < 2; ++bj)
#pragma unroll
            for (int n = 0; n < 2; ++n) bv[bj][n] = bias ? *(const f32x4*)(bias + bcol0 + bj * HALF + 4 * n) : (f32x4){0.f, 0.f, 0.f, 0.f};
#pragma unroll
        for (int ai = 0; ai < 2; ++ai)
#pragma unroll
            for (int m = 0; m < 4; ++m) { bf16_t* rowp = base + (size_t)(row0 + ai * HALF + m * 16) * ldc + col0;
#pragma unroll
                for (int bj = 0; bj < 2; ++bj) { f32x4 v0 = acc[ai][bj][m][0] + bv[bj][0], v1 = acc[ai][bj][m][1] + bv[bj][1];
                    if (ACT == 1) { f32x2 a = gelu_pk((f32x2){v0[0], v0[1]}), b = gelu_pk((f32x2){v0[2], v0[3]}), c = gelu_pk((f32x2){v1[0], v1[1]}), d = gelu_pk((f32x2){v1[2], v1[3]});
                        v0 = (f32x4){a.x, a.y, b.x, b.y}; v1 = (f32x4){c.x, c.y, d.x, d.y}; }
                    v0 = v0 * sc; v1 = v1 * sc; u32x4 w; w.x = cvt_pk_bf16(v0[0], v0[1]); w.y = cvt_pk_bf16(v0[2], v0[3]); w.z = cvt_pk_bf16(v1[0], v1[1]); w.w = cvt_pk_bf16(v1[2], v1[3]);
                    *(u32x4*)(rowp + bj * HALF) = w; } }
    }
};
#ifndef REP_EPI
#define REP_EPI 1
#endif
template <int ACT  > struct EpiScale {
    static constexpr bool PERM = true, AFTER_DRAIN = false; static constexpr int REPS = REP_EPI;
    bf16_t* O; int ldc; const float* part; int blk = 0;
    mutable int cpm = -1; mutable float crs[8];
    __device__ __forceinline__ void operator()(const f32x4 (&acc)[2][2][4][2], const Unit& u, int wr, int wc, int fr, int fq) const {
        const int row0 = u.pm * BM + wr * 64 + fr, col0 = u.pn * BM + wc * 64 + 8 * fq;
        if (u.pm != cpm) {
            cpm = u.pm;
#pragma unroll
            for (int ai = 0; ai < 2; ++ai)
#pragma unroll
                for (int m = 0; m < 4; ++m) {
                    const f32x4* pp = (const f32x4*)(part + (size_t)(row0 + ai * HALF + m * 16) * 16);
                    const f32x4 p0 = pp[0], p1 = pp[1], p2 = pp[2], p3 = pp[3];
                    const float ss = ((p0[0] + p0[1]) + (p0[2] + p0[3])) + ((p1[0] + p1[1]) + (p1[2] + p1[3])) + ((p2[0] + p2[1]) + (p2[2] + p2[3])) + ((p3[0] + p3[1]) + (p3[2] + p3[3]));
                    crs[ai * 4 + m] = __builtin_amdgcn_rsqf(ss * (1.0f / 1024.0f) + 1e-6f);
                }
        }
#pragma unroll
        for (int ai = 0; ai < 2; ++ai)
#pragma unroll
            for (int m = 0; m < 4; ++m) {
                const int row = row0 + ai * HALF + m * 16;
                const float rs = crs[ai * 4 + m];
                bf16_t* rowp = blk ? O + (size_t)(row >> 8) * ((size_t)256 * ldc) + (size_t)(col0 >> 6) * (256 * 64) + (row & 255) * 64 + (col0 & 63) : O + (size_t)row * ldc + col0;
#pragma unroll
                for (int bj = 0; bj < 2; ++bj) {
                    f32x4 v0 = acc[ai][bj][m][0] * rs, v1 = acc[ai][bj][m][1] * rs;
                    if (ACT == 1) {
#pragma unroll
                        for (int e = 0; e < 4; ++e) { const float a = fmaxf(v0[e], 0.f), b = fmaxf(v1[e], 0.f); v0[e] = a * a; v1[e] = b * b; }
                    }
                    u32x4 w; w.x = cvt_pk_bf16(v0[0], v0[1]); w.y = cvt_pk_bf16(v0[2], v0[3]); w.z = cvt_pk_bf16(v1[0], v1[1]); w.w = cvt_pk_bf16(v1[2], v1[3]);
#ifndef EPI_NT
#define EPI_NT 0
#endif
                    if (EPI_NT == 2) { asm volatile("global_store_dwordx4 %0, %1, off sc1\n\ts_nop 1" :: "v"((const __attribute__((address_space(1))) void*)(rowp + bj * 32)), "v"(w) : "memory"); } else if (EPI_NT) __builtin_nontemporal_store(w, (u32x4*)(rowp + bj * 32)); else *(u32x4*)(rowp + bj * 32) = w;
                }
            }
    }
};
struct EpiRes {
    static constexpr bool PERM = true, AFTER_DRAIN = false; static constexpr int REPS = 1;
    bf16_t* hb; float* part_out; bf16_t* hbw = nullptr;
    __device__ __forceinline__ void operator()(const f32x4 (&acc)[2][2][4][2], const Unit& u, int wr, int wc, int fr, int fq) const {
        const int row0 = u.pm * BM + wr * 64 + fr, col0 = u.pn * BM + wc * 64 + 8 * fq;
        u32x4 oldv[8][2];
#define EPIRES_LD(k) do { _Pragma("unroll") for (int bj = 0; bj < 2; ++bj) oldv[k][bj] = *(const u32x4*)(hb + (size_t)(row0 + ((k) >> 2) * HALF + ((k) & 3) * 16) * 1024 + col0 + bj * 32); } while (0)
        EPIRES_LD(0); EPIRES_LD(1); EPIRES_LD(2); EPIRES_LD(3); EPIRES_LD(4); EPIRES_LD(5);
#pragma unroll
        for (int ai = 0; ai < 2; ++ai) {
#pragma unroll
            for (int m = 0; m < 4; ++m) {
                if (ai == 0 && m == 2) { EPIRES_LD(6); EPIRES_LD(7); }
                const int row = row0 + ai * HALF + m * 16;
                float ssq = 0.f;
#pragma unroll
                for (int bj = 0; bj < 2; ++bj) {
                    const u32x4 o = oldv[ai * 4 + m][bj];
                    f32x4 h0, h1;
                    h0[0] = __builtin_bit_cast(float, o.x << 16) + acc[ai][bj][m][0][0]; h0[1] = __builtin_bit_cast(float, o.x & 0xffff0000u) + acc[ai][bj][m][0][1];
                    h0[2] = __builtin_bit_cast(float, o.y << 16) + acc[ai][bj][m][0][2]; h0[3] = __builtin_bit_cast(float, o.y & 0xffff0000u) + acc[ai][bj][m][0][3];
                    h1[0] = __builtin_bit_cast(float, o.z << 16) + acc[ai][bj][m][1][0]; h1[1] = __builtin_bit_cast(float, o.z & 0xffff0000u) + acc[ai][bj][m][1][1];
                    h1[2] = __builtin_bit_cast(float, o.w << 16) + acc[ai][bj][m][1][2]; h1[3] = __builtin_bit_cast(float, o.w & 0xffff0000u) + acc[ai][bj][m][1][3];
                    ssq += (h0[0] * h0[0] + h0[1] * h0[1]) + (h0[2] * h0[2] + h0[3] * h0[3]) + (h1[0] * h1[0] + h1[1] * h1[1]) + (h1[2] * h1[2] + h1[3] * h1[3]);
                    u32x4 w; w.x = cvt_pk_bf16(h0[0], h0[1]); w.y = cvt_pk_bf16(h0[2], h0[3]); w.z = cvt_pk_bf16(h1[0], h1[1]); w.w = cvt_pk_bf16(h1[2], h1[3]);
                    *(u32x4*)((hbw ? hbw : hb) + (size_t)row * 1024 + col0 + bj * 32) = w;
                }
                ssq += __shfl_xor(ssq, 16); ssq += __shfl_xor(ssq, 32);
                if (fq == 0) part_out[(size_t)row * 16 + u.pn * 4 + wc] = ssq;
            }
        }
    }
};
template <class Epi, class Sched, bool ALIGN_EPI = false, bool SP2 = false>
__device__ __forceinline__ void gemm_phase(PG8_LAS unsigned char* lds, const Gemm g, const Sched& S, const Epi& E) {
    int tid_o = threadIdx.x; asm volatile("" : "+v"(tid_o));
    const int tid = tid_o, wid = __builtin_amdgcn_readfirstlane(tid >> 6), lane = tid & 63, wr = wid >> 2, wc = wid & 3, fr = lane & 15, fq = lane >> 4;
    const int K = g.K, nt = K / BK;
    unsigned voffA[2], voffB[2];
#pragma unroll
    for (int i = 0; i < 2; ++i) { int R, C; stage_rc(tid * 16 + i * 8192, R, C); const int Rb = Epi::PERM ? (2 * (R & ~31) + perm32(R & 31)) : R;
        voffA[i] = (unsigned)(R * (g.ablk ? BK : K) + C) * 2u; voffB[i] = (unsigned)(Rb * (g.bblk ? BK : K) + C) * 2u; }
    const size_t kstep = (size_t)(BK * 2);
    const size_t hstep = (size_t)HALF * K * 2;
    const size_t kstepB = g.bblk ? (size_t)BM * BK * 2 : kstep;
    const size_t hstepB = (Epi::PERM ? (size_t)32 : (size_t)HALF) * (g.bblk ? BK : K) * 2;
    const size_t hstepA = g.ablk ? (size_t)HALF * BK * 2 : hstep, kstepA = g.ablk ? (size_t)BM * BK * 2 : kstep;
    const size_t tstep = 2 * hstep;
    const unsigned ldsw = (unsigned)wid * 1024u;
    const int aoff = lds_byte(wr * 64 + fr, fq * 8), boff = lds_byte(wc * 32 + fr, fq * 8);
#define PG8_SA(b, h) (((b) * 2 + (h)) * HTB)
#define PG8_SB(b, h) ((4 + (b) * 2 + (h)) * HTB)
#define PG8_STAGE(bufoff, gbase, voff) do { _Pragma("unroll") for (int _i = 0; _i < 2; ++_i) \
        __builtin_amdgcn_global_load_lds((const unsigned*)((const char*)(gbase) + (voff)[_i]), (PG8_LAS unsigned*)(lds + (bufoff) + ldsw + _i * 8192), 16, 0, 0); } while (0)
#define PG8_LDA(dst, b, h) do { _Pragma("unroll") for (int m = 0; m < 4; ++m) _Pragma("unroll") for (int k = 0; k < 2; ++k) dst[m][k] = *(const PG8_LAS bf16x8*)(lds + PG8_SA(b, h) + aoff + m * 2048 + k * 1024); } while (0)
#define PG8_LDB(dst, b, h) do { _Pragma("unroll") for (int n = 0; n < 2; ++n) _Pragma("unroll") for (int k = 0; k < 2; ++k) dst[n][k] = *(const PG8_LAS bf16x8*)(lds + PG8_SB(b, h) + boff + n * 2048 + k * 1024); } while (0)
#define PG8_MMA(ai, bj, At, Bt) do { __builtin_amdgcn_s_setprio(1); _Pragma("unroll") for (int m = 0; m < 4; ++m) _Pragma("unroll") for (int n = 0; n < 2; ++n) _Pragma("unroll") for (int k = 0; k < 2; ++k) \
        acc[ai][bj][m][n] = __builtin_amdgcn_mfma_f32_16x16x32_bf16(Bt[n][k], At[m][k], acc[ai][bj][m][n], 0, 0, 0); __builtin_amdgcn_s_setprio(0); } while (0)
#define PG8_WAIT_V(n) asm volatile("s_waitcnt vmcnt(" #n ")" ::: "memory")
#define PG8_WAIT_L(n) asm volatile("s_waitcnt lgkmcnt(" #n ")" ::: "memory")
#define PG8_BAR __builtin_amdgcn_s_barrier()
#define PG8_SCHED __builtin_amdgcn_sched_barrier(0)
    Unit cur, nxt; int ui = 0;
    if (!S.next(0, cur)) return;
    f32x4 acc[2][2][4][2];
#pragma unroll
    for (int a = 0; a < 2; ++a)
#pragma unroll
        for (int b = 0; b < 2; ++b)
#pragma unroll
            for (int m = 0; m < 4; ++m)
#pragma unroll
                for (int n = 0; n < 2; ++n) acc[a][b][m][n] = (f32x4){0.f, 0.f, 0.f, 0.f};
    bf16x8 At[4][2], B0[2][2], B1[2][2];
    const char* cA = (const char*)g.A + (size_t)cur.pm * tstep; const char* cB = (const char*)g.Bt + (size_t)cur.pn * tstep;
    S.a_ready(cur);
    if constexpr (SP2) {
        PG8_STAGE(PG8_SB(0, 0), cB, voffB); PG8_STAGE(PG8_SB(0, 1), cB + hstepB, voffB); PG8_STAGE(PG8_SA(0, 0), cA, voffA); PG8_STAGE(PG8_SA(0, 1), cA + hstepA, voffA);
        if (wr == 1) PG8_BAR;
        PG8_WAIT_V(2); PG8_BAR;
        PG8_STAGE(PG8_SB(1, 0), cB + kstepB, voffB); PG8_STAGE(PG8_SA(1, 0), cA + kstepA, voffA); PG8_STAGE(PG8_SB(1, 1), cB + hstepB + kstepB, voffB);
        PG8_WAIT_V(6); PG8_BAR;
    } else {
        PG8_STAGE(PG8_SB(0, 0), cB, voffB); PG8_STAGE(PG8_SA(0, 0), cA, voffA); PG8_STAGE(PG8_SB(0, 1), cB + hstepB, voffB); PG8_STAGE(PG8_SA(0, 1), cA + hstepA, voffA);
        if (wr == 1) PG8_BAR;
        PG8_WAIT_V(4); PG8_BAR;
        PG8_STAGE(PG8_SB(1, 0), cB + kstepB, voffB); PG8_STAGE(PG8_SA(1, 0), cA + kstepA, voffA); PG8_STAGE(PG8_SB(1, 1), cB + hstepB + kstepB, voffB);
        PG8_WAIT_V(6); PG8_BAR;
    }
    for (;;) {
        const bool has_next = S.next(ui + 1, nxt);
        const char* nA0 = has_next ? (const char*)g.A + (size_t)nxt.pm * tstep : cA; const char* nB0 = has_next ? (const char*)g.Bt + (size_t)nxt.pn * tstep : cB;
#ifndef REP_KLOOP
#define REP_KLOOP 1
#endif
        for (int rk_ = 0; rk_ < REP_KLOOP; ++rk_) {
        const char* nA = (rk_ + 1 < REP_KLOOP) ? cA : nA0; const char* nB = (rk_ + 1 < REP_KLOOP) ? cB : nB0;
        if (rk_ > 0) {
#pragma unroll
            for (int a = 0; a < 2; ++a)
#pragma unroll
                for (int b = 0; b < 2; ++b)
#pragma unroll
                    for (int m = 0; m < 4; ++m)
#pragma unroll
                        for (int n = 0; n < 2; ++n) acc[a][b][m][n] = (f32x4){0.f, 0.f, 0.f, 0.f}; }
        for (int t = 0; t < nt; t += 2) {
            const bool last = (t == nt - 2);
            const char* a1 = cA + (size_t)(t + 1) * kstepA;
            const char* a2 = last ? nA : cA + (size_t)(t + 2) * kstepA; const char* b2 = last ? nB : cB + (size_t)(t + 2) * kstepB;
            const char* a3 = a2 + kstepA; const char* b3 = b2 + kstepB;
            if (last && has_next && rk_ + 1 == REP_KLOOP) S.a_ready(nxt);
            if constexpr (SP2) {
            PG8_LDB(B0, 0, 0); PG8_LDB(B1, 0, 1); PG8_SCHED; PG8_LDA(At, 0, 0); PG8_STAGE(PG8_SA(1, 1), a1 + hstepA, voffA);
            PG8_WAIT_V(8); PG8_WAIT_L(0); PG8_BAR; PG8_MMA(0, 0, At, B0); PG8_MMA(0, 1, At, B1); PG8_BAR; PG8_SCHED;
            PG8_LDA(At, 0, 1); PG8_STAGE(PG8_SB(0, 0), b2, voffB); PG8_STAGE(PG8_SB(0, 1), b2 + hstepB, voffB); PG8_STAGE(PG8_SA(0, 0), a2, voffA);
            PG8_WAIT_V(8); PG8_WAIT_L(0); PG8_BAR; PG8_MMA(1, 0, At, B0); PG8_MMA(1, 1, At, B1); PG8_BAR; PG8_SCHED;
            PG8_LDB(B0, 1, 0); PG8_LDB(B1, 1, 1); PG8_SCHED; PG8_LDA(At, 1, 0); PG8_STAGE(PG8_SA(0, 1), a2 + hstepA, voffA);
            PG8_WAIT_V(8); PG8_WAIT_L(0); PG8_BAR; PG8_MMA(0, 0, At, B0); PG8_MMA(0, 1, At, B1); PG8_BAR; PG8_SCHED;
            PG8_LDA(At, 1, 1); PG8_STAGE(PG8_SB(1, 0), b3, voffB); PG8_STAGE(PG8_SB(1, 1), b3 + hstepB, voffB); PG8_STAGE(PG8_SA(1, 0), a3, voffA);
            PG8_WAIT_V(8); PG8_WAIT_L(0); PG8_BAR; PG8_MMA(1, 0, At, B0); PG8_MMA(1, 1, At, B1); PG8_BAR; PG8_SCHED;
            } else {
            PG8_LDB(B0, 0, 0); PG8_SCHED; PG8_LDA(At, 0, 0); PG8_STAGE(PG8_SA(1, 1), a1 + hstepA, voffA);
            PG8_WAIT_L(8); PG8_BAR; PG8_WAIT_L(0); PG8_MMA(0, 0, At, B0); PG8_BAR; PG8_SCHED;
            PG8_LDB(B1, 0, 1); PG8_STAGE(PG8_SB(0, 0), b2, voffB);
            PG8_BAR; PG8_WAIT_L(0); PG8_MMA(0, 1, At, B1); PG8_BAR;
            PG8_LDA(At, 0, 1); PG8_STAGE(PG8_SA(0, 0), a2, voffA);
            PG8_BAR; PG8_WAIT_L(0); PG8_MMA(1, 0, At, B0); PG8_BAR; PG8_SCHED;
            PG8_STAGE(PG8_SB(0, 1), b2 + hstepB, voffB);
            PG8_WAIT_V(6); PG8_BAR; PG8_MMA(1, 1, At, B1); PG8_BAR;
            PG8_LDB(B0, 1, 0); PG8_SCHED; PG8_LDA(At, 1, 0); PG8_STAGE(PG8_SA(0, 1), a2 + hstepA, voffA);
            PG8_WAIT_L(8); PG8_BAR; PG8_WAIT_L(0); PG8_MMA(0, 0, At, B0); PG8_BAR; PG8_SCHED;
            PG8_LDB(B1, 1, 1); PG8_STAGE(PG8_SB(1, 0), b3, voffB);
            PG8_BAR; PG8_WAIT_L(0); PG8_MMA(0, 1, At, B1); PG8_BAR;
            PG8_LDA(At, 1, 1); PG8_STAGE(PG8_SA(1, 0), a3, voffA);
            PG8_BAR; PG8_WAIT_L(0); PG8_MMA(1, 0, At, B0); PG8_BAR; PG8_SCHED;
            PG8_STAGE(PG8_SB(1, 1), b3 + hstepB, voffB);
            PG8_WAIT_V(6); PG8_BAR; PG8_MMA(1, 1, At, B1); PG8_BAR;
            }
        }
        }
        const char* nA = nA0; const char* nB = nB0;
        if constexpr (ALIGN_EPI) { if (wr == 0) PG8_BAR; }
#ifndef PG8_NPF
#define PG8_NPF 0
#endif
        if (has_next && PG8_NPF > 0) {
            const char* pb_ = (tid < 256 ? nA : nB) + (size_t)(tid & 255) * K * 2 + 2 * (BK * 2);
            const unsigned scrap = (unsigned)(unsigned long long)(PG8_LAS unsigned char*)(lds + STAGE_BYTES);
#pragma unroll
            for (int j = 0; j < PG8_NPF; ++j) if (j + 2 < nt) {
                unsigned sv_; asm volatile("s_mov_b32 %0, m0\n\ts_mov_b32 m0, %2\n\ts_nop 0\n\tglobal_load_lds_dword %1, off\n\ts_mov_b32 m0, %0" : "=&s"(sv_) : "v"(pb_ + j * (BK * 2)), "s"(scrap) : "memory"); }
        }
        if constexpr (!Epi::AFTER_DRAIN) { for (int re_ = 0; re_ < Epi::REPS; ++re_) E(acc, cur, wr, wc, fr, fq); S.done(cur); }
        if (!has_next) break;
#pragma unroll
        for (int a = 0; a < 2; ++a)
#pragma unroll
            for (int b = 0; b < 2; ++b)
#pragma unroll
                for (int m = 0; m < 4; ++m)
#pragma unroll
                    for (int n = 0; n < 2; ++n) acc[a][b][m][n] = (f32x4){0.f, 0.f, 0.f, 0.f};
        cur = nxt; cA = nA; cB = nB; ++ui;
        if constexpr (ALIGN_EPI) { if (wr == 1) PG8_BAR; }
    }
    PG8_WAIT_V(0);
    if constexpr (!ALIGN_EPI) { if (wr == 0) PG8_BAR; }
    PG8_BAR;
    if constexpr (Epi::AFTER_DRAIN) { E.fused(acc, cur, wr, wc, fr, fq, lds, wid, lane); S.done(cur); }
#undef PG8_SA
#undef PG8_SB
#undef PG8_STAGE
#undef PG8_LDA
#undef PG8_LDB
#undef PG8_MMA
#undef PG8_WAIT_V
#undef PG8_WAIT_L
#undef PG8_BAR
#undef PG8_SCHED
}
}

#ifndef PG8_SP2
#define PG8_SP2 true
#endif
#ifndef PG8_ALIGN
#define PG8_ALIGN true
#endif
#define GAS __attribute__((address_space(1)))
#define LAS __attribute__((address_space(3)))
typedef unsigned short bf16;
typedef unsigned v4u __attribute__((ext_vector_type(4)));
typedef float f32x4 __attribute__((ext_vector_type(4)));
typedef short bf16x8 __attribute__((ext_vector_type(8)));
typedef GAS unsigned gu32;
typedef GAS unsigned long long gu64;
#define RLX_AGENT __ATOMIC_RELAXED, __HIP_MEMORY_SCOPE_AGENT
#define LDS_WAIT() asm volatile("s_waitcnt lgkmcnt(0)" ::: "memory")
#define VM_WAIT() asm volatile("s_waitcnt vmcnt(0)" ::: "memory")
__device__ __forceinline__ unsigned long long rt() { return __builtin_amdgcn_s_memrealtime(); }
__device__ __forceinline__ unsigned f2bf(float f) { unsigned u = __builtin_bit_cast(unsigned, f); return (u + 0x7fffu + ((u >> 16) & 1u)) >> 16; }
__device__ __forceinline__ unsigned pk2(float lo, float hi) { return f2bf(lo) | (f2bf(hi) << 16); }

#define XB_TMO      128
#define XB_XCNT(j)  (256  + 64 * (j))
#define XB_XSUB(j)  (1280 + 64 * (j))
#define XB_XGEN(j)  (2304 + 64 * (j))
#define XB_TOP      3328
#define XB_TOPGEN   3392
#define XCD_BAR_WORDS 3456
#define XB_SPIN_CAP (1u << 18)

__device__ __forceinline__ unsigned xb_ld(unsigned* p)              { return __hip_atomic_load(p, __ATOMIC_RELAXED, __HIP_MEMORY_SCOPE_AGENT); }
__device__ __forceinline__ unsigned xb_add(unsigned* p, unsigned v) { return __hip_atomic_fetch_add(p, v, __ATOMIC_RELAXED, __HIP_MEMORY_SCOPE_AGENT); }
__device__ __forceinline__ unsigned xb_xcc_id() { return (unsigned)__builtin_amdgcn_s_getreg((3 << 11) | 20) & 0xFu; }
#define XB_SPIN(cond, bar) do { unsigned _sp = 0; while (cond) { __builtin_amdgcn_s_sleep(1); \
    if ((++_sp & 255u) == 0u) { if (xb_ld(&(bar)[XB_TMO])) break; if (_sp > XB_SPIN_CAP) { atomicAdd(&(bar)[XB_TMO], 1u); break; } } } } while (0)

struct XcdBarrier {
    unsigned* bar; unsigned x;
    volatile LAS unsigned* st;
};

__device__ __forceinline__ XcdBarrier xcd_barrier_post(unsigned* bar, volatile LAS unsigned* st) {
    XcdBarrier b; b.bar = bar; b.x = xb_xcc_id(); b.st = st;
    if (threadIdx.x == 0) (void)xb_add(&bar[XB_XCNT(b.x)], 1u);
    return b;
}
__device__ __forceinline__ void xcd_barrier_complete(unsigned* bar, unsigned x, unsigned& nloc, unsigned& nx) {
    const unsigned G = gridDim.x * gridDim.y * gridDim.z;
    unsigned sum, cnt, mine, sp = 0u;
    for (;;) {
        sum = 0u; cnt = 0u; mine = 0u;
#pragma unroll
        for (unsigned j = 0; j < 16; ++j) { const unsigned c = xb_ld(&bar[XB_XCNT(j)]); sum += c; cnt += (c > 0u) ? 1u : 0u; mine = (j == x) ? c : mine; }
        if (sum == G) break;
        __builtin_amdgcn_s_sleep(1);
        if ((++sp & 255u) == 0u) { if (xb_ld(&bar[XB_TMO])) break; if (sp > XB_SPIN_CAP) { atomicAdd(&bar[XB_TMO], 1u); break; } }
    }
    nloc = mine > 0u ? mine : 1u; nx = cnt > 0u ? cnt : 1u;
}

__device__ __forceinline__ void xcd_barrier(const XcdBarrier& b) {
    asm volatile("s_waitcnt vmcnt(0)" ::: "memory");
    __syncthreads();
    if (threadIdx.x == 0) {
        unsigned* bar = b.bar;
        __builtin_amdgcn_s_waitcnt(0);
        unsigned nloc = b.st[0], nx = b.st[1];
        if (nloc == 0u) { xcd_barrier_complete(bar, b.x, nloc, nx); b.st[0] = nloc; b.st[1] = nx; }
        const unsigned old = xb_add(&bar[XB_XSUB(b.x)], 1u);
        const unsigned gen = old / nloc;
        if (old + 1u == (gen + 1u) * nloc) {
            __builtin_amdgcn_fence(__ATOMIC_RELEASE, "agent");
            asm volatile("s_waitcnt vmcnt(0)" ::: "memory");
            const unsigned og = xb_add(&bar[XB_TOP], 1u);
            const unsigned tg = og / nx;
            if (og + 1u == (tg + 1u) * nx) xb_add(&bar[XB_TOPGEN], 1u);
            else XB_SPIN(xb_ld(&bar[XB_TOPGEN]) == tg, bar);
            __builtin_amdgcn_fence(__ATOMIC_ACQUIRE, "agent");
            xb_add(&bar[XB_XGEN(b.x)], 1u);
            asm volatile("s_waitcnt vmcnt(0)" ::: "memory");
        } else {
            XB_SPIN(xb_ld(&bar[XB_XGEN(b.x)]) == gen, bar);
            __builtin_amdgcn_fence(__ATOMIC_ACQUIRE, "agent");
            asm volatile("s_waitcnt vmcnt(0)" ::: "memory");
        }
    }
    __syncthreads();
}
namespace att {
typedef float f32x16 __attribute__((ext_vector_type(16)));
typedef short s16x4 __attribute__((ext_vector_type(4)));
typedef unsigned v2u __attribute__((ext_vector_type(2)));
typedef float f32x2_t __attribute__((ext_vector_type(2))); typedef __bf16 bf16x2_t __attribute__((ext_vector_type(2)));
__device__ __forceinline__ unsigned cvtpk(float lo, float hi) { f32x2_t v = {lo, hi}; bf16x2_t b = __builtin_convertvector(v, bf16x2_t); return __builtin_bit_cast(unsigned, b); }
__device__ __forceinline__ float xhalf_max(float x) { const auto r = __builtin_amdgcn_permlane32_swap(__float_as_uint(x), __float_as_uint(x), false, false); return __builtin_elementwise_maximum(__uint_as_float(r[0]), __uint_as_float(r[1])); }
__device__ __forceinline__ int wave_max_i(int v) {
    v = max(v, __builtin_amdgcn_update_dpp(v, v, 0x111, 0xf, 0xf, false)); v = max(v, __builtin_amdgcn_update_dpp(v, v, 0x112, 0xf, 0xf, false));
    v = max(v, __builtin_amdgcn_update_dpp(v, v, 0x114, 0xf, 0xf, false)); v = max(v, __builtin_amdgcn_update_dpp(v, v, 0x118, 0xf, 0xf, false));
    v = max(v, __builtin_amdgcn_update_dpp(v, v, 0x142, 0xa, 0xf, false)); v = max(v, __builtin_amdgcn_update_dpp(v, v, 0x143, 0xc, 0xf, false));
    return __builtin_amdgcn_readlane(v, 63); }
constexpr int KT = 64, VP = 136;
template <int DQK> struct C { static constexpr int KP = (DQK == 96) ? 208 : 144, KS = DQK / 16, CPR = DQK / 8, KCH = KT * CPR, KBYTES = KT * KP, VBYTES = 64 * VP, STAGE = KBYTES + VBYTES; };
constexpr int LDS_NEED = 3 * C<96>::STAGE;
__device__ __forceinline__ int crow(int r, int hi) { return (r & 3) + 8 * (r >> 2) + 4 * hi; }

template <int DQK, bool SPARSE>
__device__ __forceinline__ void attn_unit(LAS unsigned char* lds, const bf16* Q, int qpitch, const bf16* K, int kpitch, const bf16* VT, bf16* O, int opitch, int q0,
                                          const unsigned* maskb, const int* posb, const LAS float* biastab, int h, float qs) {
    typedef C<DQK> CC;
    int tid_o = threadIdx.x; asm volatile("" : "+v"(tid_o));
    const int tid = tid_o, lane = tid & 63, wave = __builtin_amdgcn_readfirstlane(tid >> 6), r32 = lane & 31, hi = lane >> 5;
    const int qw0 = q0 + wave * 32, myq = qw0 + r32;
    bf16x8 qf[CC::KS];
#pragma unroll
    for (int s = 0; s < CC::KS; ++s) qf[s] = *(const bf16x8*)(Q + (size_t)myq * qpitch + 16 * s + 8 * hi);
    f32x16 o0, o1;
#pragma unroll
    for (int r = 0; r < 16; ++r) { o0[r] = 0.f; o1[r] = 0.f; }
    float mhat = 0.f, lrun = 0.f;
    f32x16 negm;
#pragma unroll
    for (int r = 0; r < 16; ++r) negm[r] = 0.f;
    constexpr float THR = 8.0f;
    const float b31 = SPARSE ? biastab[127 * 4 + h] : 0.f;
    (void)qs;
    int posq = 0, qmin = 0;
    if (SPARSE) { posq = posb[myq]; qmin = -wave_max_i(-posq); }
    const int ntiles = (q0 + 256) / KT;
    const int kc0 = tid, kc1 = tid + 512;
    const bool k1on = kc1 < CC::KCH;
    const int kr0 = kc0 / CC::CPR, kp0 = kc0 % CC::CPR, kr1 = k1on ? kc1 / CC::CPR : 0, kp1 = k1on ? kc1 % CC::CPR : 0;
    const bf16* kg0 = K + (size_t)kr0 * kpitch + kp0 * 8; const bf16* kg1 = K + (size_t)kr1 * kpitch + kp1 * 8;
    const bf16* vg = VT + (size_t)(tid >> 3) * SEQ + (tid & 7) * 8;
    const int kl0 = kr0 * CC::KP + kp0 * 16, kl1 = kr1 * CC::KP + kp1 * 16, vl = CC::KBYTES + (tid >> 3) * VP + (tid & 7) * 16;
    v4u sk0[2], sk1[2], sv[2];
    sk0[0] = *(const v4u*)kg0; sk1[0] = k1on ? *(const v4u*)kg1 : (v4u){0u, 0u, 0u, 0u}; sv[0] = *(const v4u*)vg;
    { const size_t ko = (size_t)KT * kpitch; sk0[1] = *(const v4u*)(kg0 + ko); sk1[1] = k1on ? *(const v4u*)(kg1 + ko) : (v4u){0u, 0u, 0u, 0u}; sv[1] = *(const v4u*)(vg + KT); }
    __syncthreads();
    *(LAS v4u*)(lds + kl0) = sk0[0]; if (k1on) *(LAS v4u*)(lds + kl1) = sk1[0]; *(LAS v2u*)(lds + vl) = (v2u){sv[0].x, sv[0].y}; *(LAS v2u*)(lds + vl + 8) = (v2u){sv[0].z, sv[0].w};
    __syncthreads();
    int scur = 0;
    unsigned mwa = 0u, mwb = 0u;
    if (SPARSE) { mwa = maskb[(size_t)myq]; mwb = maskb[(size_t)SEQ + myq]; }
    for (int it2 = 0; it2 < ntiles; it2 += 2) {
#pragma unroll
      for (int u2 = 0; u2 < 2; ++u2) {
        const int it = it2 + u2;
        const int j0 = it * KT; LAS unsigned char* st = lds + scur * CC::STAGE;
        const int snext = scur == 2 ? 0 : scur + 1;
        if (it + 2 < ntiles) { const size_t ko = (size_t)(j0 + 2 * KT) * kpitch; sk0[u2] = *(const v4u*)(kg0 + ko); if (k1on) sk1[u2] = *(const v4u*)(kg1 + ko); sv[u2] = *(const v4u*)(vg + j0 + 2 * KT); }
        unsigned nmwa = 0u, nmwb = 0u;
        if (SPARSE && it + 1 < ntiles) { nmwa = maskb[(size_t)((j0 + KT) >> 5) * SEQ + myq]; nmwb = maskb[(size_t)(((j0 + KT) >> 5) + 1) * SEQ + myq]; }
        if (j0 <= qw0 + 31) {
            f32x16 p0, p1;
            const LAS unsigned char* kb = st + r32 * CC::KP + hi * 16;
            bf16x8 ka0[CC::KS], ka1[CC::KS];
#pragma unroll
            for (int s = 0; s < CC::KS; ++s) { ka0[s] = *(const LAS bf16x8*)(kb + s * 32); ka1[s] = *(const LAS bf16x8*)(kb + 32 * CC::KP + s * 32); }
            __builtin_amdgcn_sched_barrier(0);
#pragma unroll
            for (int s = 0; s < CC::KS; ++s) {
                p0 = __builtin_amdgcn_mfma_f32_32x32x16_bf16(ka0[s], qf[s], s == 0 ? negm : p0, 0, 0, 0);
                p1 = __builtin_amdgcn_mfma_f32_32x32x16_bf16(ka1[s], qf[s], s == 0 ? negm : p1, 0, 0, 0);
            }
            const LAS unsigned char* vb = st + CC::KBYTES + r32 * VP + hi * 8;
            s16x4 va_lo[4], va_hi[4], vb_lo[4], vb_hi[4];
#pragma unroll
            for (int s = 0; s < 4; ++s) { va_lo[s] = *(const LAS s16x4*)(vb + s * 32); va_hi[s] = *(const LAS s16x4*)(vb + s * 32 + 16); vb_lo[s] = *(const LAS s16x4*)(vb + 32 * VP + s * 32); vb_hi[s] = *(const LAS s16x4*)(vb + 32 * VP + s * 32 + 16); }
            __builtin_amdgcn_sched_barrier(0);
            if (SPARSE) {
                const int kmax = wave_max_i(posb[j0 + lane]);
                const bool far = (qmin - kmax >= 113);
                if (!far) {
#pragma unroll
                    for (int r = 0; r < 16; ++r) { int d0 = posq - posb[j0 + crow(r, hi)], d1 = posq - posb[j0 + 32 + crow(r, hi)];
                        d0 = d0 < 0 ? 0 : (d0 > 127 ? 127 : d0); d1 = d1 < 0 ? 0 : (d1 > 127 ? 127 : d1);
                        p0[r] += biastab[d0 * 4 + h] - b31; p1[r] += biastab[d1 * 4 + h] - b31; } }
                const int w0 = (int)(mwa >> (4 * hi)), w1 = (int)(mwb >> (4 * hi));
#pragma unroll
                for (int r = 0; r < 16; ++r) { const unsigned m0 = (unsigned)__builtin_amdgcn_sbfe(w0, (r & 3) + 8 * (r >> 2), 1), m1 = (unsigned)__builtin_amdgcn_sbfe(w1, (r & 3) + 8 * (r >> 2), 1);
                    p0[r] = __uint_as_float((__float_as_uint(p0[r]) & m0) | (0xff800000u & ~m0)); p1[r] = __uint_as_float((__float_as_uint(p1[r]) & m1) | (0xff800000u & ~m1)); }
            } else if (j0 + KT - 1 > qw0) {
#pragma unroll
                for (int r = 0; r < 16; ++r) { const int key = j0 + crow(r, hi); if (key > myq) p0[r] = -INFINITY; if (key + 32 > myq) p1[r] = -INFINITY; }
            }
            float mx = __builtin_elementwise_maximum(p0[0], p1[0]), mxb = __builtin_elementwise_maximum(p0[1], p1[1]);
#pragma unroll
            for (int r = 2; r < 16; r += 2) { mx = __builtin_elementwise_maximum(__builtin_elementwise_maximum(mx, p0[r]), p1[r]); mxb = __builtin_elementwise_maximum(__builtin_elementwise_maximum(mxb, p0[r + 1]), p1[r + 1]); }
            mx = __builtin_elementwise_maximum(mx, mxb);
            mx = xhalf_max(mx);
            if (it == 0 || __any(mx > THR)) {
                const float dl = (it == 0) ? ((mx == -INFINITY) ? 0.f : mx) : fmaxf(mx, 0.f);
                mhat += dl;
#pragma unroll
                for (int r = 0; r < 16; ++r) { p0[r] -= dl; p1[r] -= dl; }
                const float alpha = __builtin_amdgcn_exp2f(-dl);
                lrun *= alpha;
#pragma unroll
                for (int r = 0; r < 16; ++r) { o0[r] *= alpha; o1[r] *= alpha; }
                const float nm = -mhat;
#pragma unroll
                for (int r = 0; r < 16; ++r) negm[r] = nm;
            }
            float rsa = 0.f, rsb = 0.f, rsc = 0.f, rsd = 0.f;
#pragma unroll
            for (int r = 0; r < 16; r += 2) { p0[r] = __builtin_amdgcn_exp2f(p0[r]); p1[r] = __builtin_amdgcn_exp2f(p1[r]); p0[r + 1] = __builtin_amdgcn_exp2f(p0[r + 1]); p1[r + 1] = __builtin_amdgcn_exp2f(p1[r + 1]);
                rsa += p0[r]; rsb += p1[r]; rsc += p0[r + 1]; rsd += p1[r + 1]; }
            lrun += (rsa + rsb) + (rsc + rsd);
#pragma unroll
            for (int s = 0; s < 4; ++s) {
                v4u pw;
                if (s < 2) { pw.x = cvtpk(p0[8 * s + 0], p0[8 * s + 1]); pw.y = cvtpk(p0[8 * s + 2], p0[8 * s + 3]); pw.z = cvtpk(p0[8 * s + 4], p0[8 * s + 5]); pw.w = cvtpk(p0[8 * s + 6], p0[8 * s + 7]); }
                else { const int q = s - 2; pw.x = cvtpk(p1[8 * q + 0], p1[8 * q + 1]); pw.y = cvtpk(p1[8 * q + 2], p1[8 * q + 3]); pw.z = cvtpk(p1[8 * q + 4], p1[8 * q + 5]); pw.w = cvtpk(p1[8 * q + 6], p1[8 * q + 7]); }
                const bf16x8 pf = __builtin_bit_cast(bf16x8, pw);
                const s16x4 a_lo = va_lo[s], a_hi = va_hi[s], b_lo = vb_lo[s], b_hi = vb_hi[s];
                const bf16x8 va = (bf16x8){a_lo[0], a_lo[1], a_lo[2], a_lo[3], a_hi[0], a_hi[1], a_hi[2], a_hi[3]};
                const bf16x8 vb2 = (bf16x8){b_lo[0], b_lo[1], b_lo[2], b_lo[3], b_hi[0], b_hi[1], b_hi[2], b_hi[3]};
                o0 = __builtin_amdgcn_mfma_f32_32x32x16_bf16(va, pf, o0, 0, 0, 0);
                o1 = __builtin_amdgcn_mfma_f32_32x32x16_bf16(vb2, pf, o1, 0, 0, 0);
            }
        }
        if (it + 1 < ntiles) { LAS unsigned char* sn = lds + snext * CC::STAGE; *(LAS v4u*)(sn + kl0) = sk0[u2 ^ 1]; if (k1on) *(LAS v4u*)(sn + kl1) = sk1[u2 ^ 1]; *(LAS v2u*)(sn + vl) = (v2u){sv[u2 ^ 1].x, sv[u2 ^ 1].y}; *(LAS v2u*)(sn + vl + 8) = (v2u){sv[u2 ^ 1].z, sv[u2 ^ 1].w}; }
        if (SPARSE) { mwa = nmwa; mwb = nmwb; }
        scur = snext;
        __syncthreads();
      }
    }
    float lt = lrun + __shfl_xor(lrun, 32);
    const float inv = 1.0f / lt;
    LAS unsigned char* ost = lds + wave * (32 * 144);
#pragma unroll
    for (int g = 0; g < 4; ++g) {
        v2u w0, w1;
        w0.x = cvtpk(o0[4 * g] * inv, o0[4 * g + 1] * inv); w0.y = cvtpk(o0[4 * g + 2] * inv, o0[4 * g + 3] * inv);
        w1.x = cvtpk(o1[4 * g] * inv, o1[4 * g + 1] * inv); w1.y = cvtpk(o1[4 * g + 2] * inv, o1[4 * g + 3] * inv);
        *(LAS v2u*)(ost + r32 * 144 + (8 * g + 4 * hi) * 2) = w0; *(LAS v2u*)(ost + r32 * 144 + (32 + 8 * g + 4 * hi) * 2) = w1;
    }
    asm volatile("s_waitcnt lgkmcnt(0)" ::: "memory");
#pragma unroll
    for (int ps = 0; ps < 4; ++ps) { const int rr = 8 * ps + (lane >> 3), pc = lane & 7;
        const v4u v = *(const LAS v4u*)(ost + rr * 144 + pc * 16);
        *(v4u*)(O + (size_t)(qw0 + rr) * opitch + pc * 8) = v; }
}
}
namespace prep {
typedef float f32x16 __attribute__((ext_vector_type(16)));
typedef unsigned v2u __attribute__((ext_vector_type(2)));
__device__ __forceinline__ int crow(int r, int hi) { return (r & 3) + 8 * (r >> 2) + 4 * hi; }
__device__ __forceinline__ float sumsq8(const bf16x8 v) {
    float s = 0.f;
#pragma unroll
    for (int j = 0; j < 8; ++j) { const float x = __uint_as_float((unsigned)(unsigned short)v[j] << 16); s += x * x; }
    return s;
}
constexpr int WQ_PITCH = 400, WKV_PITCH = 272, MLA_WLDS_BYTES = 384 * WQ_PITCH;
template <bool WLDS = false>
__device__ __forceinline__ void mla_prep_unit(const bf16* __restrict__ proj, const bf16* __restrict__ wqb_t, const bf16* __restrict__ wkvb_t, const float* __restrict__ cs, const float* __restrict__ sn,
                                              bf16* __restrict__ Q, bf16* __restrict__ K, bf16* __restrict__ VT, int u, int lane, int part, const LAS unsigned char* wl = nullptr) {
    int lane_o = lane; asm volatile("" : "+v"(lane_o));
    const int r32 = lane_o & 31, hi = lane_o >> 5, tok = u * 32 + r32, b = tok / SEQ, t = tok % SEQ;
    const bf16* row = proj + (size_t)tok * NINP;
    if (part == 0) {
        bf16x8 bq[12]; float ss = 0.f;
#pragma unroll
        for (int s = 0; s < 12; ++s) { bq[s] = *(const bf16x8*)(row + PC_MQA + 16 * s + 8 * hi); ss += sumsq8(bq[s]); }
        ss += __shfl_xor(ss, 32);
        const float rq = (1.0f / sqrtf(ss * (1.0f / 192.0f) + EPS)) * QSCALE;
        const f32x4 c0 = *(const f32x4*)(cs + (size_t)tok * 16 + 4 * hi), c1 = *(const f32x4*)(cs + (size_t)tok * 16 + 8 + 4 * hi);
        const f32x4 s0 = *(const f32x4*)(sn + (size_t)tok * 16 + 4 * hi), s1 = *(const f32x4*)(sn + (size_t)tok * 16 + 8 + 4 * hi);
        bf16x8 wf[12];
        if (!WLDS) {
#pragma unroll
            for (int s = 0; s < 12; ++s) wf[s] = *(const bf16x8*)(wqb_t + (size_t)r32 * 192 + 8 * hi + 16 * s); }
#pragma unroll 1
        for (int nt = 0; nt < 12; ++nt) {
            f32x16 acc;
#pragma unroll
            for (int r = 0; r < 16; ++r) acc[r] = 0.f;
            if (WLDS) {
#pragma unroll
                for (int s = 0; s < 12; ++s) wf[s] = *(const LAS bf16x8*)(wl + (nt * 32 + r32) * WQ_PITCH + (8 * hi + 16 * s) * 2); }
            const bf16* wr = wqb_t + (size_t)((nt < 11 ? nt + 1 : nt) * 32 + r32) * 192 + 8 * hi;
#pragma unroll
            for (int s = 0; s < 12; ++s) acc = __builtin_amdgcn_mfma_f32_32x32x16_bf16(wf[s], bq[s], acc, 0, 0, 0);
            if (!WLDS) {
#pragma unroll
                for (int s = 0; s < 12; ++s) wf[s] = *(const bf16x8*)(wr + 16 * s); }
            const int hh = nt / 3, part = nt % 3;
            bf16* qo = Q + (size_t)tok * 384 + hh * 96 + part * 32;
            if (part < 2) {
#pragma unroll
                for (int g = 0; g < 4; ++g) { v2u w; w.x = att::cvtpk(acc[4 * g] * rq, acc[4 * g + 1] * rq); w.y = att::cvtpk(acc[4 * g + 2] * rq, acc[4 * g + 3] * rq); *(v2u*)(qo + 8 * g + 4 * hi) = w; }
            } else {
                float o1[8], o2[8];
#pragma unroll
                for (int r = 0; r < 8; ++r) { const float c = r < 4 ? c0[r & 3] : c1[r & 3], s = r < 4 ? s0[r & 3] : s1[r & 3]; const float x1 = acc[r] * rq, x2 = acc[r + 8] * rq; o1[r] = x1 * c - x2 * s; o2[r] = x2 * c + x1 * s; }
#pragma unroll
                for (int g = 0; g < 2; ++g) { v2u w; w.x = att::cvtpk(o1[4 * g], o1[4 * g + 1]); w.y = att::cvtpk(o1[4 * g + 2], o1[4 * g + 3]); *(v2u*)(qo + 8 * g + 4 * hi) = w;
                    v2u w2; w2.x = att::cvtpk(o2[4 * g], o2[4 * g + 1]); w2.y = att::cvtpk(o2[4 * g + 2], o2[4 * g + 3]); *(v2u*)(qo + 16 + 8 * g + 4 * hi) = w2; }
            }
        }
    }
    if (part == 1) {
        bf16x8 bk[8]; float ss = 0.f;
#pragma unroll
        for (int s = 0; s < 8; ++s) { bk[s] = *(const bf16x8*)(row + PC_MKVA + 16 * s + 8 * hi); ss += sumsq8(bk[s]); }
        ss += __shfl_xor(ss, 32);
        const float rkv = 1.0f / sqrtf(ss * (1.0f / 128.0f) + EPS);
        bf16x8 wf[8];
        if (!WLDS) {
#pragma unroll
            for (int s = 0; s < 8; ++s) wf[s] = *(const bf16x8*)(wkvb_t + (size_t)r32 * 128 + 8 * hi + 16 * s); }
#pragma unroll 1
        for (int nt = 0; nt < 16; ++nt) {
            f32x16 acc;
#pragma unroll
            for (int r = 0; r < 16; ++r) acc[r] = 0.f;
            if (WLDS) {
#pragma unroll
                for (int s = 0; s < 8; ++s) wf[s] = *(const LAS bf16x8*)(wl + (nt * 32 + r32) * WKV_PITCH + (8 * hi + 16 * s) * 2); }
            const bf16* wr = wkvb_t + (size_t)((nt < 15 ? nt + 1 : nt) * 32 + r32) * 128 + 8 * hi;
#pragma unroll
            for (int s = 0; s < 8; ++s) acc = __builtin_amdgcn_mfma_f32_32x32x16_bf16(wf[s], bk[s], acc, 0, 0, 0);
            if (!WLDS) {
#pragma unroll
                for (int s = 0; s < 8; ++s) wf[s] = *(const bf16x8*)(wr + 16 * s); }
            const int hh = nt >> 2, part = nt & 3;
            if (part < 2) {
                bf16* ko = K + (size_t)tok * 384 + hh * 96 + part * 32;
#pragma unroll
                for (int g = 0; g < 4; ++g) { v2u w; w.x = att::cvtpk(acc[4 * g] * rkv, acc[4 * g + 1] * rkv); w.y = att::cvtpk(acc[4 * g + 2] * rkv, acc[4 * g + 3] * rkv); *(v2u*)(ko + 8 * g + 4 * hi) = w; }
            } else {
                bf16* vo = VT + ((size_t)(b * 4 + hh) * 64 + (part - 2) * 32) * SEQ + t;
#pragma unroll
                for (int r = 0; r < 16; ++r) vo[(size_t)crow(r, hi) * SEQ] = (bf16)f2bf(acc[r] * rkv);
            }
        }
    }
    if (part == 1) {
        const bf16x8 x1 = *(const bf16x8*)(row + PC_MKVA + 128 + 8 * hi), x2 = *(const bf16x8*)(row + PC_MKVA + 144 + 8 * hi);
        const f32x4 ca = *(const f32x4*)(cs + (size_t)tok * 16 + 8 * hi), cb = *(const f32x4*)(cs + (size_t)tok * 16 + 8 * hi + 4);
        const f32x4 sa = *(const f32x4*)(sn + (size_t)tok * 16 + 8 * hi), sb = *(const f32x4*)(sn + (size_t)tok * 16 + 8 * hi + 4);
        float o1[8], o2[8];
#pragma unroll
        for (int j = 0; j < 8; ++j) { const float a = __uint_as_float((unsigned)(unsigned short)x1[j] << 16), bb = __uint_as_float((unsigned)(unsigned short)x2[j] << 16);
            const float c = j < 4 ? ca[j & 3] : cb[j & 3], s = j < 4 ? sa[j & 3] : sb[j & 3]; o1[j] = a * c - bb * s; o2[j] = bb * c + a * s; }
        v4u w1, w2; w1.x = att::cvtpk(o1[0], o1[1]); w1.y = att::cvtpk(o1[2], o1[3]); w1.z = att::cvtpk(o1[4], o1[5]); w1.w = att::cvtpk(o1[6], o1[7]);
        w2.x = att::cvtpk(o2[0], o2[1]); w2.y = att::cvtpk(o2[2], o2[3]); w2.z = att::cvtpk(o2[4], o2[5]); w2.w = att::cvtpk(o2[6], o2[7]);
#pragma unroll
        for (int hh = 0; hh < 4; ++hh) { *(v4u*)(K + (size_t)tok * 384 + hh * 96 + 64 + 8 * hi) = w1; *(v4u*)(K + (size_t)tok * 384 + hh * 96 + 80 + 8 * hi) = w2; }
    }
}

__device__ __forceinline__ unsigned mono_key2(float s) { const unsigned u = __float_as_uint(s + 0.0f); return (u & 0x80000000u) ? ~u : (u | 0x80000000u); }

__device__ __forceinline__ void dsa_select_unit(LAS unsigned char* lds, const bf16* __restrict__ projb  , const bf16* __restrict__ KIb, const float* __restrict__ WIb, unsigned* __restrict__ maskb, int t0) {
    int tid_o = threadIdx.x; asm volatile("" : "+v"(tid_o));
    const int tid = tid_o, lane = tid & 63, wave = __builtin_amdgcn_readfirstlane(tid >> 6), r32 = lane & 31, hi = lane >> 5;
    LAS unsigned* keys = (LAS unsigned*)lds;
    bf16x8 aq[2][4];
    { const int i = r32, e = i & 3, g = (i >> 3), hh = (i >> 2) & 1; const int ql = 2 * hh + (g >> 1), head = 4 * (g & 1) + e;
#pragma unroll
      for (int rt = 0; rt < 2; ++rt)
#pragma unroll
          for (int s = 0; s < 4; ++s) aq[rt][s] = *(const bf16x8*)(projb + (size_t)(t0 + 4 * rt + ql) * NINP + PC_IQ + head * 64 + 16 * s + 8 * hi); }
    float wv[2][2][8];
#pragma unroll
    for (int rt = 0; rt < 2; ++rt)
#pragma unroll
        for (int w2 = 0; w2 < 2; ++w2) { const f32x4 a = *(const f32x4*)(WIb + (size_t)(t0 + 4 * rt + 2 * hi + w2) * 8), bq = *(const f32x4*)(WIb + (size_t)(t0 + 4 * rt + 2 * hi + w2) * 8 + 4);
            wv[rt][w2][0] = a[0]; wv[rt][w2][1] = a[1]; wv[rt][w2][2] = a[2]; wv[rt][w2][3] = a[3]; wv[rt][w2][4] = bq[0]; wv[rt][w2][5] = bq[1]; wv[rt][w2][6] = bq[2]; wv[rt][w2][7] = bq[3]; }
    const int ntile = (t0 + 8 + 31) >> 5;
    __syncthreads();
#ifndef SEL_REP_SCORE
#define SEL_REP_SCORE 1
#endif
#ifndef SEL_REP_SEARCH
#define SEL_REP_SEARCH 1
#endif
    for (int rsc = 0; rsc < SEL_REP_SCORE; ++rsc) {
    bf16x8 kf[4];
    if (wave < ntile) {
#pragma unroll
        for (int s = 0; s < 4; ++s) kf[s] = *(const bf16x8*)(KIb + (size_t)(wave * 32 + r32) * 64 + 16 * s + 8 * hi); }
    for (int tt = wave; tt < ntile; tt += 8) {
        const int j0 = tt * 32;
        bf16x8 kn[4];
        { const int jn = (tt + 8 < ntile) ? (tt + 8) * 32 : j0;
#pragma unroll
          for (int s = 0; s < 4; ++s) kn[s] = *(const bf16x8*)(KIb + (size_t)(jn + r32) * 64 + 16 * s + 8 * hi); }
#pragma unroll
        for (int rt = 0; rt < 2; ++rt) {
            f32x16 acc;
#pragma unroll
            for (int r = 0; r < 16; ++r) acc[r] = 0.f;
#pragma unroll
            for (int s = 0; s < 4; ++s) acc = __builtin_amdgcn_mfma_f32_32x32x16_bf16(aq[rt][s], kf[s], acc, 0, 0, 0);
#pragma unroll
            for (int w2 = 0; w2 < 2; ++w2) { float sc = 0.f;
#pragma unroll
                for (int hd = 0; hd < 8; ++hd) sc += fmaxf(acc[8 * w2 + hd], 0.f) * wv[rt][w2][hd];
                keys[(4 * rt + 2 * hi + w2) * SEQ + j0 + r32] = __float_as_uint(sc + 0.0f); }
        }
#pragma unroll
        for (int s = 0; s < 4; ++s) kf[s] = kn[s];
    }
    __syncthreads();
    }
    for (int rse = 0; rse < SEL_REP_SEARCH; ++rse) {
    const int t = t0 + wave, N = t + 1, R = (N + 63) >> 6, nl = N - lane;
    float sr[64];
#pragma unroll
    for (int r = 0; r < 64; ++r) sr[r] = (r < R && 64 * r < nl) ? __uint_as_float(keys[wave * SEQ + 64 * r + lane]) : 0.f;
    unsigned long long mysel = 0ull;
    if (N <= 256) {
#pragma unroll
        for (int r = 0; r < 4; ++r) { const unsigned long long sel = __ballot(64 * r < nl); if (lane == r) mysel = sel; }
    } else {
        LAS unsigned* hist = (LAS unsigned*)(lds + 131072) + wave * 512;
        LAS unsigned* list = (LAS unsigned*)(lds + 131072 + 16384) + wave * 64;
        bool fast = true; unsigned bstar = 0u; int need16 = 256; unsigned T32 = 0u;
        unsigned bp[32];
        {
            float lo = INFINITY, hi2 = -INFINITY;
#pragma unroll
            for (int r = 0; r < 64; ++r) if (r < R) { const bool v = 64 * r < nl; lo = fminf(lo, v ? sr[r] : INFINITY); hi2 = fmaxf(hi2, v ? sr[r] : -INFINITY); }
#pragma unroll
            for (int off = 32; off >= 1; off >>= 1) { lo = fminf(lo, __shfl_xor(lo, off)); hi2 = fmaxf(hi2, __shfl_xor(hi2, off)); }
            const float span = hi2 - lo;
            fast = (span > 0.f) && (span < 3.0e38f);
            const float inv = fast ? 511.9f / span : 0.f;
            { v4u z = {0u, 0u, 0u, 0u}; *(LAS v4u*)(hist + 8 * lane) = z; *(LAS v4u*)(hist + 8 * lane + 4) = z; }
            list[lane] = 0u;
#pragma unroll
            for (int r = 0; r < 64; ++r) {
                unsigned b = 0u;
                if (r < R) { b = (unsigned)((sr[r] - lo) * inv); b = b > 511u ? 511u : b; if (64 * r < nl) __hip_atomic_fetch_add(hist + b, 1u, __ATOMIC_RELAXED, __HIP_MEMORY_SCOPE_WORKGROUP); }
                if (r & 1) bp[r >> 1] |= b << 16; else bp[r >> 1] = b;
            }
            asm volatile("s_waitcnt lgkmcnt(0)" ::: "memory");
            const v4u h0 = *(const LAS v4u*)(hist + 8 * lane), h1 = *(const LAS v4u*)(hist + 8 * lane + 4);
            const unsigned own = (h0.x + h0.y) + (h0.z + h0.w) + (h1.x + h1.y) + (h1.z + h1.w);
            unsigned suf = own;
#pragma unroll
            for (int off = 1; off < 64; off <<= 1) { const unsigned o = __shfl_down(suf, off); suf += (lane + off < 64) ? o : 0u; }
            const int L = (int)__popcll(__ballot(suf >= 256u)) - 1;
            int c = (int)__shfl(suf - own, L);
            const unsigned g0 = __shfl(h0.x, L), g1 = __shfl(h0.y, L), g2 = __shfl(h0.z, L), g3 = __shfl(h0.w, L), g4 = __shfl(h1.x, L), g5 = __shfl(h1.y, L), g6 = __shfl(h1.z, L), g7 = __shfl(h1.w, L);
            int bsel = 0, cab = c; bool found = false;
#define STEP_BIN(gv, idx) if (!found) { if (c + (int)(gv) >= 256) { found = true; bsel = (idx); cab = c; } else c += (int)(gv); }
            STEP_BIN(g7, 7) STEP_BIN(g6, 6) STEP_BIN(g5, 5) STEP_BIN(g4, 4) STEP_BIN(g3, 3) STEP_BIN(g2, 2) STEP_BIN(g1, 1) STEP_BIN(g0, 0)
#undef STEP_BIN
            bstar = (unsigned)(8 * L + bsel); need16 = 256 - cab;
            fast = fast && found && (L >= 0);
            int base = 0;
            if (fast) {
                const unsigned long long ltm = (1ull << lane) - 1ull;
#pragma unroll
                for (int r = 0; r < 64; ++r) if (r < R) {
                    const unsigned b = (r & 1) ? (bp[r >> 1] >> 16) : (bp[r >> 1] & 0xffffu);
                    const bool inb = (b == bstar) && (64 * r < nl);
                    const unsigned long long m = __ballot(inb);
                    if (m) { const int pos = base + (int)__popcll(m & ltm); if (inb && pos < 64) list[pos] = mono_key2(sr[r]); base += (int)__popcll(m); }
                }
                fast = base <= 64;
            }
        }
        if (fast) {
            asm volatile("s_waitcnt lgkmcnt(0)" ::: "memory");
            const unsigned cv = list[lane];
#pragma unroll 1
            for (int bit = 31; bit >= 0; --bit) { const unsigned cand = T32 | (1u << bit); if ((int)__popcll(__ballot(cv >= cand)) >= need16) T32 = cand; }
        } else {
            need16 = 256;
#define CNT_GE(cand, out) do { int c_ = 0; _Pragma("unroll") for (int g8 = 0; g8 < 8; ++g8) if (g8 * 8 < R) { _Pragma("unroll") for (int q = 0; q < 8; ++q) \
                c_ += (int)__popcll(__ballot((64 * (g8 * 8 + q) < nl) && mono_key2(sr[g8 * 8 + q]) >= (cand))); } (out) = c_; } while (0)
#pragma unroll 1
            for (int bit = 31; bit >= 0; --bit) { const unsigned cand = T32 | (1u << bit); int cnt; CNT_GE(cand, cnt); if (cnt >= 256) T32 = cand; }
#undef CNT_GE
        }
        int taken = 0;
        int ngt = 0;
#pragma unroll
        for (int r = 0; r < 64; ++r) if (r < R) {
            const unsigned b = (r & 1) ? (bp[r >> 1] >> 16) : (bp[r >> 1] & 0xffffu);
            const bool v = 64 * r < nl, cand = v && (!fast || b == bstar);
            ngt += (int)__popcll(__ballot(cand && mono_key2(sr[r]) > T32));
        }
        const int need_eq = need16 - ngt;
#pragma unroll
        for (int r = 0; r < 64; ++r) {
            unsigned long long sel = 0ull;
            if (r < R) {
                const unsigned b = (r & 1) ? (bp[r >> 1] >> 16) : (bp[r >> 1] & 0xffffu);
                const bool v = 64 * r < nl, cand = v && (!fast || b == bstar);
                sel = fast ? __ballot(v && b > bstar) : 0ull;
                const unsigned long long cm = __ballot(cand);
                if (cm) { const unsigned mk = mono_key2(sr[r]);
                    unsigned long long eqm = __ballot(cand && mk == T32);
                    sel |= __ballot(cand && mk > T32);
                    int ce = (int)__popcll(eqm);
                    if (taken + ce > need_eq) { int keep = need_eq - taken; keep = keep < 0 ? 0 : keep; while (ce > keep) { eqm &= ~(1ull << (63 - __clzll((long long)eqm))); --ce; } }
                    taken += ce; sel |= eqm; }
            }
            if (lane == r) mysel = sel;
        }
    }
    *(v2u*)(maskb + (size_t)t * 128 + 2 * lane) = (v2u){(unsigned)mysel, (unsigned)(mysel >> 32)};
    }
}
}
namespace sel2 {
typedef float f32x16 __attribute__((ext_vector_type(16)));
typedef unsigned v2u __attribute__((ext_vector_type(2)));
constexpr int L_HIST = 0, L_MASK = 16384, L_MLIST = 20480, L_CTL = 24576, L_SKEYS = 32768, L_END = 49152;
constexpr int C_AMAX = 0, C_MCNT = 8, C_BSTAR = 16, C_NEED = 24, C_SLOW = 32;
__device__ __forceinline__ unsigned mono(float s) { const unsigned u = __float_as_uint(s + 0.0f); return (u & 0x80000000u) ? ~u : (u | 0x80000000u); }

__device__ __forceinline__ void slow_query(const LAS unsigned* skeys, LAS unsigned* maskrow, int N, int lane) {
    const int R = (N + 63) >> 6;
    unsigned kr[64];
#pragma unroll
    for (int r = 0; r < 64; ++r) { const int j = 64 * r + lane; kr[r] = (r < R && j < N) ? skeys[j] : 0u; }
    unsigned T = 0u;
#define CNT_GE(cand, out) do { int c_ = 0; _Pragma("unroll") for (int g8 = 0; g8 < 8; ++g8) if (g8 * 8 < R) { _Pragma("unroll") for (int q = 0; q < 8; ++q) c_ += (int)__popcll(__ballot(kr[g8 * 8 + q] >= (cand))); } (out) = c_; } while (0)
#pragma unroll 1
    for (int bit = 31; bit >= 0; --bit) { const unsigned cand = T | (1u << bit); int cnt; CNT_GE(cand, cnt); if (cnt >= 256) T = cand; }
    int gt; { const unsigned c4 = T + 1u; CNT_GE(c4, gt); }
#undef CNT_GE
    const int need = 256 - gt;
    int base = 0;
#pragma unroll
    for (int r = 0; r < 64; ++r) {
        const unsigned long long gtm = __ballot(kr[r] > T); unsigned long long eqm = __ballot(kr[r] == T && (64 * r + lane) < N);
        int c = (int)__popcll(eqm);
        if (base + c > need) { int keep = need - base; keep = keep < 0 ? 0 : keep; while (c > keep) { eqm &= ~(1ull << (63 - __clzll((long long)eqm))); --c; } }
        base += c; const unsigned long long sel = gtm | eqm;
        if (lane == 0) { maskrow[2 * r] = (unsigned)sel; maskrow[2 * r + 1] = (unsigned)(sel >> 32); }
    }
}

__device__ __forceinline__ void dsa_select_unit2(LAS unsigned char* lds, const bf16* __restrict__ projb  , const bf16* __restrict__ KIb, const float* __restrict__ WIb, unsigned* __restrict__ maskb, int t0) {
    int tid_o = threadIdx.x; asm volatile("" : "+v"(tid_o));
    const int tid = tid_o, lane = tid & 63, wave = __builtin_amdgcn_readfirstlane(tid >> 6), r32 = lane & 31, hi = lane >> 5;
    LAS unsigned* hist = (LAS unsigned*)(lds + L_HIST);
    LAS unsigned* maskL = (LAS unsigned*)(lds + L_MASK);
    LAS unsigned long long* mlist = (LAS unsigned long long*)(lds + L_MLIST);
    LAS unsigned* ctl = (LAS unsigned*)(lds + L_CTL);
    LAS unsigned* skeys = (LAS unsigned*)(lds + L_SKEYS);
    __syncthreads();
    { const v4u z = {0u, 0u, 0u, 0u}; *(LAS v4u*)(hist + tid * 8) = z; *(LAS v4u*)(hist + tid * 8 + 4) = z; *(LAS v2u*)(maskL + tid * 2) = (v2u){0u, 0u}; if (tid < 64) ctl[tid] = 0u; }
    bf16x8 aq[2][4];
    { const int i = r32, e = i & 3, g = (i >> 3), hh = (i >> 2) & 1; const int ql = 2 * hh + (g >> 1), head = 4 * (g & 1) + e;
#pragma unroll
      for (int rt = 0; rt < 2; ++rt)
#pragma unroll
          for (int s = 0; s < 4; ++s) aq[rt][s] = *(const bf16x8*)(projb + (size_t)(t0 + 4 * rt + ql) * NINP + PC_IQ + head * 64 + 16 * s + 8 * hi); }
    float wv[4][8];
#pragma unroll
    for (int c = 0; c < 4; ++c) { const int qg = t0 + 4 * (c >> 1) + 2 * hi + (c & 1); const f32x4 a = *(const f32x4*)(WIb + (size_t)qg * 8), bq = *(const f32x4*)(WIb + (size_t)qg * 8 + 4);
        wv[c][0] = a[0]; wv[c][1] = a[1]; wv[c][2] = a[2]; wv[c][3] = a[3]; wv[c][4] = bq[0]; wv[c][5] = bq[1]; wv[c][6] = bq[2]; wv[c][7] = bq[3]; }
    __syncthreads();
    const int ntile = (t0 + 8 + 31) >> 5;
    const int jl = wave * 32 + r32;
    const int jrel = jl - t0 - 2 * hi;
    float sc[16][4]; float mx[4] = {0.f, 0.f, 0.f, 0.f};
    bf16x8 kf[4];
    if (wave < ntile) {
#pragma unroll
        for (int s = 0; s < 4; ++s) kf[s] = *(const bf16x8*)(KIb + (size_t)jl * 64 + 16 * s + 8 * hi); }
#pragma unroll
    for (int i = 0; i < 16; ++i) {
        const int tt = wave + 8 * i;
        if (tt < ntile) {
            bf16x8 kn[4];
            { const int jn = ((tt + 8 < ntile) ? (tt + 8) : tt) * 32 + r32;
#pragma unroll
              for (int s = 0; s < 4; ++s) kn[s] = *(const bf16x8*)(KIb + (size_t)jn * 64 + 16 * s + 8 * hi); }
#pragma unroll
            for (int rt = 0; rt < 2; ++rt) {
                f32x16 acc;
#pragma unroll
                for (int r = 0; r < 16; ++r) acc[r] = 0.f;
#pragma unroll
                for (int s = 0; s < 4; ++s) acc = __builtin_amdgcn_mfma_f32_32x32x16_bf16(aq[rt][s], kf[s], acc, 0, 0, 0);
#pragma unroll
                for (int w2 = 0; w2 < 2; ++w2) { const int c = 2 * rt + w2; float s_ = 0.f;
#pragma unroll
                    for (int hd = 0; hd < 8; ++hd) s_ += fmaxf(acc[8 * w2 + hd], 0.f) * wv[c][hd];
                    s_ += 0.0f;
                    const bool v = (jrel + 256 * i) <= (4 * rt + w2);
                    sc[i][c] = s_; mx[c] = fmaxf(mx[c], v ? fabsf(s_) : 0.f); }
            }
#pragma unroll
            for (int s = 0; s < 4; ++s) kf[s] = kn[s];
        } else {
#pragma unroll
            for (int c = 0; c < 4; ++c) sc[i][c] = 0.f;
        }
    }
#pragma unroll
    for (int c = 0; c < 4; ++c) __hip_atomic_fetch_max(ctl + C_AMAX + 4 * (c >> 1) + 2 * hi + (c & 1), __float_as_uint(mx[c]), __ATOMIC_RELAXED, __HIP_MEMORY_SCOPE_WORKGROUP);
    __syncthreads();
    float inv[4];
#pragma unroll
    for (int c = 0; c < 4; ++c) { const float am = __uint_as_float(ctl[C_AMAX + 4 * (c >> 1) + 2 * hi + (c & 1)]); inv[c] = (am > 0.f && am < 3.0e38f) ? 255.95f / am : 0.f; }
#pragma unroll
    for (int i = 0; i < 16; ++i) if (wave + 8 * i < ntile) {
#pragma unroll
        for (int c = 0; c < 4; ++c) { unsigned b = (unsigned)fmaf(sc[i][c], inv[c], 255.95f); b = b > 511u ? 511u : b;
            if ((jrel + 256 * i) <= (4 * (c >> 1) + (c & 1))) __hip_atomic_fetch_add(hist + (4 * (c >> 1) + 2 * hi + (c & 1)) * 512 + b, 1u, __ATOMIC_RELAXED, __HIP_MEMORY_SCOPE_WORKGROUP); }
    }
    __syncthreads();
    {
        const int N = t0 + wave + 1;
        int bstar = -1, need16 = 0; bool slow = false;
        if (N > 256) {
            const float am = __uint_as_float(ctl[C_AMAX + wave]);
            slow = !(am > 0.f && am < 3.0e38f);
            const LAS unsigned* hq = hist + wave * 512;
            const v4u h0 = *(const LAS v4u*)(hq + 8 * lane), h1 = *(const LAS v4u*)(hq + 8 * lane + 4);
            const unsigned own = (h0.x + h0.y) + (h0.z + h0.w) + (h1.x + h1.y) + (h1.z + h1.w);
            unsigned suf = own;
#pragma unroll
            for (int off = 1; off < 64; off <<= 1) { const unsigned o = __shfl_down(suf, off); suf += (lane + off < 64) ? o : 0u; }
            const int L = (int)__popcll(__ballot(suf >= 256u)) - 1;
            if (L < 0) slow = true;
            const int Lc = L < 0 ? 0 : L;
            int c = (int)__shfl(suf - own, Lc);
            const unsigned g0 = __shfl(h0.x, Lc), g1 = __shfl(h0.y, Lc), g2 = __shfl(h0.z, Lc), g3 = __shfl(h0.w, Lc), g4 = __shfl(h1.x, Lc), g5 = __shfl(h1.y, Lc), g6 = __shfl(h1.z, Lc), g7 = __shfl(h1.w, Lc);
            int bsel = 0, cab = c; bool found = false;
#define STEP_BIN(gv, idx) if (!found) { if (c + (int)(gv) >= 256) { found = true; bsel = (idx); cab = c; } else c += (int)(gv); }
            STEP_BIN(g7, 7) STEP_BIN(g6, 6) STEP_BIN(g5, 5) STEP_BIN(g4, 4) STEP_BIN(g3, 3) STEP_BIN(g2, 2) STEP_BIN(g1, 1) STEP_BIN(g0, 0)
#undef STEP_BIN
            if (!found) slow = true;
            bstar = 8 * Lc + bsel; need16 = 256 - cab;
        }
        if (lane == 0) { ctl[C_BSTAR + wave] = (unsigned)bstar; ctl[C_NEED + wave] = (unsigned)need16; if (slow) __hip_atomic_fetch_or(ctl + C_SLOW, 1u << wave, __ATOMIC_RELAXED, __HIP_MEMORY_SCOPE_WORKGROUP); }
    }
    __syncthreads();
    {
        int bs[4];
#pragma unroll
        for (int c = 0; c < 4; ++c) bs[c] = (int)ctl[C_BSTAR + 4 * (c >> 1) + 2 * hi + (c & 1)];
#pragma unroll
        for (int i = 0; i < 16; ++i) if (wave + 8 * i < ntile) {
            const int tt = wave + 8 * i;
#pragma unroll
            for (int c = 0; c < 4; ++c) { const int ql = 4 * (c >> 1) + 2 * hi + (c & 1);
                unsigned b = (unsigned)fmaf(sc[i][c], inv[c], 255.95f); b = b > 511u ? 511u : b;
                const bool v = (jrel + 256 * i) <= (4 * (c >> 1) + (c & 1));
                const unsigned long long bm = __ballot(v && (int)b > bs[c]);
                if (r32 == 0) maskL[ql * 128 + tt] = hi ? (unsigned)(bm >> 32) : (unsigned)bm;
                if (v && (int)b == bs[c]) { const unsigned pos = __hip_atomic_fetch_add(ctl + C_MCNT + ql, 1u, __ATOMIC_RELAXED, __HIP_MEMORY_SCOPE_WORKGROUP);
                    if (pos < 64u) mlist[ql * 64 + pos] = ((unsigned long long)mono(sc[i][c]) << 32) | (unsigned)(tt * 32 + r32); }
            }
        }
    }
    __syncthreads();
    {
        const int N = t0 + wave + 1;
        const bool slowq = (ctl[C_SLOW] >> wave) & 1u;
        if (N > 256 && !slowq) {
            const int cnt = (int)ctl[C_MCNT + wave];
            if (cnt > 64) { if (lane == 0) __hip_atomic_fetch_or(ctl + C_SLOW, 1u << wave, __ATOMIC_RELAXED, __HIP_MEMORY_SCOPE_WORKGROUP); }
            else {
                const unsigned long long e = lane < cnt ? mlist[wave * 64 + lane] : 0ull;
                const unsigned key = (unsigned)(e >> 32), idx = (unsigned)e; const bool have = lane < cnt;
                const int need16 = (int)ctl[C_NEED + wave];
                unsigned T = 0u;
#pragma unroll 1
                for (int bit = 31; bit >= 0; --bit) { const unsigned cand = T | (1u << bit); if ((int)__popcll(__ballot(have && key >= cand)) >= need16) T = cand; }
                const unsigned long long gtm = __ballot(have && key > T), eqm = __ballot(have && key == T);
                const int need_eq = need16 - (int)__popcll(gtm);
                bool sel = have && key > T;
                if ((int)__popcll(eqm) <= need_eq) sel = sel || (have && key == T);
                else {
                    int rank = 0; unsigned long long m = eqm;
                    while (m) { const int src = (int)__builtin_ctzll(m); m &= m - 1ull; const unsigned io = (unsigned)__shfl((int)idx, src); rank += (io < idx) ? 1 : 0; }
                    sel = sel || (have && key == T && rank < need_eq);
                }
                if (sel) __hip_atomic_fetch_or(maskL + wave * 128 + (idx >> 5), 1u << (idx & 31u), __ATOMIC_RELAXED, __HIP_MEMORY_SCOPE_WORKGROUP);
            }
        }
    }
    __syncthreads();
    {
        unsigned sm = (unsigned)__builtin_amdgcn_readfirstlane((int)ctl[C_SLOW]);
        while (sm) {
            const int q = (int)__builtin_ctz(sm); sm &= sm - 1u;
#pragma unroll
            for (int i = 0; i < 16; ++i) if (wave + 8 * i < ntile) {
#pragma unroll
                for (int c = 0; c < 4; ++c) if ((4 * (c >> 1) + 2 * hi + (c & 1)) == q && (jrel + 256 * i) <= (4 * (c >> 1) + (c & 1))) skeys[(wave + 8 * i) * 32 + r32] = mono(sc[i][c]);
            }
            __syncthreads();
            if (wave == 0) slow_query(skeys, maskL + q * 128, t0 + q + 1, lane);
            __syncthreads();
        }
    }
    { const int q = tid >> 6, w = 2 * (tid & 63); const v2u mw = *(const LAS v2u*)(maskL + q * 128 + w); *(v2u*)(maskb + (size_t)(t0 + q) * 128 + w) = mw; }
}
}
#ifndef SEL3_SLOWCNT
#define SEL3_SLOWCNT 64
#endif
namespace sel3 {
typedef float f32x16 __attribute__((ext_vector_type(16)));
typedef unsigned v2u __attribute__((ext_vector_type(2)));
constexpr int L_HIST = 0, L_MASK = 16384  , L_MLIST = 24576, L_CTL = 28672  , L_SKEYS = 0  , L_RING = 32768  , L_IQ = 131072  , L_END = 149504;
constexpr int C_AMAX = 0, C_MCNT = 8, C_BSTAR = 16, C_NEED = 24, C_SLOW = 32;
__device__ __forceinline__ unsigned mono(float s) { const unsigned u = __float_as_uint(s + 0.0f); return (u & 0x80000000u) ? ~u : (u | 0x80000000u); }

__device__ __forceinline__ void slow_query(const LAS unsigned* skeys, LAS unsigned* maskrow, int N, int lane) {
    const int R = (N + 63) >> 6;
    unsigned kr[64];
#pragma unroll
    for (int r = 0; r < 64; ++r) { const int j = 64 * r + lane; kr[r] = (r < R && j < N) ? skeys[j] : 0u; }
    unsigned T = 0u;
#define CNT_GE(cand, out) do { int c_ = 0; _Pragma("unroll") for (int g8 = 0; g8 < 8; ++g8) if (g8 * 8 < R) { _Pragma("unroll") for (int q = 0; q < 8; ++q) c_ += (int)__popcll(__builtin_amdgcn_ballot_w64(kr[g8 * 8 + q] >= (cand))); } (out) = c_; } while (0)
#pragma unroll 1
    for (int bit = 31; bit >= 0; --bit) { const unsigned cand = T | (1u << bit); int cnt; CNT_GE(cand, cnt); if (cnt >= 256) T = cand; }
    int gt; { const unsigned c4 = T + 1u; CNT_GE(c4, gt); }
#undef CNT_GE
    const int need = 256 - gt;
    int base = 0;
#pragma unroll
    for (int r = 0; r < 64; ++r) {
        const unsigned long long gtm = __builtin_amdgcn_ballot_w64(kr[r] > T); unsigned long long eqm = __builtin_amdgcn_ballot_w64(kr[r] == T && (64 * r + lane) < N);
        int c = (int)__popcll(eqm);
        if (base + c > need) { int keep = need - base; keep = keep < 0 ? 0 : keep; while (c > keep) { eqm &= ~(1ull << (63 - __clzll((long long)eqm))); --c; } }
        base += c; const unsigned long long sel = gtm | eqm;
        if (lane == 0) { maskrow[2 * r] = (unsigned)sel; maskrow[2 * r + 1] = (unsigned)(sel >> 32); }
    }
}

__device__ __forceinline__ void glds16_asm(const void* g, unsigned lds_base) {
    unsigned sv; asm volatile("s_mov_b32 %0, m0\n\ts_mov_b32 m0, %2\n\ts_nop 0\n\tglobal_load_lds_dwordx4 %1, off\n\ts_mov_b32 m0, %0" : "=&s"(sv) : "v"(g), "s"(lds_base) : "memory"); }
constexpr int KSEL0 = 64, KEND = 64 + 512;
__device__ __forceinline__ void dsa_select_stream(LAS unsigned char* lds, volatile LAS unsigned* MISC, gu32* qcnt, const bf16* __restrict__ proj, const bf16* __restrict__ KI, const float* __restrict__ WI, unsigned* __restrict__ maskp, int kfirst, int bb) {
    int tid_o = threadIdx.x; asm volatile("" : "+v"(tid_o));
    const int tid0 = tid_o;
    LAS unsigned* hist = (LAS unsigned*)(lds + L_HIST);
    LAS unsigned long long* mlist = (LAS unsigned long long*)(lds + L_MLIST);
    LAS unsigned* skeys = (LAS unsigned*)(lds + L_SKEYS);
    __syncthreads();
    { unsigned z0_ = 0u; asm volatile("" : "+v"(z0_)); const v4u z = {z0_, z0_, z0_, z0_};     *(LAS v4u*)(hist + tid0 * 8) = z; *(LAS v4u*)(hist + tid0 * 8 + 4) = z; *(LAS v4u*)((LAS unsigned*)(lds + L_MASK) + tid0 * 4) = z; if (tid0 < 128) ((LAS unsigned*)(lds + L_CTL))[tid0] = 0u; }
    unsigned pend = 0u;
    if (tid0 == 0) pend = __hip_atomic_fetch_add(qcnt, 1u, __ATOMIC_RELAXED, __HIP_MEMORY_SCOPE_AGENT);
    bf16x8 aq[2][4];
    LAS float* wvL = (LAS float*)(lds + L_CTL + 512);
#define STAGE_OPERANDS(parity, kk) do { const int k2_ = (kk) - KSEL0, b_ = bb, t0_ = 8 * (511 - k2_); const int q_ = tid >> 6, pc_ = tid & 63; \
        const v4u v_ = *(const v4u*)(proj + ((size_t)b_ * SEQ + t0_ + q_) * NINP + PC_IQ + pc_ * 8); \
        *(LAS v4u*)(lds + L_IQ + (parity) * 9216 + (q_ * 8 + (pc_ >> 3)) * 144 + (pc_ & 7) * 16) = v_; \
        if (tid < 64) wvL[(parity) * 64 + tid] = WI[((size_t)b_ * SEQ + t0_) * 8 + tid]; } while (0)
    { const int tid = tid0; STAGE_OPERANDS(0, kfirst); }
    __syncthreads();
    int kcur = kfirst;
    bool pre = false;
#pragma unroll 1
    for (int par = 0; ; par ^= 1) {
    if (tid0 == 0) MISC[17] = pend;
    int tid_i = tid0; asm volatile("" : "+v"(tid_i)); const int tid = tid_i;
    const int lane = tid_i & 63, wave = __builtin_amdgcn_readfirstlane(tid_i >> 6), r32 = lane & 31, hi = lane >> 5;
    const int a_ql = 2 * ((r32 >> 2) & 1) + (r32 >> 4), a_head = 4 * ((r32 >> 3) & 1) + (r32 & 3);
    const int k2 = kcur - KSEL0, t0 = 8 * (511 - k2);
    const bf16* KIb = KI + (size_t)bb * SEQ * 64; unsigned* maskb = maskp + (size_t)bb * SEQ * 128;
    LAS unsigned* maskL = (LAS unsigned*)(lds + L_MASK) + par * 1024;
    LAS unsigned* ctl = (LAS unsigned*)(lds + L_CTL) + par * 64;
    { unsigned z0_ = 0u; asm volatile("" : "+v"(z0_)); const v4u z = {z0_, z0_, z0_, z0_};     *(LAS v4u*)(hist + tid * 8) = z; *(LAS v4u*)(hist + tid * 8 + 4) = z; *(LAS v2u*)(maskL + tid * 2) = (v2u){z0_, z0_}; }
    const int ntile = (t0 + 8 + 31) >> 5;
    const int jl = wave * 32 + r32;
    const int jrel = jl - t0 - 2 * hi;
#pragma unroll
    for (int rt = 0; rt < 2; ++rt)
#pragma unroll
        for (int s = 0; s < 4; ++s) aq[rt][s] = *(const LAS bf16x8*)(lds + L_IQ + par * 9216 + ((4 * rt + a_ql) * 8 + a_head) * 144 + (16 * s + 8 * hi) * 2);
    f32x4 wvr[4][2];
#pragma unroll
    for (int c = 0; c < 4; ++c) { wvr[c][0] = *(const LAS f32x4*)(wvL + par * 64 + (4 * (c >> 1) + 2 * hi + (c & 1)) * 8); wvr[c][1] = *(const LAS f32x4*)(wvL + par * 64 + (4 * (c >> 1) + 2 * hi + (c & 1)) * 8 + 4); }
    float sc[16][4]; float mx[4] = {0.f, 0.f, 0.f, 0.f};
    {
    const GAS bf16* kbase = (const GAS bf16*)KIb + (size_t)wave * 2048 + lane * 8;
    const GAS bf16* kptr = kbase;
    bf16x8 kq[2][4];
#define KLOAD(set, on) do { const GAS bf16* kp_ = (on) ? kptr : kbase; \
        asm volatile("global_load_dwordx4 %0, %4, off\n\tglobal_load_dwordx4 %1, %4, off offset:1024\n\tglobal_load_dwordx4 %2, %4, off offset:2048\n\tglobal_load_dwordx4 %3, %4, off offset:3072" \
                     : "=&v"(kq[set][0]), "=&v"(kq[set][1]), "=&v"(kq[set][2]), "=&v"(kq[set][3]) : "v"(kp_) : "memory"); } while (0)
#define KWAIT(set, n) asm volatile("s_waitcnt vmcnt(" #n ")" : "+v"(kq[set][0]), "+v"(kq[set][1]), "+v"(kq[set][2]), "+v"(kq[set][3]) :: "memory")
    if (wave < ntile) { KLOAD(0, true); kptr += 8 * 2048; asm volatile("" : "+v"(kptr)); KLOAD(1, wave + 8 < ntile); kptr += 8 * 2048; asm volatile("" : "+v"(kptr)); }
#pragma unroll
    for (int i = 0; i < 16; ++i) {
        const int tt = wave + 8 * i;
        if (tt < ntile) {
            const bool a2 = (i + 2 < 16) && (tt + 16 < ntile);
            const bool allv = (tt * 32 + 31) <= t0;
            f32x16 acc0, acc1;
#pragma unroll
            for (int r = 0; r < 16; ++r) { acc0[r] = 0.f; acc1[r] = 0.f; }
            if (i & 1) KWAIT(1, 4); else KWAIT(0, 4);
#pragma unroll
            for (int s = 0; s < 4; ++s) { acc0 = __builtin_amdgcn_mfma_f32_32x32x16_bf16(aq[0][s], kq[i & 1][s], acc0, 0, 0, 0); acc1 = __builtin_amdgcn_mfma_f32_32x32x16_bf16(aq[1][s], kq[i & 1][s], acc1, 0, 0, 0); }
            if (i & 1) KLOAD(1, a2); else KLOAD(0, a2);
            kptr += 8 * 2048; asm volatile("" : "+v"(kptr));
#pragma unroll
            for (int rt = 0; rt < 2; ++rt) {
                const f32x16& acc = rt ? acc1 : acc0;
#pragma unroll
                for (int w2 = 0; w2 < 2; ++w2) { const int c = 2 * rt + w2;
                    const f32x4 wa = wvr[c][0], wb = wvr[c][1];
#define RELU1(a_) __int_as_float(max(__float_as_int(a_), 0))
#define FMAC(acc_, a_, b_) asm("v_fmac_f32 %0, %1, %2" : "+v"(acc_) : "v"(a_), "v"(b_))
                    float e0 = RELU1(acc[8 * w2 + 0]) * wa[0], e1 = RELU1(acc[8 * w2 + 1]) * wa[1];
                    asm volatile("" : "+v"(e0), "+v"(e1));
                    { float r2 = RELU1(acc[8 * w2 + 2]), r3 = RELU1(acc[8 * w2 + 3]), r4 = RELU1(acc[8 * w2 + 4]), r5 = RELU1(acc[8 * w2 + 5]), r6 = RELU1(acc[8 * w2 + 6]), r7 = RELU1(acc[8 * w2 + 7]);
                      FMAC(e0, r2, wa[2]); FMAC(e1, r3, wa[3]); FMAC(e0, r4, wb[0]); FMAC(e1, r5, wb[1]); FMAC(e0, r6, wb[2]); FMAC(e1, r7, wb[3]); }
#undef RELU1
#undef FMAC
                    sc[i][c] = e0 + e1;
                }
            }
            if (allv) {
#pragma unroll
                for (int c = 0; c < 4; ++c) mx[c] = __builtin_elementwise_maximum(mx[c], fabsf(sc[i][c]));
            } else { asm volatile("" ::: "memory");
#pragma unroll
                for (int c = 0; c < 4; ++c) { const bool v = (jrel + 256 * i) <= (4 * (c >> 1) + (c & 1)); const float s_ = sc[i][c]; sc[i][c] = v ? s_ : -3.0e38f; mx[c] = __builtin_elementwise_maximum(mx[c], v ? fabsf(s_) : 0.f); }
            }
        } else {
#pragma unroll
            for (int c = 0; c < 4; ++c) sc[i][c] = 0.f;
        }
    }
    asm volatile("s_waitcnt vmcnt(0)" : "+v"(kq[0][0]), "+v"(kq[0][1]), "+v"(kq[0][2]), "+v"(kq[0][3]), "+v"(kq[1][0]), "+v"(kq[1][1]), "+v"(kq[1][2]), "+v"(kq[1][3]) :: "memory");
#undef KLOAD
#undef KWAIT
    }
#pragma unroll
    for (int c = 0; c < 4; ++c) __hip_atomic_fetch_max(ctl + C_AMAX + 4 * (c >> 1) + 2 * hi + (c & 1), __float_as_uint(mx[c]), __ATOMIC_RELAXED, __HIP_MEMORY_SCOPE_WORKGROUP);
    __syncthreads();
    const int knext = (int)MISC[17];
    if (tid0 == 0) pend = __hip_atomic_fetch_add(qcnt, 1u, __ATOMIC_RELAXED, __HIP_MEMORY_SCOPE_AGENT);
    v4u st_iq = {0u, 0u, 0u, 0u}; float st_w = 0.f;
    if (knext < KEND) { const int t0n_ = 8 * (511 - (knext - KSEL0)); const int q_ = tid >> 6, pc_ = tid & 63;
        st_iq = *(const v4u*)(proj + ((size_t)bb * SEQ + t0n_ + q_) * NINP + PC_IQ + pc_ * 8);
        if (tid < 64) st_w = WI[((size_t)bb * SEQ + t0n_) * 8 + tid]; }
    bool pre_n = false;
    if (false) {
        const int ntn = (8 * (511 - (knext - KSEL0)) + 8 + 31) >> 5;
        LAS unsigned char* ring = lds + L_RING + wave * 12288; const bf16* kptr = KIb + (size_t)wave * 2048 + lane * 8;
        const unsigned rbase = (unsigned)__builtin_amdgcn_readfirstlane((int)(unsigned)(unsigned long long)(LAS unsigned char*)ring);
#define DMA_TILE_N(slot, off) do { _Pragma("unroll") for (int s = 0; s < 4; ++s) glds16_asm(kptr + (off) + 512 * s, rbase + (slot) * 4096 + s * 1024); } while (0)
        if (wave < ntn) DMA_TILE_N(0, 0);
        if (wave + 8 < ntn) DMA_TILE_N(1, 16384);
        if (wave + 16 < ntn) DMA_TILE_N(2, 32768);
#undef DMA_TILE_N
        pre_n = true;
    }
    if (tid < 64) ((LAS unsigned*)(lds + L_CTL) + (par ^ 1) * 64)[tid] = 0u;
    float inv[4];
#pragma unroll
    for (int c = 0; c < 4; ++c) { const float am = __uint_as_float(ctl[C_AMAX + 4 * (c >> 1) + 2 * hi + (c & 1)]); inv[c] = (am > 0.f && am < 3.0e38f) ? 255.95f * __builtin_amdgcn_rcpf(am) : 0.f; }
    LAS unsigned* hrow[4];
#pragma unroll
    for (int c = 0; c < 4; ++c) { hrow[c] = hist + (4 * (c >> 1) + 2 * hi + (c & 1)) * 512; asm volatile("" : "+v"(hrow[c])); }
#pragma unroll
    for (int i = 0; i < 16; ++i) if (wave + 8 * i < ntile) {
#pragma unroll
        for (int c = 0; c < 4; ++c) { unsigned b = (unsigned)fmaf(sc[i][c], inv[c], 255.95f); b = b > 511u ? 511u : b;
            __hip_atomic_fetch_add(hrow[c] + b, 1u, __ATOMIC_RELAXED, __HIP_MEMORY_SCOPE_WORKGROUP); }
    }
#ifndef SEL3_REP_B
#define SEL3_REP_B 0
#endif
    for (int rb_ = 0; rb_ < SEL3_REP_B; ++rb_) {
#pragma unroll
        for (int i = 0; i < 16; ++i) if (wave + 8 * i < ntile) {
#pragma unroll
            for (int c = 0; c < 4; ++c) { unsigned b = (unsigned)fmaf(sc[i][c], inv[c], 255.95f); b = b > 511u ? 511u : b;
                __hip_atomic_fetch_add(hrow[c] + 8192 + b, 1u, __ATOMIC_RELAXED, __HIP_MEMORY_SCOPE_WORKGROUP); }
        }
    }
    if (knext < KEND) { const int q_ = tid >> 6, pc_ = tid & 63;
        *(LAS v4u*)(lds + L_IQ + (par ^ 1) * 9216 + (q_ * 8 + (pc_ >> 3)) * 144 + (pc_ & 7) * 16) = st_iq;
        if (tid < 64) wvL[(par ^ 1) * 64 + tid] = st_w; }
    __syncthreads();
    {
        const int N = t0 + wave + 1;
        int bstar = -1, need16 = 0; bool slow = false;
        if (N > 256) {
            const float am = __uint_as_float(ctl[C_AMAX + wave]);
            slow = !(am > 0.f && am < 3.0e38f);
            const LAS unsigned* hq = hist + wave * 512;
            const v4u h0 = *(const LAS v4u*)(hq + 8 * lane), h1 = *(const LAS v4u*)(hq + 8 * lane + 4);
            const unsigned own = (h0.x + h0.y) + (h0.z + h0.w) + (h1.x + h1.y) + (h1.z + h1.w);
            unsigned suf = own;
#define SUF_STEP(ctrl) suf += (unsigned)__builtin_amdgcn_update_dpp(0, (int)suf, ctrl, 0xf, 0xf, false)
            SUF_STEP(0x101); SUF_STEP(0x102); SUF_STEP(0x104); SUF_STEP(0x108);
#undef SUF_STEP
            { const unsigned t1 = (unsigned)__builtin_amdgcn_readlane((int)suf, 16), t2 = (unsigned)__builtin_amdgcn_readlane((int)suf, 32), t3 = (unsigned)__builtin_amdgcn_readlane((int)suf, 48);
              suf += lane < 16 ? t1 + t2 + t3 : lane < 32 ? t2 + t3 : lane < 48 ? t3 : 0u; }
            const int L = (int)__popcll(__builtin_amdgcn_ballot_w64(suf >= 256u)) - 1;
            if (L < 0) slow = true;
            const int Lc = L < 0 ? 0 : L;
            int c = __builtin_amdgcn_readlane((int)(suf - own), Lc);
            const unsigned g0 = (unsigned)__builtin_amdgcn_readlane((int)h0.x, Lc), g1 = (unsigned)__builtin_amdgcn_readlane((int)h0.y, Lc), g2 = (unsigned)__builtin_amdgcn_readlane((int)h0.z, Lc), g3 = (unsigned)__builtin_amdgcn_readlane((int)h0.w, Lc),
                           g4 = (unsigned)__builtin_amdgcn_readlane((int)h1.x, Lc), g5 = (unsigned)__builtin_amdgcn_readlane((int)h1.y, Lc), g6 = (unsigned)__builtin_amdgcn_readlane((int)h1.z, Lc), g7 = (unsigned)__builtin_amdgcn_readlane((int)h1.w, Lc);
            int bsel = 0, cab = c; bool found = false;
#define STEP_BIN(gv, idx) if (!found) { if (c + (int)(gv) >= 256) { found = true; bsel = (idx); cab = c; } else c += (int)(gv); }
            STEP_BIN(g7, 7) STEP_BIN(g6, 6) STEP_BIN(g5, 5) STEP_BIN(g4, 4) STEP_BIN(g3, 3) STEP_BIN(g2, 2) STEP_BIN(g1, 1) STEP_BIN(g0, 0)
#undef STEP_BIN
            if (!found) slow = true;
            bstar = 8 * Lc + bsel; need16 = 256 - cab;
        }
        if (lane == 0) { ctl[C_BSTAR + wave] = (unsigned)bstar; ctl[C_NEED + wave] = (unsigned)need16; if (slow) __hip_atomic_fetch_or(ctl + C_SLOW, 1u << wave, __ATOMIC_RELAXED, __HIP_MEMORY_SCOPE_WORKGROUP); }
    }
    __syncthreads();
    {
        int bs[4];
        LAS unsigned* mrow[4];
#pragma unroll
        for (int c = 0; c < 4; ++c) { mrow[c] = maskL + (4 * (c >> 1) + 2 * hi + (c & 1)) * 128; asm volatile("" : "+v"(mrow[c])); }
#pragma unroll
        for (int c = 0; c < 4; ++c) bs[c] = (int)ctl[C_BSTAR + 4 * (c >> 1) + 2 * hi + (c & 1)];
#pragma unroll
        for (int i = 0; i < 16; ++i) if (wave + 8 * i < ntile) {
            const int tt = wave + 8 * i;
            const bool allv = (tt * 32 + 31) <= t0;
            unsigned b4[4]; unsigned long long bm4[4];
#pragma unroll
            for (int c = 0; c < 4; ++c) { unsigned b = (unsigned)fmaf(sc[i][c], inv[c], 255.95f); b4[c] = b > 511u ? 511u : b;
                bm4[c] = __builtin_amdgcn_ballot_w64((int)b4[c] > bs[c]); }
            bool mem4[4];
#pragma unroll
            for (int c = 0; c < 4; ++c) mem4[c] = ((int)b4[c] == bs[c]);
            if (!allv) { asm volatile("" ::: "memory");
#pragma unroll
                for (int c = 0; c < 4; ++c) { const bool v = (jrel + 256 * i) <= (4 * (c >> 1) + (c & 1));
                    bm4[c] &= __builtin_amdgcn_ballot_w64(v);
                    mem4[c] = mem4[c] && v; }
            }
#pragma unroll
            for (int c = 0; c < 4; ++c) mrow[c][tt] = hi ? (unsigned)(bm4[c] >> 32) : (unsigned)bm4[c];
            if (__builtin_amdgcn_ballot_w64(mem4[0] || mem4[1] || mem4[2] || mem4[3]) != 0ull) {
                unsigned pos4[4];
#pragma unroll
                for (int c = 0; c < 4; ++c) { pos4[c] = 64u; if (mem4[c]) pos4[c] = __hip_atomic_fetch_add(ctl + C_MCNT + 4 * (c >> 1) + 2 * hi + (c & 1), 1u, __ATOMIC_RELAXED, __HIP_MEMORY_SCOPE_WORKGROUP); }
#pragma unroll
                for (int c = 0; c < 4; ++c) if (mem4[c] && pos4[c] < 64u) mlist[(4 * (c >> 1) + 2 * hi + (c & 1)) * 64 + pos4[c]] = ((unsigned long long)mono(sc[i][c]) << 32) | (unsigned)(tt * 32 + r32);
            }
        }
    }
    __syncthreads();
    {
        const int N = t0 + wave + 1;
        const bool slowq = (ctl[C_SLOW] >> wave) & 1u;
        if (N > 256 && !slowq) {
            const int cnt = (int)ctl[C_MCNT + wave];
            if (cnt > SEL3_SLOWCNT) { if (lane == 0) __hip_atomic_fetch_or(ctl + C_SLOW, 1u << wave, __ATOMIC_RELAXED, __HIP_MEMORY_SCOPE_WORKGROUP); }
            else {
                const unsigned long long e = lane < cnt ? mlist[wave * 64 + lane] : 0ull;
                const unsigned key = (unsigned)(e >> 32), idx = (unsigned)e; const bool have = lane < cnt;
                const int need16 = (int)ctl[C_NEED + wave];
                unsigned T = 0u;
#pragma unroll 1
                for (int bit = 31; bit >= 0; --bit) { const unsigned cand = T | (1u << bit); if ((int)__popcll(__builtin_amdgcn_ballot_w64(have && key >= cand)) >= need16) T = cand; }
                const unsigned long long gtm = __builtin_amdgcn_ballot_w64(have && key > T), eqm = __builtin_amdgcn_ballot_w64(have && key == T);
                const int need_eq = need16 - (int)__popcll(gtm);
                bool sel = have && key > T;
                if ((int)__popcll(eqm) <= need_eq) sel = sel || (have && key == T);
                else {
                    int rank = 0; unsigned long long m = eqm;
                    while (m) { const int src = (int)__builtin_ctzll(m); m &= m - 1ull; const unsigned io = (unsigned)__shfl((int)idx, src); rank += (io < idx) ? 1 : 0; }
                    sel = sel || (have && key == T && rank < need_eq);
                }
                if (sel) __hip_atomic_fetch_or(maskL + wave * 128 + (idx >> 5), 1u << (idx & 31u), __ATOMIC_RELAXED, __HIP_MEMORY_SCOPE_WORKGROUP);
            }
        }
    }
    __syncthreads();
    {
        unsigned sm = (unsigned)__builtin_amdgcn_readfirstlane((int)ctl[C_SLOW]);
        while (sm) {
            const int q = (int)__builtin_ctz(sm); sm &= sm - 1u;
            int jrel_o = jrel; asm volatile("" : "+v"(jrel_o));
#pragma unroll
            for (int i = 0; i < 16; ++i) if (wave + 8 * i < ntile) {
#pragma unroll
                for (int c = 0; c < 4; ++c) if ((4 * (c >> 1) + 2 * hi + (c & 1)) == q && (jrel_o + 256 * i) <= (4 * (c >> 1) + (c & 1))) { float sv_ = sc[i][c]; asm volatile("" : "+v"(sv_)); skeys[(wave + 8 * i) * 32 + r32] = mono(sv_); }
            }
            __syncthreads();
            if (wave == 0) slow_query(skeys, maskL + q * 128, t0 + q + 1, lane);
            __syncthreads();
        }
    }
    { const int q = tid & 7, w = tid >> 3; maskb[(size_t)w * SEQ + t0 + q] = maskL[q * 128 + w]; maskb[(size_t)(w + 64) * SEQ + t0 + q] = maskL[q * 128 + w + 64]; }
    if (knext >= KEND) break;
    kcur = knext; pre = pre_n;
    }
#undef STAGE_OPERANDS
    __syncthreads();
}
}
namespace hgrn {
typedef float f32x16 __attribute__((ext_vector_type(16)));
typedef unsigned v2u __attribute__((ext_vector_type(2)));
typedef short s16x4 __attribute__((ext_vector_type(4)));
__device__ __forceinline__ int crow(int r, int hi) { return (r & 3) + 8 * (r >> 2) + 4 * hi; }
constexpr int PPITCH = 264;
constexpr int PREP_LDS_PER_WAVE = 2 * 32 * PPITCH;

__device__ __forceinline__ bf16x8 ld_frag2(const bf16* p0, const bf16* p1) {
    const s16x4 a = *(const s16x4*)p0, b = *(const s16x4*)p1; return (bf16x8){a[0], a[1], a[2], a[3], b[0], b[1], b[2], b[3]};
}
__device__ __forceinline__ bf16x8 ld_frag2_lds(const LAS unsigned char* p0, const LAS unsigned char* p1) {
    const s16x4 a = *(const LAS s16x4*)p0, b = *(const LAS s16x4*)p1; return (bf16x8){a[0], a[1], a[2], a[3], b[0], b[1], b[2], b[3]};
}

template <bool DRY = false> __device__ __forceinline__ void prep_unit(LAS unsigned char* scr  , bf16* __restrict__ proj, const float* __restrict__ lbt  ,
                                          bf16* __restrict__ KSTT, float* __restrict__ DECAY, bf16* __restrict__ AT, int u, int lane) {
    const int hh = u & 3, cn = u >> 2;
    const size_t m0 = (size_t)cn * 32;
    const int k0 = 2 * lane, c0 = hh * 128 + k0;
    const float lb0 = lbt[c0], lb1 = lbt[c0 + 1];
    bf16* rowq = proj + m0 * NINP + PC_HQ + c0; bf16* rowf = proj + m0 * NINP + PC_HF + c0; bf16* rowi = proj + m0 * NINP + PC_HI + c0;
    LAS unsigned char* sq = scr; LAS unsigned char* sk = scr + 32 * PPITCH;
    float g0 = 0.f, g1 = 0.f;
    unsigned kiv[32];
    unsigned vtk[16];
    const float ol0 = 1.0f - lb0, ol1 = 1.0f - lb1;
    unsigned wfa[2][16], wqa[2][16], wia[2][16];
#pragma unroll
    for (int hf = 0; hf < 2; ++hf)
#pragma unroll
        for (int t = 0; t < 16; ++t) { const size_t ro = (size_t)(16 * hf + t) * NINP; wfa[hf][t] = *(const unsigned*)(rowf + ro); wqa[hf][t] = *(const unsigned*)(rowq + ro); wia[hf][t] = *(const unsigned*)(rowi + ro); }
#pragma unroll
    for (int hf = 0; hf < 2; ++hf) {
        unsigned (&wf)[16] = wfa[hf]; unsigned (&wq)[16] = wqa[hf]; unsigned (&wi)[16] = wia[hf];
        unsigned vt0[8], vt1[8];
#pragma unroll
        for (int t = 0; t < 16; ++t) {
            const float f0 = __uint_as_float(wf[t] << 16), f1 = __uint_as_float(wf[t] & 0xffff0000u), q0 = __uint_as_float(wq[t] << 16) * 0.08838834764831845f, q1 = __uint_as_float(wq[t] & 0xffff0000u) * 0.08838834764831845f;
            const float s0 = __builtin_amdgcn_rcpf(1.0f + __expf(-f0)), s1 = __builtin_amdgcn_rcpf(1.0f + __expf(-f1));
            const float kk0 = ol0 * (1.0f - s0), kk1 = ol1 * (1.0f - s1);
            g0 += __logf(lb0 + ol0 * s0); g1 += __logf(lb1 + ol1 * s1);
            const float e0 = __expf(g0), e1 = __expf(g1);
            const unsigned qd = att::cvtpk(q0 * e0, q1 * e1), ki = att::cvtpk(kk0 * __builtin_amdgcn_rcpf(e0), kk1 * __builtin_amdgcn_rcpf(e1));
            wq[t] = qd; kiv[16 * hf + t] = ki;
            *(LAS unsigned*)(sq + (16 * hf + t) * PPITCH + 4 * lane) = qd; *(LAS unsigned*)(sk + (16 * hf + t) * PPITCH + 4 * lane) = ki;
            if (t & 1) { vt0[t >> 1] = (wi[t - 1] & 0xffffu) | (wi[t] << 16); vt1[t >> 1] = (wi[t - 1] >> 16) | (wi[t] & 0xffff0000u); }
        }
#pragma unroll
        for (int t = 0; t < 16; ++t) if (!DRY) *(unsigned*)(rowq + (size_t)(16 * hf + t) * NINP) = wq[t];
        if (hf == 0) { vtk[0] = vt0[0]; vtk[1] = vt0[1]; vtk[2] = vt0[2]; vtk[3] = vt0[3]; vtk[4] = vt0[4]; vtk[5] = vt0[5]; vtk[6] = vt0[6]; vtk[7] = vt0[7];
                       vtk[8] = vt1[0]; vtk[9] = vt1[1]; vtk[10] = vt1[2]; vtk[11] = vt1[3]; vtk[12] = vt1[4]; vtk[13] = vt1[5]; vtk[14] = vt1[6]; vtk[15] = vt1[7]; }
        else if (!DRY) {
            v4u* d0 = (v4u*)(proj + (m0 + (k0 >> 2)) * NINP + PC_HI + hh * 128 + (k0 & 3) * 32); v4u* d1 = d0 + 4;
            d0[0] = (v4u){vtk[0], vtk[1], vtk[2], vtk[3]}; d0[1] = (v4u){vtk[4], vtk[5], vtk[6], vtk[7]}; d0[2] = (v4u){vt0[0], vt0[1], vt0[2], vt0[3]}; d0[3] = (v4u){vt0[4], vt0[5], vt0[6], vt0[7]};
            d1[0] = (v4u){vtk[8], vtk[9], vtk[10], vtk[11]}; d1[1] = (v4u){vtk[12], vtk[13], vtk[14], vtk[15]}; d1[2] = (v4u){vt1[0], vt1[1], vt1[2], vt1[3]}; d1[3] = (v4u){vt1[4], vt1[5], vt1[6], vt1[7]};
        }
    }
    {
        const float dc0 = __expf(g0), dc1 = __expf(g1);
        *(v2u*)(DECAY + (size_t)u * 128 + k0) = (v2u){__float_as_uint(dc0), __float_as_uint(dc1)};
        unsigned ks0[16], ks1[16];
#pragma unroll
        for (int tp = 0; tp < 16; ++tp) { const unsigned a = kiv[2 * tp], bq = kiv[2 * tp + 1];
            ks0[tp] = att::cvtpk(__uint_as_float(a << 16) * dc0, __uint_as_float(bq << 16) * dc0);
            ks1[tp] = att::cvtpk(__uint_as_float(a & 0xffff0000u) * dc1, __uint_as_float(bq & 0xffff0000u) * dc1); }
        v4u* d0 = (v4u*)(KSTT + ((size_t)u * 128 + k0) * 32); v4u* d1 = d0 + 4;
#pragma unroll
        for (int i = 0; i < 4; ++i) { d0[i] = (v4u){ks0[4 * i], ks0[4 * i + 1], ks0[4 * i + 2], ks0[4 * i + 3]}; d1[i] = (v4u){ks1[4 * i], ks1[4 * i + 1], ks1[4 * i + 2], ks1[4 * i + 3]}; }
    }
    asm volatile("s_waitcnt lgkmcnt(0)" ::: "memory");
    const int r32 = lane & 31, hi = lane >> 5;
    f32x16 acc;
#pragma unroll
    for (int r = 0; r < 16; ++r) acc[r] = 0.f;
#pragma unroll
    for (int s = 0; s < 8; ++s) {
        const bf16x8 a = ld_frag2_lds(sk + r32 * PPITCH + (16 * s + 8 * hi) * 2, sk + r32 * PPITCH + (16 * s + 8 * hi) * 2 + 8);
        const bf16x8 bq = ld_frag2_lds(sq + r32 * PPITCH + (16 * s + 8 * hi) * 2, sq + r32 * PPITCH + (16 * s + 8 * hi) * 2 + 8);
        acc = __builtin_amdgcn_mfma_f32_32x32x16_bf16(a, bq, acc, 0, 0, 0);
    }
    bf16* ao = AT + (size_t)u * 1024 + r32 * 32;
#pragma unroll
    for (int g = 0; g < 4; ++g) { float x[4];
#pragma unroll
        for (int e = 0; e < 4; ++e) { const int s = 8 * g + 4 * hi + e; x[e] = (s <= r32) ? acc[4 * g + e] : 0.f; }
        v2u w; w.x = att::cvtpk(x[0], x[1]); w.y = att::cvtpk(x[2], x[3]); *(v2u*)(ao + 8 * g + 4 * hi) = w; }
    asm volatile("s_waitcnt lgkmcnt(0)" ::: "memory");
}

constexpr int CP_Q = 264, CP_V = 72;
constexpr int CO_QD = 0, CO_VT = CO_QD + 32 * CP_Q, CO_KS = CO_VT + 128 * CP_V, CO_GT = CO_KS + 128 * CP_V, CO_A = CO_GT + 32 * CP_Q, CO_DC = CO_A + 32 * CP_V, CH_PAIR = CO_DC + 512;
constexpr int CH_STAGE = 2 * CH_PAIR, CH_XCH = 2 * CH_STAGE, CH_LDS = CH_XCH + 2048;
__device__ __forceinline__ void st16(LAS unsigned char* p, const v4u v) { *(LAS v2u*)p = (v2u){v.x, v.y}; *(LAS v2u*)(p + 8) = (v2u){v.z, v.w}; }
__device__ __forceinline__ bf16x8 ldl2(const LAS unsigned char* p0, const LAS unsigned char* p1) { const s16x4 a = *(const LAS s16x4*)p0, b = *(const LAS s16x4*)p1; return (bf16x8){a[0], a[1], a[2], a[3], b[0], b[1], b[2], b[3]}; }

__device__ __forceinline__ void chain(LAS unsigned char* lds, const bf16* __restrict__ proj, const bf16* __restrict__ KSTT, const float* __restrict__ DECAY, const bf16* __restrict__ AT,
                                      const float* __restrict__ nw  , bf16* __restrict__ mixed, int pair0, int npairs  ) {
    int tid_o = threadIdx.x; asm volatile("" : "+v"(tid_o));
    const int tid = tid_o, lane = tid & 63, wave = __builtin_amdgcn_readfirstlane(tid >> 6), r32 = lane & 31, hi = lane >> 5;
    const int pr = wave >> 2; const bool active = pr < npairs; const int bh = pair0 + (active ? pr : 0), b = bh >> 2, hh = bh & 3, vs = wave & 3;
    const int t256 = tid & 255;
    LAS float* xch = (LAS float*)(lds + CH_XCH);
    f32x16 S[4];
#pragma unroll
    for (int kt = 0; kt < 4; ++kt)
#pragma unroll
        for (int r = 0; r < 16; ++r) S[kt][r] = 0.f;
    float nwv[16];
#pragma unroll
    for (int r = 0; r < 16; ++r) nwv[r] = nw[vs * 32 + crow(r, hi)];
    const int vcol = vs * 32 + r32;
    v4u gq[2], gg[2], gv[2], gk[2], ga;
    auto issue = [&](int n) {
        if (!active) return;
        const int cn = b * 128 + n, u = cn * 4 + hh; const size_t m0 = (size_t)cn * 32;
#pragma unroll
        for (int i = 0; i < 2; ++i) { const int p = t256 + 256 * i;
            gq[i] = *(const v4u*)(proj + (m0 + (p >> 4)) * NINP + PC_HQ + hh * 128 + (p & 15) * 8);
            gg[i] = *(const v4u*)(proj + (m0 + (p >> 4)) * NINP + PC_HG + hh * 128 + (p & 15) * 8);
            gv[i] = *(const v4u*)(proj + (m0 + (p >> 4)) * NINP + PC_HI + hh * 128 + (p & 15) * 8);
            gk[i] = *(const v4u*)(KSTT + (size_t)u * 4096 + p * 8); }
        if (t256 < 128) ga = *(const v4u*)(AT + (size_t)u * 1024 + t256 * 8);
        else if (t256 < 160) ga = *(const v4u*)(DECAY + (size_t)u * 128 + (t256 - 128) * 4);
    };
    auto commit = [&](int stage) {
        if (!active) return;
        LAS unsigned char* st = lds + stage * CH_STAGE + pr * CH_PAIR;
#pragma unroll
        for (int i = 0; i < 2; ++i) { const int p = t256 + 256 * i;
            st16(st + CO_QD + (p >> 4) * CP_Q + (p & 15) * 16, gq[i]);
            st16(st + CO_GT + (p >> 4) * CP_Q + (p & 15) * 16, gg[i]);
            st16(st + CO_VT + (4 * (p >> 4) + ((p & 15) >> 2)) * CP_V + (p & 3) * 16, gv[i]);
            st16(st + CO_KS + (p >> 2) * CP_V + (p & 3) * 16, gk[i]); }
        if (t256 < 128) st16(st + CO_A + (t256 >> 2) * CP_V + (t256 & 3) * 16, ga);
        else if (t256 < 160) *(LAS v4u*)(st + CO_DC + (t256 - 128) * 16) = ga;
    };
    __syncthreads();
    issue(0); commit(0);
    __syncthreads();
#pragma unroll 1
    for (int n = 0; n < SEQ / 32; ++n) {
        const int cn = b * 128 + n; const size_t m0 = (size_t)cn * 32;
        const LAS unsigned char* st = lds + (n & 1) * CH_STAGE + pr * CH_PAIR;
        if (n + 1 < SEQ / 32) issue(n + 1);
        f32x16 O; v2u gw2[4]; LAS float* xb = xch + (n & 1) * 256;
        if (active) {
        const LAS unsigned char* qrow = st + CO_QD + r32 * CP_Q;
        const LAS unsigned char* vrow = st + CO_VT + vcol * CP_V;
        const LAS unsigned char* arow = st + CO_A + r32 * CP_V;
#pragma unroll
        for (int r = 0; r < 16; ++r) O[r] = 0.f;
#pragma unroll
        for (int s2 = 0; s2 < 2; ++s2) {
            const bf16x8 va = ldl2(vrow + (16 * s2 + 4 * hi) * 2, vrow + (16 * s2 + 8 + 4 * hi) * 2);
            const bf16x8 ab = ldl2(arow + (16 * s2 + 4 * hi) * 2, arow + (16 * s2 + 8 + 4 * hi) * 2);
            O = __builtin_amdgcn_mfma_f32_32x32x16_bf16(va, ab, O, 0, 0, 0);
        }
#pragma unroll
        for (int kt = 0; kt < 4; ++kt)
#pragma unroll
            for (int s2 = 0; s2 < 2; ++s2) {
                v4u pw; pw.x = att::cvtpk(S[kt][8 * s2 + 0], S[kt][8 * s2 + 1]); pw.y = att::cvtpk(S[kt][8 * s2 + 2], S[kt][8 * s2 + 3]); pw.z = att::cvtpk(S[kt][8 * s2 + 4], S[kt][8 * s2 + 5]); pw.w = att::cvtpk(S[kt][8 * s2 + 6], S[kt][8 * s2 + 7]);
                const bf16x8 sa = __builtin_bit_cast(bf16x8, pw);
                const bf16x8 qb = ldl2(qrow + (32 * kt + 16 * s2 + 4 * hi) * 2, qrow + (32 * kt + 16 * s2 + 8 + 4 * hi) * 2);
                O = __builtin_amdgcn_mfma_f32_32x32x16_bf16(sa, qb, O, 0, 0, 0);
            }
        float ssq = 0.f;
#pragma unroll
        for (int r = 0; r < 16; ++r) ssq += O[r] * O[r];
        ssq += __shfl_xor(ssq, 32);
        if (hi == 0) xb[wave * 32 + r32] = ssq;
#pragma unroll
        for (int kt = 0; kt < 4; ++kt) {
#pragma unroll
            for (int g = 0; g < 4; ++g) { const f32x4 dc = *(const LAS f32x4*)(st + CO_DC + (32 * kt + 8 * g + 4 * hi) * 4);
                S[kt][4 * g] *= dc[0]; S[kt][4 * g + 1] *= dc[1]; S[kt][4 * g + 2] *= dc[2]; S[kt][4 * g + 3] *= dc[3]; }
            const LAS unsigned char* krow = st + CO_KS + (32 * kt + r32) * CP_V;
#pragma unroll
            for (int ts = 0; ts < 2; ++ts) {
                const bf16x8 ka = ldl2(krow + (16 * ts + 8 * hi) * 2, krow + (16 * ts + 8 * hi) * 2 + 8);
                const bf16x8 vb = ldl2(vrow + (16 * ts + 8 * hi) * 2, vrow + (16 * ts + 8 * hi) * 2 + 8);
                S[kt] = __builtin_amdgcn_mfma_f32_32x32x16_bf16(ka, vb, S[kt], 0, 0, 0);
            }
        }
#pragma unroll
        for (int g = 0; g < 4; ++g) gw2[g] = *(const LAS v2u*)(st + CO_GT + r32 * CP_Q + (vs * 32 + 8 * g + 4 * hi) * 2);
        }
        if (n + 1 < SEQ / 32) commit((n + 1) & 1);
        __syncthreads();
        if (active) {
        const int w0 = wave & 4;
        const float tot = (xb[(w0 + 0) * 32 + r32] + xb[(w0 + 1) * 32 + r32]) + (xb[(w0 + 2) * 32 + r32] + xb[(w0 + 3) * 32 + r32]);
        const float rs = __builtin_amdgcn_rsqf(tot * (1.0f / 128.0f) + EPS);
        bf16* orow = mixed + (m0 + r32) * DM + hh * 128 + vs * 32;
#pragma unroll
        for (int g = 0; g < 4; ++g) {
            const float g0 = __uint_as_float(gw2[g].x << 16), g1 = __uint_as_float(gw2[g].x & 0xffff0000u), g2 = __uint_as_float(gw2[g].y << 16), g3 = __uint_as_float(gw2[g].y & 0xffff0000u);
            const float y0 = O[4 * g] * rs * nwv[4 * g] * (g0 * __builtin_amdgcn_rcpf(1.0f + __expf(-g0))), y1 = O[4 * g + 1] * rs * nwv[4 * g + 1] * (g1 * __builtin_amdgcn_rcpf(1.0f + __expf(-g1)));
            const float y2 = O[4 * g + 2] * rs * nwv[4 * g + 2] * (g2 * __builtin_amdgcn_rcpf(1.0f + __expf(-g2))), y3 = O[4 * g + 3] * rs * nwv[4 * g + 3] * (g3 * __builtin_amdgcn_rcpf(1.0f + __expf(-g3)));
            v2u w; w.x = att::cvtpk(y0, y1); w.y = att::cvtpk(y2, y3); *(v2u*)(orow + 8 * g + 4 * hi) = w;
        }
        }
    }
    __syncthreads();
}
}

constexpr size_t MiB = 1u << 20;
constexpr size_t WS_CTL = 0, CTL_ZERO_BYTES = 1 * MiB, WS_LBT = 768 * 1024;
constexpr size_t WS_PARTA = 1 * MiB, WS_PARTB = 3 * MiB, WS_COS = 5 * MiB, WS_SIN = 7 * MiB, WS_WI = 9 * MiB;
constexpr size_t WS_WSLOT = 10 * MiB, WSLOT_BYTES = 26 * MiB;
constexpr size_t WO_IN = 0, WO_OUT = WO_IN + (size_t)NINP * DM * 2, WO_1 = WO_OUT + (size_t)DM * DM * 2, WO_2 = WO_1 + (size_t)DFF * DM * 2, WO_QB = WO_2 + (size_t)DM * DFF * 2, WO_KVB = WO_QB + (size_t)384 * 192 * 2, WO_END = WO_KVB + (size_t)512 * 128 * 2;
static_assert(WO_END <= WSLOT_BYTES, "weight slot");
constexpr size_t WS_X = 62 * MiB, WS_Y = 126 * MiB, WS_PROJ = 190 * MiB, WS_MASK = 430 * MiB, WS_KI = 446 * MiB, WS_DECAY = 450 * MiB, WS_AT = 452 * MiB, WS_DVT = 460 * MiB, WS_KSTT = 476 * MiB, WS_END = 508 * MiB;
static_assert(WS_PROJ + (size_t)M * NINP * 2 == WS_MASK && WS_PROJ + (size_t)M * DFF * 2 == WS_KI, "proj / hidden overlay");
constexpr size_t MLA_Q = 0, MLA_K = 24 * MiB, MLA_VT = 48 * MiB;
constexpr int CW_BAR = 4096, CW_Q = 65536;
constexpr int N_BAR_REGIONS = 16;

constexpr int RING_OFF = 0, RING_BYTES = 131072;
constexpr int LDS_BYTES = 163840;
constexpr int LDSCTL_OFF = LDS_BYTES - 1024, MISC_OFF = LDSCTL_OFF + 320;
static_assert(8 * hgrn::PREP_LDS_PER_WAVE <= LDSCTL_OFF && hgrn::CH_LDS <= LDSCTL_OFF && prep::MLA_WLDS_BYTES <= LDSCTL_OFF && 512 * prep::WKV_PITCH <= LDSCTL_OFF, "LDS map");
constexpr int NWAVES = 8;

__device__ __forceinline__ float bf2f(bf16 v) { return __uint_as_float((unsigned)v << 16); }

__device__ __forceinline__ int in_colmap(int n) {
    if (n < 2240) return n;
    if (n < 2304) return -1;
    if (n < 2304 + 160) return 2240 + (n - 2304);
    if (n < 2304 + 224) return 3680 + (n - 2304 - 160);
    if (n < 2304 + 232) return 3744 + (n - 2304 - 224);
    if (n < 2560) return -1;
    if (n < 3328) return 2400 + (n - 2560);
    return 3168 + (n - 3328);
}

__device__ __forceinline__ float wave_sum(float v) {
#define WS_STEP(ctrl, rmask) v += __uint_as_float((unsigned)__builtin_amdgcn_update_dpp(0, (int)__float_as_uint(v), ctrl, rmask, 0xf, false))
    WS_STEP(0x111, 0xf); WS_STEP(0x112, 0xf); WS_STEP(0x114, 0xf); WS_STEP(0x118, 0xf); WS_STEP(0x142, 0xa); WS_STEP(0x143, 0xc);
#undef WS_STEP
    return __uint_as_float((unsigned)__builtin_amdgcn_readlane((int)__float_as_uint(v), 63));
}

template <int BLK = 0  >
__device__ __forceinline__ void cvt_item(const float* W, int K, int Nsrc, const float* gain, bf16* WT, int Np, int mode, LAS float* scr, int item, int lane) {
    const int nblk = Np / 32, kb = item / nblk, nb = item % nblk, k0 = 64 * kb, n0 = 32 * nb;
    const int n = n0 + (lane & 31); const int c = mode ? in_colmap(n) : n;
    float vals[32], gn[32];
#pragma unroll
    for (int i = 0; i < 32; ++i) { const int kk = 2 * i + (lane >> 5); vals[i] = (c >= 0) ? W[(size_t)(k0 + kk) * Nsrc + c] : 0.f; gn[i] = gain ? gain[k0 + kk] : 1.0f; }
    const float cscale = (mode && n >= PC_DQ && n < PC_DQ + 256) ? 0.125f * 1.4426950408889634f : 1.0f;
#pragma unroll
    for (int i = 0; i < 32; ++i) { const int kk = 2 * i + (lane >> 5); scr[kk * 33 + (lane & 31)] = vals[i] * gn[i] * cscale; }
    LDS_WAIT(); asm volatile("" ::: "memory");
    const int cc = lane & 7;
#pragma unroll
    for (int j = 0; j < 4; ++j) { const int nn = (lane >> 3) + 8 * j; const LAS float* s = scr + (8 * cc) * 33 + nn;
        v4u o; o.x = pk2(s[0 * 33], s[1 * 33]); o.y = pk2(s[2 * 33], s[3 * 33]); o.z = pk2(s[4 * 33], s[5 * 33]); o.w = pk2(s[6 * 33], s[7 * 33]);
        const int nrow = n0 + nn;
        *(GAS v4u*)(WT + (BLK ? (size_t)(nrow >> 8) * ((size_t)256 * K) + (size_t)(k0 >> 6) * (256 * 64) + (nrow & 255) * 64 + 8 * cc : (size_t)nrow * K + k0 + 8 * cc)) = o; }
    LDS_WAIT(); asm volatile("" ::: "memory");
}

__device__ __forceinline__ int t5_bucket(int dist) {
    const int n = dist > 0 ? dist : 0;
    if (n < 16) return n;
    int lg = 16 + (int)(logf((float)n / 16.0f) / 2.0794415416798357f * 16.0f);
    return lg < 31 ? lg : 31;
}

struct Args { const void* in[18]; float* out; unsigned char* ws; int p_lo, p_hi, bar_region, pad; };
enum { IN_X = 0, IN_POS, IN_ATTN_NW, IN_WIN, IN_LB, IN_HNW, IN_QNW, IN_WQB, IN_KVNW, IN_WKVB, IN_IKW, IN_IKB, IN_REL, IN_WOUT, IN_MLPNW, IN_W1, IN_W2, IN_FNW };

#ifndef STAG_TICKS
#define STAG_TICKS 0
#endif
__device__ __forceinline__ void stagger_delay() {
    if (STAG_TICKS > 0) { const unsigned long long t0 = rt(), d = (unsigned long long)((((int)blockIdx.x >> 3) & 7) * STAG_TICKS); while (rt() - t0 < d) __builtin_amdgcn_s_sleep(4); }
}
__device__ __forceinline__ void convert_layer(const Args& args, int l, int slot, LAS unsigned char* lds, int gw, int NGW, int wave, int lane) {
    LAS float* scr = (LAS float*)(lds + RING_OFF + wave * 16384);
    unsigned char* sb = args.ws + WS_WSLOT + (size_t)slot * WSLOT_BYTES;
    constexpr int I_IN = 16 * (NINP / 32), I_OUT = 16 * 32, I_1 = 16 * (DFF / 32), I_2 = 64 * 32, I_QB = 3 * 12, I_KVB = 2 * 16;
    constexpr int NIT = I_IN + I_OUT + I_1 + I_2 + I_QB + I_KVB;
    for (int it = gw; it < NIT; it += NGW) {
        int r = it;
        if (r < I_IN) { cvt_item((const float*)args.in[IN_WIN] + (size_t)l * DM * NIN_SRC, DM, NIN_SRC, (const float*)args.in[IN_ATTN_NW] + l * DM, (bf16*)(sb + WO_IN), NINP, 1, scr, r, lane); continue; } r -= I_IN;
        if (r < I_OUT) { cvt_item((const float*)args.in[IN_WOUT] + (size_t)l * DM * DM, DM, DM, nullptr, (bf16*)(sb + WO_OUT), DM, 0, scr, r, lane); continue; } r -= I_OUT;
        if (r < I_1) { cvt_item((const float*)args.in[IN_W1] + (size_t)l * DM * DFF, DM, DFF, (const float*)args.in[IN_MLPNW] + l * DM, (bf16*)(sb + WO_1), DFF, 0, scr, r, lane); continue; } r -= I_1;
        if (r < I_2) { cvt_item<1>((const float*)args.in[IN_W2] + (size_t)l * DFF * DM, DFF, DM, nullptr, (bf16*)(sb + WO_2), DM, 0, scr, r, lane); continue; } r -= I_2;
        if (r < I_QB) { cvt_item((const float*)args.in[IN_WQB] + (size_t)l * 192 * 384, 192, 384, (const float*)args.in[IN_QNW] + l * 192, (bf16*)(sb + WO_QB), 384, 0, scr, r, lane); continue; } r -= I_QB;
        cvt_item((const float*)args.in[IN_WKVB] + (size_t)l * 128 * 512, 128, 512, (const float*)args.in[IN_KVNW] + l * 128, (bf16*)(sb + WO_KVB), 512, 0, scr, r, lane);
    }
}

#ifndef REP_INPROJ
#define REP_INPROJ 1
#endif
#ifndef REP_MLPIN
#define REP_MLPIN 1
#endif
#ifndef REP_MIX1
#define REP_MIX1 1
#endif
#ifndef REP_MIX2
#define REP_MIX2 1
#endif
#ifndef REP_SEL
#define REP_SEL 1
#endif
#ifndef REP_MLA
#define REP_MLA 1
#endif
#ifndef REP_CHAIN
#define REP_CHAIN 1
#endif
#ifndef REP_CONV
#define REP_CONV 1
#endif
constexpr int PH_PER_LAYER = 8, PH_FINAL = 1 + PH_PER_LAYER * DEPTH, PH_COUNT = PH_FINAL + 1;
__global__ void __launch_bounds__(NWAVES * 64, 2) fwd(Args args) {
    extern __shared__ __attribute__((aligned(16))) unsigned char lds_raw[];
    LAS unsigned char* lds = (LAS unsigned char*)lds_raw;
    volatile LAS unsigned* MISC = (volatile LAS unsigned*)(lds + MISC_OFF);
    const int G = gridDim.x, NGW = G * NWAVES;
#define PHASE_IDS int tid_p = threadIdx.x; asm volatile("" : "+v"(tid_p)); const int tid = tid_p, lane = tid & 63, wave = __builtin_amdgcn_readfirstlane(tid >> 6), gw = blockIdx.x * NWAVES + wave; (void)lane; (void)gw; \
    GAS unsigned char* ws_p = (GAS unsigned char*)args.ws; asm volatile("" : "+s"(ws_p)); unsigned char* const ws = (unsigned char*)ws_p; (void)ws;
    unsigned char* ws0 = args.ws;
    gu32* ctl = (gu32*)(ws0 + WS_CTL);
    for (int u = threadIdx.x; u < (LDS_BYTES - LDSCTL_OFF) / 4; u += NWAVES * 64) ((LAS unsigned*)(lds + LDSCTL_OFF))[u] = 0u;
    __syncthreads();
    XcdBarrier bar = xcd_barrier_post((unsigned*)(ctl + CW_BAR) + args.bar_region * XCD_BAR_WORDS, MISC + 8);
    const int lo = args.p_lo, hi = args.p_hi;
#define IN(k) (lo <= (k) && (k) < hi)
#define SEAM(k) do { if ((k) + 1 < hi) xcd_barrier(bar); } while (0)
    unsigned char* mlab = (unsigned char*)args.out;

    if (IN(0)) {
        PHASE_IDS
        float* partA = (float*)(ws + WS_PARTA);
        const float* x = (const float*)args.in[IN_X]; bf16* hb = (bf16*)(ws + WS_X);
        for (int m = gw; m < M; m += NGW) {
            const GAS f32x4* xr = (const GAS f32x4*)(x + (size_t)m * DM) + lane;
            GAS unsigned long long* o8 = (GAS unsigned long long*)(hb + (size_t)m * DM) + lane;
            float s = 0.f;
#pragma unroll
            for (int j = 0; j < 4; ++j) { const f32x4 v = xr[64 * j]; s += (v.x * v.x + v.y * v.y) + (v.z * v.z + v.w * v.w);
                o8[64 * j] = (unsigned long long)pk2(v.x, v.y) | ((unsigned long long)pk2(v.z, v.w) << 32); }
            s = wave_sum(s);
            if (lane < 16) partA[(size_t)m * 16 + lane] = (lane == 0) ? s : 0.f;
        }
        const int* pos = (const int*)args.in[IN_POS]; float* cs = (float*)(ws + WS_COS); float* sn = (float*)(ws + WS_SIN);
        for (int idx = blockIdx.x * (NWAVES * 64) + tid; idx < M * 16; idx += G * NWAVES * 64) {
            const int m = idx >> 4, i = idx & 15;
            const float invf = __builtin_amdgcn_exp2f(-(float)i * 0.8304820237218405f);
            const float ang = (float)pos[m] * invf;
            const double rev = (double)ang * 0.15915494309189535; const float fr = (float)(rev - rint(rev));
            cs[idx] = __builtin_amdgcn_cosf(fr); sn[idx] = __builtin_amdgcn_sinf(fr);
        }
        {
            const float* lg = (const float*)args.in[IN_LB]; float* lbt = (float*)(ws + WS_LBT);
            for (int c = blockIdx.x * (NWAVES * 64) + tid; c < 512; c += G * NWAVES * 64) {
                float e[DEPTH], mx = -INFINITY, sm = 0.f;
#pragma unroll
                for (int i = 0; i < DEPTH; ++i) { e[i] = lg[i * 512 + c]; mx = fmaxf(mx, e[i]); }
#pragma unroll
                for (int i = 0; i < DEPTH; ++i) { e[i] = expf(e[i] - mx); sm += e[i]; }
                float cum = 0.f;
#pragma unroll
                for (int i = 0; i < DEPTH; ++i) { if (i > 0) cum += e[i] / sm; lbt[i * 512 + c] = cum; }
            }
        }
        if (!IN(1)) SEAM(0);
    }

#pragma unroll 1
    for (int l = 0; l < DEPTH; ++l) {
        const int pb = 1 + PH_PER_LAYER * l;
#define LAYER_PTRS unsigned char* sb = ws + WS_WSLOT + (size_t)(l & 1) * WSLOT_BYTES; unsigned char* bufIn = ws + WS_X; unsigned char* bufOt = ws + WS_Y; \
    float* partA = (float*)(ws + WS_PARTA); float* partB = (float*)(ws + WS_PARTB); (void)sb; (void)bufIn; (void)bufOt; (void)partA; (void)partB;
        const bool conv_early = (G == 256);
        if (IN(pb + 0) && (l == 0 || !conv_early)) { PHASE_IDS for (int rep = 0; rep < REP_CONV; ++rep) { convert_layer(args, l, l & 1, lds, gw, NGW, wave, lane); if (rep + 1 < REP_CONV) xcd_barrier(bar); } SEAM(pb + 0); }
        if (IN(pb + 1)) {
            PHASE_IDS LAYER_PTRS
            pg8::Gemm g{(const pg8::bf16_t*)bufIn, (const pg8::bf16_t*)(sb + WO_IN), M, NINP, DM}; pg8::StaticOrder S; S.init(M, NINP, G, (int)blockIdx.x);
            pg8::EpiScale<0> E{(pg8::bf16_t*)(ws + WS_PROJ), NINP, partA};
            stagger_delay();
            for (int rep = 0; rep < REP_INPROJ; ++rep) { pg8::gemm_phase<pg8::EpiScale<0>, pg8::StaticOrder, PG8_ALIGN, PG8_SP2>(lds + RING_OFF, g, S, E); if (rep + 1 < REP_INPROJ) xcd_barrier(bar); }
            if (conv_early && l + 1 < DEPTH && (int)blockIdx.x >= 128) {
                __syncthreads();
                convert_layer(args, l + 1, (l + 1) & 1, lds, ((int)blockIdx.x - 128) * NWAVES + wave, 128 * NWAVES, wave, lane);
            }
            SEAM(pb + 1);
        }
        if (IN(pb + 2)) {
            PHASE_IDS LAYER_PTRS
            const bf16* proj = (const bf16*)(ws + WS_PROJ);
            const bool aff = (G == 256);
            const int lwi = aff ? ((int)blockIdx.x >> 3) * NWAVES + wave : gw, lstr = aff ? 256 : NGW, bq = aff ? ((int)blockIdx.x & 7) : 0, nbat = aff ? 1 : NB;
#ifndef REP_PREPA
#define REP_PREPA 1
#endif
#ifndef REP_HDRY
#define REP_HDRY 0
#endif
            for (int r5 = 0; r5 < REP_PREPA; ++r5) {
            {
                const float* lnw = (const float*)args.in[IN_IKW] + l * 64; const float* lnb = (const float*)args.in[IN_IKB] + l * 64; bf16* KI = (bf16*)(ws + WS_KI); float* WI = (float*)(ws + WS_WI);
                const float lw = lnw[lane], lb2 = lnb[lane];
                const int glim = nbat * (SEQ / 4);
                for (int g0 = lwi; g0 < glim; g0 += 4 * lstr) {
                    unsigned short xr[4][4], wr_[4][4];
#pragma unroll
                    for (int q = 0; q < 4; ++q) { const int g4 = g0 + q * lstr; const int m4 = bq * SEQ + (g4 < glim ? g4 : g0) * 4;
#pragma unroll
                        for (int j = 0; j < 4; ++j) { const bf16* row = proj + (size_t)(m4 + j) * NINP; xr[q][j] = row[PC_IK + lane]; wr_[q][j] = row[PC_IW + (lane & 7)]; } }
#pragma unroll
                    for (int q = 0; q < 4; ++q) { const int g4 = g0 + q * lstr; if (g4 < glim) { const int m4 = bq * SEQ + g4 * 4;
                    float xs[4], ws4[4];
#pragma unroll
                    for (int j = 0; j < 4; ++j) { xs[j] = bf2f(xr[q][j]); ws4[j] = bf2f(wr_[q][j]); }
#pragma unroll
                    for (int j = 0; j < 4; ++j) { const int m = m4 + j;
                        const float mu = wave_sum(xs[j]) * (1.0f / 64.0f), dx = xs[j] - mu, var = wave_sum(dx * dx) * (1.0f / 64.0f);
                        KI[(size_t)(m >> 5) * 2048 + (lane >> 4) * 512 + ((lane >> 3) & 1) * 256 + (m & 31) * 8 + (lane & 7)] = (bf16)f2bf(dx * __builtin_amdgcn_rsqf(var + EPS) * lw + lb2);
                        if (lane < 8) WI[(size_t)m * 8 + lane] = ws4[j] * (0.35355339059327373f * 0.125f); }
                    } }
                }
            }
            {
                bf16* DVT = (bf16*)(ws + WS_DVT);
                for (int itl = lwi; itl < nbat * (SEQ / 64) * 4; itl += lstr) { const int it = bq * (SEQ / 64) * 4 + itl;
                    const int tile = it >> 2, hh = it & 3, m0 = tile * 64, b = m0 / SEQ, t0 = m0 % SEQ;
                    const int p = lane & 31, th = lane >> 5;
                    unsigned raw[32];
#pragma unroll
                    for (int i = 0; i < 32; ++i) raw[i] = *(const unsigned*)(proj + (size_t)(m0 + th * 32 + i) * NINP + PC_DV + hh * 64 + 2 * p);
                    v4u* d0 = (v4u*)(DVT + ((size_t)(b * 4 + hh) * 64 + 2 * p) * SEQ + t0 + th * 32); v4u* d1 = (v4u*)(DVT + ((size_t)(b * 4 + hh) * 64 + 2 * p + 1) * SEQ + t0 + th * 32);
#pragma unroll
                    for (int i = 0; i < 4; ++i) {
                        v4u a, c;
                        a.x = (raw[8 * i] & 0xffffu) | (raw[8 * i + 1] << 16); a.y = (raw[8 * i + 2] & 0xffffu) | (raw[8 * i + 3] << 16); a.z = (raw[8 * i + 4] & 0xffffu) | (raw[8 * i + 5] << 16); a.w = (raw[8 * i + 6] & 0xffffu) | (raw[8 * i + 7] << 16);
                        c.x = (raw[8 * i] >> 16) | (raw[8 * i + 1] & 0xffff0000u); c.y = (raw[8 * i + 2] >> 16) | (raw[8 * i + 3] & 0xffff0000u); c.z = (raw[8 * i + 4] >> 16) | (raw[8 * i + 5] & 0xffff0000u); c.w = (raw[8 * i + 6] >> 16) | (raw[8 * i + 7] & 0xffff0000u);
                        d0[i] = a; d1[i] = c; }
                }
            }
            }
            {
                const int wv = wave;
                for (int r6 = 0; r6 < REP_HDRY; ++r6)
                for (int ul = lwi; ul < nbat * (SEQ / 32) * 4; ul += lstr) { const int u = bq * (SEQ / 32) * 4 + ul;
                    hgrn::prep_unit<true>(lds + wv * hgrn::PREP_LDS_PER_WAVE, (bf16*)(ws + WS_PROJ), (const float*)(ws + WS_LBT) + l * 512, (bf16*)(ws + WS_KSTT), (float*)(ws + WS_DECAY), (bf16*)(ws + WS_AT), u, lane); }
                for (int ul = lwi; ul < nbat * (SEQ / 32) * 4; ul += lstr) { const int u = bq * (SEQ / 32) * 4 + ul;
                    hgrn::prep_unit<false>(lds + wv * hgrn::PREP_LDS_PER_WAVE, (bf16*)(ws + WS_PROJ), (const float*)(ws + WS_LBT) + l * 512, (bf16*)(ws + WS_KSTT), (float*)(ws + WS_DECAY), (bf16*)(ws + WS_AT), u, lane); }
            }
#ifndef REP_MLAPREP
#define REP_MLAPREP 1
#endif
            for (int r4 = 0; r4 < REP_MLAPREP; ++r4)
            if (aff) {
                const int rk = (int)blockIdx.x >> 3, kind = rk & 1, j = rk >> 1;
                __syncthreads();
#define MLA_WSTAGE(WOFF, CPR, PITCH, NCH, NPI) do { const bf16* wsrc = (const bf16*)(sb + (WOFF)); _Pragma("unroll 1") for (int c0 = tid; c0 < (NCH); c0 += (NPI) * 512) { v4u wv_[NPI]; \
                    _Pragma("unroll") for (int q_ = 0; q_ < (NPI); ++q_) wv_[q_] = *(const v4u*)(wsrc + (size_t)(c0 + q_ * 512) * 8);                        \
                    _Pragma("unroll") for (int q_ = 0; q_ < (NPI); ++q_) { const int c_ = c0 + q_ * 512; *(LAS v4u*)(lds + (c_ / (CPR)) * (PITCH) + (c_ % (CPR)) * 16) = wv_[q_]; } } } while (0)
                if (kind) MLA_WSTAGE(WO_KVB, 16, prep::WKV_PITCH, 512 * 16, 8); else MLA_WSTAGE(WO_QB, 24, prep::WQ_PITCH, 384 * 24, 6);
#undef MLA_WSTAGE
                __syncthreads();
                prep::mla_prep_unit<true>(proj, (const bf16*)(sb + WO_QB), (const bf16*)(sb + WO_KVB), (const float*)(ws + WS_COS), (const float*)(ws + WS_SIN),
                                          (bf16*)(mlab + MLA_Q), (bf16*)(mlab + MLA_K), (bf16*)(mlab + MLA_VT), bq * (SEQ / 32) + j * 8 + wave, lane, kind, lds);
                __syncthreads();
            } else
            for (int ul = lwi; ul < nbat * (SEQ / 32) * 2; ul += lstr) { const int u2 = bq * (SEQ / 32) * 2 + ul;
                prep::mla_prep_unit<false>(proj, (const bf16*)(sb + WO_QB), (const bf16*)(sb + WO_KVB), (const float*)(ws + WS_COS), (const float*)(ws + WS_SIN),
                                    (bf16*)(mlab + MLA_Q), (bf16*)(mlab + MLA_K), (bf16*)(mlab + MLA_VT), u2 >> 1, lane, u2 & 1); }
            SEAM(pb + 2);
        }
        if (IN(pb + 3)) {
            PHASE_IDS LAYER_PTRS
            for (int rep = 0; rep < REP_MIX1; ++rep) {
            for (int r3 = 0; r3 < REP_CHAIN; ++r3)
            for (int pp = (int)blockIdx.x; pp < 32; pp += G)
                hgrn::chain(lds + RING_OFF, (const bf16*)(ws + WS_PROJ), (const bf16*)(ws + WS_KSTT), (const float*)(ws + WS_DECAY), (const bf16*)(ws + WS_AT), (const float*)args.in[IN_HNW] + l * 128, (bf16*)bufOt, pp, 1);
            const bf16* proj = (const bf16*)(ws + WS_PROJ); const bf16* KI = (const bf16*)(ws + WS_KI); const float* WI = (const float*)(ws + WS_WI); unsigned* maskp = (unsigned*)(ws + WS_MASK);
            const bf16* Qb = (const bf16*)(mlab + MLA_Q); const bf16* Kb = (const bf16*)(mlab + MLA_K); const bf16* VTb = (const bf16*)(mlab + MLA_VT); bf16* mixed = (bf16*)bufOt;
            for (int qi = 0; qi < 8; ++qi) {
                const int b = ((int)blockIdx.x + qi) & 7;
                gu32* qcnt = ctl + CW_Q + ((rep * DEPTH + l) * 8 + b) * 64;
                if (qi == 1) {
                    int t8 = threadIdx.x; asm volatile("" : "+v"(t8));
                    if (t8 < 8) MISC[24 + t8] = __hip_atomic_load(ctl + CW_Q + ((rep * DEPTH + l) * 8 + t8) * 64, __ATOMIC_RELAXED, __HIP_MEMORY_SCOPE_AGENT);
                    __syncthreads();
                }
                if (qi >= 1 && (int)MISC[24 + b] >= sel3::KEND) continue;
                for (;;) {
                    if (tid == 0) MISC[16] = __hip_atomic_fetch_add(qcnt, 1u, __ATOMIC_RELAXED, __HIP_MEMORY_SCOPE_AGENT);
                    __syncthreads();
                    const int k = (int)MISC[16];
                    __syncthreads();
                    if (k >= sel3::KEND) break;
                    if (k < sel3::KSEL0) {
                        const int qb = 15 - (k >> 2), hh = k & 3;
                        for (int r2 = 0; r2 < REP_MLA; ++r2)
                        att::attn_unit<96, false>(lds + RING_OFF, Qb + (size_t)b * SEQ * 384 + hh * 96, 384, Kb + (size_t)b * SEQ * 384 + hh * 96, 384, VTb + (size_t)(b * 4 + hh) * 64 * SEQ,
                                                  mixed + (size_t)b * SEQ * DM + 512 + hh * 64, DM, qb * 256, nullptr, nullptr, nullptr, hh, 1.0f);
                    } else {
                        sel3::dsa_select_stream(lds + RING_OFF, MISC, qcnt, proj, KI, WI, maskp, k, b);
                        break;
                    }
                }
            }
            __syncthreads();
            if (rep + 1 < REP_MIX1) xcd_barrier(bar);
            }
            SEAM(pb + 3);
        }
        if (IN(pb + 4)) {
            LAS float* biastab = (LAS float*)(lds + RING_OFF + 98304);
            PHASE_IDS LAYER_PTRS
            { const float* rel = (const float*)args.in[IN_REL]; const int d = tid >> 2, hh = tid & 3; biastab[tid] = rel[t5_bucket(d) * 4 + hh] * 1.4426950408889634f; }
            __syncthreads();
            const bf16* proj = (const bf16*)(ws + WS_PROJ); const bf16* DVT = (const bf16*)(ws + WS_DVT); bf16* mixed = (bf16*)bufOt;
            const unsigned* maskp = (const unsigned*)(ws + WS_MASK); const int* pos = (const int*)args.in[IN_POS];
            for (int rep = 0; rep < REP_MIX2; ++rep) { if (rep) xcd_barrier(bar);
            for (int i = 0; ; ++i) {
                int qb, b, hh;
                if (G == 256) { if (i >= 2) break; b = (int)blockIdx.x & 7; const int jj = (int)blockIdx.x >> 3; hh = jj & 3; qb = (i == 0) ? 15 - (jj >> 2) : (jj >> 2); }
                else { const int k = (int)blockIdx.x + i * G; if (k >= 512) break; qb = 15 - (k >> 5); b = (k & 31) >> 2; hh = k & 3; }
                att::attn_unit<64, true>(lds + RING_OFF, proj + (size_t)b * SEQ * NINP + PC_DQ + hh * 64, NINP, proj + (size_t)b * SEQ * NINP + PC_DK + hh * 64, NINP, DVT + (size_t)(b * 4 + hh) * 64 * SEQ,
                                         mixed + (size_t)b * SEQ * DM + 768 + hh * 64, DM, qb * 256, maskp + (size_t)b * SEQ * 128, pos + b * SEQ, biastab, hh, 1.0f);
            }
            }
            SEAM(pb + 4);
        }
        if (IN(pb + 5)) {
            PHASE_IDS LAYER_PTRS
            pg8::Gemm g{(const pg8::bf16_t*)bufOt, (const pg8::bf16_t*)(sb + WO_OUT), M, DM, DM}; pg8::StaticOrder S; S.init(M, DM, G, (int)blockIdx.x);
            pg8::EpiRes E{(pg8::bf16_t*)bufIn, partB};
#ifndef REP_RES_O
#define REP_RES_O 1
#endif
#ifndef REP_RES_M
#define REP_RES_M 1
#endif
            if (REP_RES_O > 1) { pg8::EpiRes E0{(pg8::bf16_t*)bufIn, partA, (pg8::bf16_t*)(ws + WS_PROJ)}; pg8::gemm_phase<pg8::EpiRes, pg8::StaticOrder, PG8_ALIGN, PG8_SP2>(lds + RING_OFF, g, S, E0); xcd_barrier(bar); }
            pg8::gemm_phase<pg8::EpiRes, pg8::StaticOrder, PG8_ALIGN, PG8_SP2>(lds + RING_OFF, g, S, E);
            SEAM(pb + 5);
        }
        if (IN(pb + 6)) {
            PHASE_IDS LAYER_PTRS
            pg8::Gemm g{(const pg8::bf16_t*)bufIn, (const pg8::bf16_t*)(sb + WO_1), M, DFF, DM}; pg8::StaticOrder S; S.init(M, DFF, G, (int)blockIdx.x);
            pg8::EpiScale<1> E{(pg8::bf16_t*)(ws + WS_PROJ), DFF, partB, 1};
            stagger_delay();
            for (int rep = 0; rep < REP_MLPIN; ++rep) { pg8::gemm_phase<pg8::EpiScale<1>, pg8::StaticOrder, PG8_ALIGN, PG8_SP2>(lds + RING_OFF, g, S, E); if (rep + 1 < REP_MLPIN) xcd_barrier(bar); }
            SEAM(pb + 6);
        }
        if (IN(pb + 7)) {
            PHASE_IDS LAYER_PTRS
            pg8::Gemm g{(const pg8::bf16_t*)(ws + WS_PROJ), (const pg8::bf16_t*)(sb + WO_2), M, DM, DFF, 1, 1}; pg8::StaticOrder S; S.init(M, DM, G, (int)blockIdx.x); S.rev = (512 % G == 0);
            pg8::EpiRes E{(pg8::bf16_t*)bufIn, partA};
            if (REP_RES_M > 1) { pg8::EpiRes E0{(pg8::bf16_t*)bufIn, partB, (pg8::bf16_t*)bufOt}; pg8::gemm_phase<pg8::EpiRes, pg8::StaticOrder, PG8_ALIGN, PG8_SP2>(lds + RING_OFF, g, S, E0); xcd_barrier(bar); }
            pg8::gemm_phase<pg8::EpiRes, pg8::StaticOrder, PG8_ALIGN, PG8_SP2>(lds + RING_OFF, g, S, E);
            SEAM(pb + 7);
        }
    }
    if (IN(PH_FINAL)) {
        PHASE_IDS
        float* partA = (float*)(ws + WS_PARTA);
        const float* fw = (const float*)args.in[IN_FNW];
        for (int m = gw; m < M; m += NGW) {
            const GAS f32x4* pp = (const GAS f32x4*)(partA + (size_t)m * 16);
            const f32x4 p0 = pp[0], p1 = pp[1], p2 = pp[2], p3 = pp[3];
            const float ss = ((p0.x + p0.y) + (p0.z + p0.w)) + ((p1.x + p1.y) + (p1.z + p1.w)) + ((p2.x + p2.y) + (p2.z + p2.w)) + ((p3.x + p3.y) + (p3.z + p3.w));
            const float rs = 1.0f / sqrtf(ss * (1.0f / 1024.0f) + EPS);
            GAS f32x4* orow = (GAS f32x4*)(args.out + (size_t)m * DM) + lane; const GAS f32x4* wr4 = (const GAS f32x4*)fw + lane;
            const GAS unsigned long long* h8 = (const GAS unsigned long long*)((const bf16*)(ws + WS_X) + (size_t)m * DM) + lane;
#pragma unroll
            for (int j = 0; j < 4; ++j) { const unsigned long long hv = h8[64 * j]; const unsigned lo = (unsigned)hv, hi2 = (unsigned)(hv >> 32); const f32x4 w = wr4[64 * j];
                f32x4 v; v.x = __uint_as_float(lo << 16); v.y = __uint_as_float(lo & 0xffff0000u); v.z = __uint_as_float(hi2 << 16); v.w = __uint_as_float(hi2 & 0xffff0000u);
                orow[64 * j] = v * rs * w; }
        }
    }
#undef IN
#undef SEAM
#undef PHASE_IDS
#undef LAYER_PTRS
}

__device__ __forceinline__ bf16 f2bf16(float f) { return (bf16)f2bf(f); }

__global__ void __launch_bounds__(128) hgrn_naive(const bf16* __restrict__ proj, const float* __restrict__ lb_logits, const float* __restrict__ norm_w, int layer, bf16* __restrict__ mixed) {
    const int b = blockIdx.x >> 2, hh = blockIdx.x & 3, v = threadIdx.x, lane = v & 63, wv = v >> 6;
    __shared__ float sf[128], sk[128], sq[128], red[2];
    const int c = hh * 128 + v;
    float lb;
    { float lg[4], mx = -INFINITY, sm = 0.f;
      for (int i = 0; i < 4; ++i) { lg[i] = lb_logits[i * 512 + c]; mx = fmaxf(mx, lg[i]); }
      for (int i = 0; i < 4; ++i) { lg[i] = expf(lg[i] - mx); sm += lg[i]; }
      lb = 0.f; for (int i = 1; i < 4; ++i) if (i <= layer) lb += lg[i] / sm; }
    const float nw = norm_w[layer * 128 + v];
    float S[128];
#pragma unroll
    for (int k = 0; k < 128; ++k) S[k] = 0.f;
    for (int t = 0; t < SEQ; ++t) {
        const size_t m = (size_t)b * SEQ + t; const bf16* row = proj + m * NINP;
        const float qv = bf2f(row[PC_HQ + c]) * 0.08838834764831845f, fp = bf2f(row[PC_HF + c]), iv = bf2f(row[PC_HI + c]), gv = bf2f(row[PC_HG + c]);
        const float sg = 1.0f / (1.0f + expf(-fp)), sgn = 1.0f / (1.0f + expf(fp));
        sf[v] = lb + (1.0f - lb) * sg; sk[v] = (1.0f - lb) * sgn; sq[v] = qv;
        __syncthreads();
        float o = 0.f;
#pragma unroll
        for (int k = 0; k < 128; ++k) { S[k] = sf[k] * S[k] + sk[k] * iv; o += sq[k] * S[k]; }
        float s2 = o * o;
#pragma unroll
        for (int off = 32; off >= 1; off >>= 1) s2 += __shfl_xor(s2, off);
        if (lane == 0) red[wv] = s2;
        __syncthreads();
        const float rs = 1.0f / sqrtf((red[0] + red[1]) * (1.0f / 128.0f) + EPS);
        const float y = o * rs * nw * (gv / (1.0f + expf(-gv)));
        mixed[m * DM + c] = f2bf16(y);
        __syncthreads();
    }
}

__global__ void __launch_bounds__(128) mla_prep_naive(const bf16* __restrict__ proj, const bf16* __restrict__ wqb_t, const bf16* __restrict__ wkvb_t, const float* __restrict__ cs, const float* __restrict__ sn,
                                                        bf16* __restrict__ Q, bf16* __restrict__ K, bf16* __restrict__ VT) {
    const int m = blockIdx.x, tid = threadIdx.x, b = m / SEQ, t = m % SEQ;
    __shared__ float qa[192], ckv[128], kpe[32], qout[384], red[2][2];
    const bf16* row = proj + (size_t)m * NINP;
    for (int k = tid; k < 192; k += 128) qa[k] = bf2f(row[PC_MQA + k]);
    ckv[tid] = bf2f(row[PC_MKVA + tid]);
    if (tid < 32) kpe[tid] = bf2f(row[PC_MKVA + 128 + tid]);
    __syncthreads();
    float s1 = 0.f; for (int k = tid; k < 192; k += 128) s1 += qa[k] * qa[k];
    float s2 = ckv[tid] * ckv[tid];
    for (int off = 32; off >= 1; off >>= 1) { s1 += __shfl_xor(s1, off); s2 += __shfl_xor(s2, off); }
    if ((tid & 63) == 0) { red[tid >> 6][0] = s1; red[tid >> 6][1] = s2; }
    __syncthreads();
    const float rq = 1.0f / sqrtf((red[0][0] + red[1][0]) * (1.0f / 192.0f) + EPS), rkv = 1.0f / sqrtf((red[0][1] + red[1][1]) * (1.0f / 128.0f) + EPS);
    for (int n = tid; n < 384; n += 128) { float a = 0.f; const bf16* w = wqb_t + (size_t)n * 192; for (int k = 0; k < 192; ++k) a += qa[k] * bf2f(w[k]); qout[n] = a * rq; }
    __syncthreads();
    for (int n = tid; n < 384; n += 128) {
        const int hh = n / 96, j = n % 96; float val;
        if (j < 64) val = qout[n];
        else { const int i = (j - 64) & 15, part = (j - 64) >> 4; const float x1 = qout[hh * 96 + 64 + i], x2 = qout[hh * 96 + 80 + i], c = cs[(size_t)m * 16 + i], s = sn[(size_t)m * 16 + i];
               val = part == 0 ? x1 * c - x2 * s : x2 * c + x1 * s; }
        Q[(size_t)m * 384 + n] = f2bf16(val * QSCALE);
    }
    for (int n = tid; n < 512; n += 128) {
        float a = 0.f; const bf16* w = wkvb_t + (size_t)n * 128; for (int k = 0; k < 128; ++k) a += ckv[k] * bf2f(w[k]); a *= rkv;
        const int hh = n >> 7, j = n & 127;
        if (j < 64) K[(size_t)m * 384 + hh * 96 + j] = f2bf16(a); else VT[((size_t)(b * 4 + hh) * 64 + (j - 64)) * SEQ + t] = f2bf16(a);
    }
    if (tid < 32) {
        const int i = tid & 15, part = tid >> 4; const float x1 = kpe[i], x2 = kpe[16 + i], c = cs[(size_t)m * 16 + i], s = sn[(size_t)m * 16 + i];
        const float val = part == 0 ? x1 * c - x2 * s : x2 * c + x1 * s;
        for (int hh = 0; hh < 4; ++hh) K[(size_t)m * 384 + hh * 96 + 64 + tid] = f2bf16(val);
    }
}

__global__ void __launch_bounds__(256) mla_attn_naive(const bf16* __restrict__ Q, const bf16* __restrict__ K, const bf16* __restrict__ VT, bf16* __restrict__ mixed) {
    const int lane = threadIdx.x & 63, gwv = blockIdx.x * 4 + (threadIdx.x >> 6);
    const int m = gwv >> 2, hh = gwv & 3, b = m / SEQ, t = m % SEQ;
    float q[96];
    { const bf16* qp = Q + (size_t)m * 384 + hh * 96;
#pragma unroll
      for (int d = 0; d < 96; ++d) q[d] = bf2f(qp[d]); }
    float o[64];
#pragma unroll
    for (int d = 0; d < 64; ++d) o[d] = 0.f;
    float mx = -INFINITY, l = 0.f;
    const bf16* vt = VT + (size_t)(b * 4 + hh) * 64 * SEQ;
    for (int j = lane; j <= t; j += 64) {
        const bf16* kr = K + ((size_t)b * SEQ + j) * 384 + hh * 96;
        float s = 0.f;
#pragma unroll
        for (int d8 = 0; d8 < 12; ++d8) { const v4u kk = *(const v4u*)(kr + d8 * 8);
            s += q[d8 * 8 + 0] * __uint_as_float(kk.x << 16) + q[d8 * 8 + 1] * __uint_as_float(kk.x & 0xffff0000u) + q[d8 * 8 + 2] * __uint_as_float(kk.y << 16) + q[d8 * 8 + 3] * __uint_as_float(kk.y & 0xffff0000u)
               + q[d8 * 8 + 4] * __uint_as_float(kk.z << 16) + q[d8 * 8 + 5] * __uint_as_float(kk.z & 0xffff0000u) + q[d8 * 8 + 6] * __uint_as_float(kk.w << 16) + q[d8 * 8 + 7] * __uint_as_float(kk.w & 0xffff0000u); }
        const float mn = fmaxf(mx, s), sc = exp2f(mx - mn), p = exp2f(s - mn);
        l = l * sc + p; mx = mn;
#pragma unroll
        for (int d = 0; d < 64; ++d) o[d] = o[d] * sc + p * bf2f(vt[(size_t)d * SEQ + j]);
    }
    float Mx = mx;
#pragma unroll
    for (int off = 32; off >= 1; off >>= 1) Mx = fmaxf(Mx, __shfl_xor(Mx, off));
    const float f = (mx == -INFINITY) ? 0.f : exp2f(mx - Mx);
    float lt = l * f;
#pragma unroll
    for (int off = 32; off >= 1; off >>= 1) lt += __shfl_xor(lt, off);
    float mine = 0.f;
#pragma unroll
    for (int d = 0; d < 64; ++d) { float v = o[d] * f;
#pragma unroll
        for (int off = 32; off >= 1; off >>= 1) v += __shfl_xor(v, off);
        if (lane == d) mine = v; }
    mixed[(size_t)m * DM + 512 + hh * 64 + lane] = f2bf16(mine / lt);
}

__global__ void __launch_bounds__(256) dsa_prep_naive(const bf16* __restrict__ proj, const float* __restrict__ lnw, const float* __restrict__ lnb, bf16* __restrict__ KI, float* __restrict__ WI) {
    const int lane = threadIdx.x & 63, m = blockIdx.x * 4 + (threadIdx.x >> 6);
    const bf16* row = proj + (size_t)m * NINP;
    const float x = bf2f(row[PC_IK + lane]);
    const float mu = wave_sum(x) * (1.0f / 64.0f), dx = x - mu, var = wave_sum(dx * dx) * (1.0f / 64.0f);
    KI[(size_t)m * 64 + lane] = f2bf16(dx * (1.0f / sqrtf(var + EPS)) * lnw[lane] + lnb[lane]);
    if (lane < 8) WI[(size_t)m * 8 + lane] = bf2f(row[PC_IW + lane]) * (0.35355339059327373f * 0.125f);
}

__device__ __forceinline__ unsigned mono_key(float s) { const unsigned u = __float_as_uint(s + 0.0f); return (u & 0x80000000u) ? ~u : (u | 0x80000000u); }

__global__ void __launch_bounds__(256) dsa_select_naive(const bf16* __restrict__ proj, const bf16* __restrict__ KI, const float* __restrict__ WI, unsigned* __restrict__ mask) {
    const int m = blockIdx.x, tid = threadIdx.x, lane = tid & 63, wv = tid >> 6, b = m / SEQ, t = m % SEQ, N = t + 1;
    __shared__ float iq[512]; __shared__ float wi[8]; __shared__ unsigned keys[SEQ]; __shared__ unsigned red[4];
    for (int i = tid; i < 512; i += 256) iq[i] = bf2f(proj[(size_t)m * NINP + PC_IQ + i]);
    if (tid < 8) wi[tid] = WI[(size_t)m * 8 + tid];
    __syncthreads();
    for (int j = tid; j < N; j += 256) {
        const bf16* kr = KI + ((size_t)b * SEQ + j) * 64; float kf[64];
#pragma unroll
        for (int d8 = 0; d8 < 8; ++d8) { const v4u kk = *(const v4u*)(kr + d8 * 8);
            kf[d8 * 8 + 0] = __uint_as_float(kk.x << 16); kf[d8 * 8 + 1] = __uint_as_float(kk.x & 0xffff0000u); kf[d8 * 8 + 2] = __uint_as_float(kk.y << 16); kf[d8 * 8 + 3] = __uint_as_float(kk.y & 0xffff0000u);
            kf[d8 * 8 + 4] = __uint_as_float(kk.z << 16); kf[d8 * 8 + 5] = __uint_as_float(kk.z & 0xffff0000u); kf[d8 * 8 + 6] = __uint_as_float(kk.w << 16); kf[d8 * 8 + 7] = __uint_as_float(kk.w & 0xffff0000u); }
        float sc = 0.f;
#pragma unroll
        for (int h = 0; h < 8; ++h) { float dsum = 0.f;
#pragma unroll
            for (int d = 0; d < 64; ++d) dsum += iq[h * 64 + d] * kf[d];
            sc += fmaxf(dsum, 0.f) * wi[h]; }
        keys[j] = mono_key(sc);
    }
    __syncthreads();
    unsigned T = 0u; int need = 256;
    const bool all = (N <= 256);
    if (!all) {
        for (int bit = 31; bit >= 0; --bit) {
            const unsigned cand = T | (1u << bit); unsigned cnt = 0;
            for (int j = tid; j < N; j += 256) cnt += (keys[j] >= cand) ? 1u : 0u;
#pragma unroll
            for (int off = 32; off >= 1; off >>= 1) cnt += __shfl_xor(cnt, off);
            if (lane == 0) red[wv] = cnt;
            __syncthreads();
            const unsigned tot = red[0] + red[1] + red[2] + red[3];
            __syncthreads();
            if (tot >= 256u) T = cand;
        }
        unsigned cnt = 0;
        for (int j = tid; j < N; j += 256) cnt += (keys[j] > T) ? 1u : 0u;
#pragma unroll
        for (int off = 32; off >= 1; off >>= 1) cnt += __shfl_xor(cnt, off);
        if (lane == 0) red[wv] = cnt;
        __syncthreads();
        need = 256 - (int)(red[0] + red[1] + red[2] + red[3]);
        __syncthreads();
    }
    int base = 0;
    for (int it = 0; it < SEQ / 256; ++it) {
        const int j = it * 256 + tid; const bool inr = j < N; const unsigned k = inr ? keys[j] : 0u;
        const bool eq = !all && inr && (k == T);
        const unsigned long long eb = __ballot(eq);
        if (lane == 0) red[wv] = (unsigned)__popcll(eb);
        __syncthreads();
        int pre = 0; for (int w = 0; w < wv; ++w) pre += (int)red[w];
        const int tot = (int)(red[0] + red[1] + red[2] + red[3]);
        const int rank = base + pre + (int)__popcll(eb & ((1ull << lane) - 1ull));
        const bool sel = inr && (all || k > T || (eq && rank < need));
        const unsigned long long sb = __ballot(sel);
        if (lane == 0) { mask[(size_t)m * 128 + (j >> 5)] = (unsigned)sb; mask[(size_t)m * 128 + (j >> 5) + 1] = (unsigned)(sb >> 32); }
        base += tot;
        __syncthreads();
    }
}


__global__ void __launch_bounds__(256) dsa_attn_naive(const bf16* __restrict__ proj, const unsigned* __restrict__ mask, const int* __restrict__ pos, const float* __restrict__ rel, bf16* __restrict__ mixed) {
    const int m = blockIdx.x, tid = threadIdx.x, lane = tid & 63, wv = tid >> 6, b = m / SEQ;
    __shared__ int list[256]; __shared__ float dq[256]; __shared__ float p[256][4]; __shared__ float redm[4][4]; __shared__ int cnts[128]; __shared__ int nsel_s;
    unsigned w = tid < 128 ? mask[(size_t)m * 128 + tid] : 0u;
    if (tid < 128) cnts[tid] = __popc(w);
    dq[tid] = bf2f(proj[(size_t)m * NINP + PC_DQ + tid]);
    __syncthreads();
    if (tid == 0) { int a = 0; for (int i = 0; i < 128; ++i) { const int c = cnts[i]; cnts[i] = a; a += c; } nsel_s = a; }
    __syncthreads();
    if (tid < 128) { int off = cnts[tid]; while (w) { const int bit = __ffs(w) - 1; if (off < 256) list[off] = tid * 32 + bit; ++off; w &= w - 1u; } }
    __syncthreads();
    const int nsel = nsel_s < 256 ? nsel_s : 256;
    float lg[4] = {-INFINITY, -INFINITY, -INFINITY, -INFINITY};
    if (tid < nsel) {
        const int j = list[tid]; const bf16* kr = proj + ((size_t)b * SEQ + j) * NINP + PC_DK;
        const int bk = t5_bucket(pos[m] - pos[b * SEQ + j]);
#pragma unroll
        for (int h = 0; h < 4; ++h) { float a = 0.f;
            for (int d = 0; d < 64; ++d) a += dq[h * 64 + d] * bf2f(kr[h * 64 + d]);
            lg[h] = a * 0.125f + rel[bk * 4 + h]; }
    }
    float mxh[4], smh[4];
#pragma unroll
    for (int h = 0; h < 4; ++h) { float v = lg[h];
#pragma unroll
        for (int off = 32; off >= 1; off >>= 1) v = fmaxf(v, __shfl_xor(v, off));
        if (lane == 0) redm[wv][h] = v; }
    __syncthreads();
#pragma unroll
    for (int h = 0; h < 4; ++h) mxh[h] = fmaxf(fmaxf(redm[0][h], redm[1][h]), fmaxf(redm[2][h], redm[3][h]));
    __syncthreads();
    float pe[4];
#pragma unroll
    for (int h = 0; h < 4; ++h) { pe[h] = (tid < nsel) ? expf(lg[h] - mxh[h]) : 0.f; p[tid][h] = pe[h]; float v = pe[h];
#pragma unroll
        for (int off = 32; off >= 1; off >>= 1) v += __shfl_xor(v, off);
        if (lane == 0) redm[wv][h] = v; }
    __syncthreads();
#pragma unroll
    for (int h = 0; h < 4; ++h) smh[h] = (redm[0][h] + redm[1][h]) + (redm[2][h] + redm[3][h]);
    const int hh = tid >> 6;
    float acc = 0.f;
    for (int i = 0; i < nsel; ++i) acc += p[i][hh] * bf2f(proj[((size_t)b * SEQ + list[i]) * NINP + PC_DV + tid]);
    const float den = hh == 0 ? smh[0] : hh == 1 ? smh[1] : hh == 2 ? smh[2] : smh[3];
    mixed[(size_t)m * DM + 768 + tid] = f2bf16(acc / den);
}

__global__ void __launch_bounds__(64) dvt_naive(const bf16* __restrict__ proj, bf16* __restrict__ DVT) {
    const int tile = blockIdx.x >> 2, hh = blockIdx.x & 3, d = threadIdx.x, m0 = tile * 64, b = m0 / SEQ, t0 = m0 % SEQ;
    unsigned pk[32];
#pragma unroll
    for (int i = 0; i < 32; ++i) { const unsigned lo = proj[(size_t)(m0 + 2 * i) * NINP + PC_DV + hh * 64 + d], hi = proj[(size_t)(m0 + 2 * i + 1) * NINP + PC_DV + hh * 64 + d]; pk[i] = lo | (hi << 16); }
    v4u* dst = (v4u*)(DVT + ((size_t)(b * 4 + hh) * 64 + d) * SEQ + t0);
#pragma unroll
    for (int i = 0; i < 8; ++i) dst[i] = (v4u){pk[4 * i], pk[4 * i + 1], pk[4 * i + 2], pk[4 * i + 3]};
}

extern "C" void kernel_launch(void* const* d_in, const int* in_sizes, int n_in, void* d_out, int out_size, void* d_ws, size_t ws_size, hipStream_t stream) {
    static int grid = 0;
    if (grid == 0) {
        if (n_in != 18 || in_sizes[0] != M * DM || out_size != M * DM || ws_size < WS_END) { fprintf(stderr, "kernel_launch: unexpected shapes (n_in %d, in0 %d, out %d, ws %zu); nothing launched\n", n_in, n_in > 0 ? in_sizes[0] : -1, out_size, ws_size); grid = -1; return; }
        int dev = 0, cus = 0, per_cu = 0;
        if (hipGetDevice(&dev) != hipSuccess || hipDeviceGetAttribute(&cus, hipDeviceAttributeMultiprocessorCount, dev) != hipSuccess) { grid = -1; return; }
        if (hipFuncSetAttribute((const void*)fwd, hipFuncAttributeMaxDynamicSharedMemorySize, LDS_BYTES) != hipSuccess) { fprintf(stderr, "kernel_launch: hipFuncSetAttribute failed\n"); grid = -1; return; }
        if (hipOccupancyMaxActiveBlocksPerMultiprocessor(&per_cu, (const void*)fwd, NWAVES * 64, LDS_BYTES) != hipSuccess || per_cu < 1) fprintf(stderr, "kernel_launch: occupancy query reports %d\n", per_cu);
        (void)hipGetLastError();
        grid = cus;
    }
    if (grid < 0) return;
    if (hipMemsetAsync((char*)d_ws + WS_CTL, 0, CTL_ZERO_BYTES, stream) != hipSuccess) return;
    Args a{};
    for (int i = 0; i < 18; ++i) a.in[i] = d_in[i];
    a.out = (float*)d_out; a.ws = (unsigned char*)d_ws; a.pad = 0;
    unsigned char* ws = (unsigned char*)d_ws;
    int region = 0;
    auto launch = [&](int lo, int hi) { a.p_lo = lo; a.p_hi = hi; a.bar_region = region++; hipLaunchKernelGGL(fwd, dim3(grid), dim3(NWAVES * 64), LDS_BYTES, stream, a); };
    launch(0, PH_COUNT);
}
```
